# Optimizing an MI355X kernel written in HIP

```python
import math
import jax, jax.numpy as jnp
from jax import lax
import numpy as np

D_MODEL = 2048
BATCH = 1
SEQ = 8192
DEPTH = 4

N_BRANCH = 4
BRANCH_WIDTH = D_MODEL // N_BRANCH
RW_HEAD = 64
RW_HEADS = BRANCH_WIDTH // RW_HEAD
RW_LORA = D_MODEL // 32
RW_COLS = 3 * BRANCH_WIDTH + 4 * RW_LORA
SHIFT_WIDTH = 3
GN_EPS = 64e-5
DIFF_HEAD = 64
DIFF_HEADS = BRANCH_WIDTH // (2 * DIFF_HEAD)
MLA_HEADS = 4
MLA_NOPE = 128
MLA_ROPE = 64
MLA_V = BRANCH_WIDTH // MLA_HEADS
MLA_Q_LORA = 3 * D_MODEL // 16
MLA_KV_LORA = D_MODEL // 8
MEM_LEN = 256
MEM_HEADS = 4
MEM_HEAD = BRANCH_WIDTH // MEM_HEADS
T5_BUCKETS = 32
T5_MAX_DIST = 128
ROPE_THETA = 10000.0
Q_BLOCK = 128
NORM_EPS = 1e-6
IN_WIDTHS = (RW_COLS, BRANCH_WIDTH, BRANCH_WIDTH, BRANCH_WIDTH,
             MLA_Q_LORA, MLA_KV_LORA, MLA_ROPE, BRANCH_WIDTH,
             N_BRANCH * BRANCH_WIDTH, N_BRANCH * D_MODEL)
N_IN = sum(IN_WIDTHS)

kernel_name = "hybrid_rwkv7_diffattn_mla_mem_encoder"


def _rms_norm(t, g):
    tf = t.astype(jnp.float32)
    y = tf * lax.rsqrt(jnp.mean(tf * tf, axis=-1, keepdims=True) + NORM_EPS)
    return (y * g.astype(jnp.float32)).astype(t.dtype)


def _split_cols(p, widths):
    offs = np.cumsum(np.array(widths))[:-1].tolist()
    return jnp.split(p, offs, axis=-1)


def _rope(t, cos, sin):
    t1, t2 = jnp.split(t, 2, axis=-1)
    return jnp.concatenate([t1 * cos - t2 * sin, t2 * cos + t1 * sin], axis=-1)


def _t5_bucket(rel):
    nb = T5_BUCKETS // 2
    max_exact = nb // 2
    n = jnp.abs(rel)
    n_f = jnp.maximum(n, max_exact).astype(jnp.float32)
    large = max_exact + (jnp.log(n_f / max_exact) / math.log(T5_MAX_DIST / max_exact)
                         * (nb - max_exact)).astype(jnp.int32)
    large = jnp.minimum(large, nb - 1)
    return jnp.where(rel > 0, nb, 0) + jnp.where(n < max_exact, n, large)


def _map_query_blocks(fn, *qs):
    B, S = qs[0].shape[:2]
    nblk = S // Q_BLOCK
    blocks = tuple(jnp.moveaxis(q.reshape((B, nblk, Q_BLOCK) + q.shape[2:]), 1, 0) for q in qs)
    out = lax.map(lambda a: fn(*a), blocks)
    return jnp.moveaxis(out, 0, 1).reshape((B, S) + out.shape[3:])


def _rwkv7_bidir(u, shift, w0, w_up, a0, a_up, k_k, k_a, r_k, gn_g, gn_b):
    B, S, _ = u.shape
    f32 = jnp.float32
    half = SHIFT_WIDTH // 2
    up = jnp.pad(u.astype(f32), ((0, 0), (half, half), (0, 0)))
    sh = shift.astype(f32)
    u = sum(sh[j] * up[:, j:j + S] for j in range(SHIFT_WIDTH))
    r, k, v, wd_f, wd_b, ad_f, ad_b = _split_cols(u, [BRANCH_WIDTH] * 3 + [RW_LORA] * 4)
    wd = jnp.stack([wd_f, wd_b])
    ad = jnp.stack([ad_f, ad_b])
    w_log = -jax.nn.softplus(-(w0.astype(f32)[:, None, None, :]
                               + jnp.einsum('nbsl,nlc->nbsc', jnp.tanh(wd), w_up.astype(f32)))) - 0.5
    decay = jnp.exp(-jnp.exp(w_log))
    a = jax.nn.sigmoid(a0.astype(f32)[:, None, None, :]
                       + jnp.einsum('nbsl,nlc->nbsc', ad, a_up.astype(f32)))

    def hd(t):
        return t.reshape(t.shape[:-1] + (RW_HEADS, RW_HEAD))

    kk = hd(k * k_k.astype(f32))
    kk = kk / jnp.maximum(jnp.sqrt(jnp.sum(kk * kk, axis=-1, keepdims=True)), 1e-12)
    kd = hd(k[None] * (1.0 + (a - 1.0) * k_a.astype(f32)))
    r_h, v_h = hd(r), hd(v)

    def both(t):
        return jnp.stack([t, t])

    def to_scan(t):
        t = jnp.stack([t[0], jnp.flip(t[1], axis=1)])
        return jnp.moveaxis(t, 2, 0)

    xs = tuple(to_scan(t) for t in (both(r_h), hd(decay), kd, both(v_h), both(kk), kk[None] * hd(a)))

    def step(state, inp):
        r_t, w_t, k_t, v_t, kk_t, b_t = inp
        sa = jnp.einsum('nbhij,nbhj->nbhi', state, -kk_t)
        state = (state * w_t[..., None, :] + sa[..., :, None] * b_t[..., None, :]
                 + v_t[..., :, None] * k_t[..., None, :])
        return state, jnp.einsum('nbhij,nbhj->nbhi', state, r_t)

    s0 = jnp.zeros((2, B, RW_HEADS, RW_HEAD, RW_HEAD), f32)
    _, ys = lax.scan(step, s0, xs)
    ys = jnp.moveaxis(ys, 0, 2)
    y = ys[0] + jnp.flip(ys[1], axis=1)
    mu = jnp.mean(y, axis=-1, keepdims=True)
    var = jnp.mean(jnp.square(y - mu), axis=-1, keepdims=True)
    y = (y - mu) * lax.rsqrt(var + GN_EPS) * hd(gn_g.astype(f32)) + hd(gn_b.astype(f32))
    bonus = jnp.sum(r_h[None] * kd * r_k.astype(f32), axis=-1, keepdims=True) * v_h[None]
    y = y + jnp.sum(bonus, axis=0)
    return y.reshape(B, S, BRANCH_WIDTH)


def _diff_attention(d_q, d_k, d_v, qk_g, lam, positions, rel_bias):
    B, S, _ = d_q.shape
    f32 = jnp.float32
    q = _rms_norm(d_q.reshape(B, S, DIFF_HEADS, 2, DIFF_HEAD).astype(f32), qk_g[0])
    k = _rms_norm(d_k.reshape(B, S, DIFF_HEADS, 2, DIFF_HEAD).astype(f32), qk_g[1])
    v = d_v.reshape(B, S, DIFF_HEADS, 2 * DIFF_HEAD).astype(f32)
    k1, k2 = k[..., 0, :], k[..., 1, :]
    table = rel_bias.astype(f32)
    scale = DIFF_HEAD ** -0.5

    def block(q1b, q2b, pb):
        rel = positions[:, None, :] - pb[:, :, None]
        bias = jnp.transpose(table[_t5_bucket(rel)], (0, 3, 1, 2))
        s1 = jnp.einsum('bqhd,bkhd->bhqk', q1b, k1) * scale + bias
        s2 = jnp.einsum('bqhd,bkhd->bhqk', q2b, k2) * scale + bias
        p = jax.nn.softmax(s1, axis=-1) - lam * jax.nn.softmax(s2, axis=-1)
        return jnp.einsum('bhqk,bkhe->bqhe', p, v)

    return _map_query_blocks(block, q[..., 0, :], q[..., 1, :], positions)


def _mla(q_lat, kv_lat, k_rope, q_lat_g, kv_lat_g, w_uq, w_ukv, nope_g, rope_g, cos, sin):
    B, S, _ = q_lat.shape
    f32 = jnp.float32
    q = (_rms_norm(q_lat, q_lat_g) @ w_uq).astype(f32).reshape(B, S, MLA_HEADS, MLA_NOPE + MLA_ROPE)
    kv = (_rms_norm(kv_lat, kv_lat_g) @ w_ukv).astype(f32).reshape(B, S, MLA_HEADS, MLA_NOPE + MLA_V)
    q_nope = _rms_norm(q[..., :MLA_NOPE], nope_g[0])
    q_rot = _rope(_rms_norm(q[..., MLA_NOPE:], rope_g[0]), cos[:, :, None, :], sin[:, :, None, :])
    k_nope = _rms_norm(kv[..., :MLA_NOPE], nope_g[1])
    v = kv[..., MLA_NOPE:]
    k_rot = _rope(_rms_norm(k_rope.astype(f32), rope_g[1]), cos, sin)
    scale = (MLA_NOPE + MLA_ROPE) ** -0.5

    def block(qn_b, qr_b):
        s = (jnp.einsum('bqhd,bkhd->bhqk', qn_b, k_nope)
             + jnp.einsum('bqhd,bkd->bhqk', qr_b, k_rot)) * scale
        p = jax.nn.softmax(s, axis=-1)
        return jnp.einsum('bhqk,bkhe->bqhe', p, v)

    out = _map_query_blocks(block, q_nope, q_rot)
    return out.reshape(B, S, BRANCH_WIDTH)


def _mem_attention(m_q, mem_n, w_kv, qk_g):
    B, S, _ = m_q.shape
    M = mem_n.shape[1]
    f32 = jnp.float32
    q = _rms_norm(m_q.reshape(B, S, MEM_HEADS, MEM_HEAD).astype(f32), qk_g[0])
    kv = (mem_n @ w_kv).astype(f32).reshape(B, M, 2, MEM_HEADS, MEM_HEAD)
    k = _rms_norm(kv[:, :, 0], qk_g[1])
    v = kv[:, :, 1]
    s = jnp.einsum('bqhd,bkhd->bhqk', q, k) * (MEM_HEAD ** -0.5)
    p = jax.nn.softmax(s, axis=-1)
    return jnp.einsum('bhqk,bkhe->bqhe', p, v).reshape(B, S, BRANCH_WIDTH)


def setup_inputs(seed: int = 0) -> dict:
    key = jax.random.key(seed)
    ks = iter(jax.random.split(key, 40))
    f32 = jnp.float32

    def nrm(shape, scale):
        return jax.random.normal(next(ks), shape, f32) * scale

    def gain(shape):
        return 1.0 + nrm(shape, 0.02)

    x = nrm((BATCH, SEQ, D_MODEL), 1.0)
    mem = nrm((BATCH, MEM_LEN, D_MODEL), 1.0)
    offs = jax.random.randint(next(ks), (BATCH, 1), 0, 1024, dtype=jnp.int32)
    positions = (jnp.arange(SEQ, dtype=jnp.int32)[None, :] + offs).astype(jnp.int32)
    norm_g = gain((DEPTH, D_MODEL))
    w_in = nrm((DEPTH, D_MODEL, N_IN), D_MODEL ** -0.5)
    rw_shift = jnp.array([0.25, 0.5, 0.25], f32)[None, :, None] + nrm((DEPTH, SHIFT_WIDTH, RW_COLS), 0.05)
    rw_w0 = jax.random.uniform(next(ks), (DEPTH, 2, BRANCH_WIDTH), f32, -3.0, 1.0)
    rw_w_up = nrm((DEPTH, 2, RW_LORA, BRANCH_WIDTH), 0.5 * RW_LORA ** -0.5)
    rw_a0 = nrm((DEPTH, 2, BRANCH_WIDTH), 0.1)
    rw_a_up = nrm((DEPTH, 2, RW_LORA, BRANCH_WIDTH), 0.5 * RW_LORA ** -0.5)
    rw_k_k = 0.85 + nrm((DEPTH, BRANCH_WIDTH), 0.05)
    rw_k_a = 1.0 + nrm((DEPTH, BRANCH_WIDTH), 0.05)
    rw_r_k = nrm((DEPTH, RW_HEADS, RW_HEAD), 0.1)
    rw_gn_g = gain((DEPTH, BRANCH_WIDTH))
    rw_gn_b = nrm((DEPTH, BRANCH_WIDTH), 0.02)
    diff_qk_g = gain((DEPTH, 2, DIFF_HEAD))
    diff_lambda = nrm((DEPTH, 4, DIFF_HEAD), 0.1)
    diff_sub_g = gain((DEPTH, 2 * DIFF_HEAD))
    rel_bias = nrm((T5_BUCKETS, DIFF_HEADS), 0.5)
    mla_q_lat_g = gain((DEPTH, MLA_Q_LORA))
    mla_kv_lat_g = gain((DEPTH, MLA_KV_LORA))
    mla_w_uq = nrm((DEPTH, MLA_Q_LORA, MLA_HEADS * (MLA_NOPE + MLA_ROPE)), MLA_Q_LORA ** -0.5)
    mla_w_ukv = nrm((DEPTH, MLA_KV_LORA, MLA_HEADS * (MLA_NOPE + MLA_V)), MLA_KV_LORA ** -0.5)
    mla_nope_g = gain((DEPTH, 2, MLA_NOPE))
    mla_rope_g = gain((DEPTH, 2, MLA_ROPE))
    mem_norm_g = gain((DEPTH, D_MODEL))
    mem_w_kv = nrm((DEPTH, D_MODEL, 2 * MEM_HEADS * MEM_HEAD), D_MODEL ** -0.5)
    mem_qk_g = gain((DEPTH, 2, MEM_HEAD))
    w_branch = nrm((DEPTH, N_BRANCH, BRANCH_WIDTH, D_MODEL), BRANCH_WIDTH ** -0.5)
    w_out = nrm((DEPTH, D_MODEL, D_MODEL), D_MODEL ** -0.5)
    return {"x": x, "mem": mem, "positions": positions, "norm_g": norm_g, "w_in": w_in,
            "rw_shift": rw_shift, "rw_w0": rw_w0, "rw_w_up": rw_w_up, "rw_a0": rw_a0,
            "rw_a_up": rw_a_up, "rw_k_k": rw_k_k, "rw_k_a": rw_k_a, "rw_r_k": rw_r_k,
            "rw_gn_g": rw_gn_g, "rw_gn_b": rw_gn_b, "diff_qk_g": diff_qk_g,
            "diff_lambda": diff_lambda, "diff_sub_g": diff_sub_g, "rel_bias": rel_bias,
            "mla_q_lat_g": mla_q_lat_g, "mla_kv_lat_g": mla_kv_lat_g, "mla_w_uq": mla_w_uq,
            "mla_w_ukv": mla_w_ukv, "mla_nope_g": mla_nope_g, "mla_rope_g": mla_rope_g,
            "mem_norm_g": mem_norm_g, "mem_w_kv": mem_w_kv, "mem_qk_g": mem_qk_g,
            "w_branch": w_branch, "w_out": w_out}


def reference(x, mem, positions, norm_g, w_in, rw_shift, rw_w0, rw_w_up, rw_a0, rw_a_up,
              rw_k_k, rw_k_a, rw_r_k, rw_gn_g, rw_gn_b, diff_qk_g, diff_lambda, diff_sub_g,
              rel_bias, mla_q_lat_g, mla_kv_lat_g, mla_w_uq, mla_w_ukv, mla_nope_g, mla_rope_g,
              mem_norm_g, mem_w_kv, mem_qk_g, w_branch, w_out):
    B, S, _ = x.shape
    f32 = jnp.float32
    inv_freq = ROPE_THETA ** (-jnp.arange(0, MLA_ROPE, 2, dtype=f32) / MLA_ROPE)
    ang = positions.astype(f32)[..., None] * inv_freq
    cos, sin = jnp.cos(ang), jnp.sin(ang)
    for l in range(DEPTH):
        h = _rms_norm(x, norm_g[l])
        p = h @ w_in[l]
        (rw_u, d_q, d_k, d_v, q_lat, kv_lat, k_rope, m_q, gate_in, merge_in) = _split_cols(p, IN_WIDTHS)
        y_a = _rwkv7_bidir(rw_u, rw_shift[l], rw_w0[l], rw_w_up[l], rw_a0[l], rw_a_up[l],
                           rw_k_k[l], rw_k_a[l], rw_r_k[l], rw_gn_g[l], rw_gn_b[l])
        lam_init = 0.8 - 0.6 * math.exp(-0.3 * l)
        lq = diff_lambda[l].astype(f32)
        lam = jnp.exp(jnp.sum(lq[0] * lq[1])) - jnp.exp(jnp.sum(lq[2] * lq[3])) + lam_init
        y_b = _diff_attention(d_q, d_k, d_v, diff_qk_g[l], lam, positions, rel_bias)
        y_b = (_rms_norm(y_b, diff_sub_g[l]) * (1.0 - lam_init)).reshape(B, S, BRANCH_WIDTH)
        y_c = _mla(q_lat, kv_lat, k_rope, mla_q_lat_g[l], mla_kv_lat_g[l], mla_w_uq[l],
                   mla_w_ukv[l], mla_nope_g[l], mla_rope_g[l], cos, sin)
        mem_n = _rms_norm(mem, mem_norm_g[l])
        y_d = _mem_attention(m_q, mem_n, mem_w_kv[l], mem_qk_g[l])
        gates = gate_in.reshape(B, S, N_BRANCH, BRANCH_WIDTH)
        merges = merge_in.reshape(B, S, N_BRANCH, D_MODEL)
        z = None
        for bi, y in enumerate((y_a, y_b, y_c, y_d)):
            zb = jax.nn.sigmoid(merges[:, :, bi]) * (
                (y.astype(x.dtype) * jax.nn.silu(gates[:, :, bi])) @ w_branch[l, bi])
            z = zb if z is None else z + zb
        x = x + z @ w_out[l]
    return x
```

```cpp
#include <hip/hip_runtime.h>
#include <hip/hip_cooperative_groups.h>
#include <cstdio>
namespace cg = cooperative_groups;

typedef unsigned short u16;
typedef __attribute__((ext_vector_type(8))) short bf16x8;
typedef __attribute__((ext_vector_type(4))) float f32x4;
typedef __attribute__((ext_vector_type(4))) unsigned int u32x4;
typedef __attribute__((ext_vector_type(2))) unsigned int u32x2;

#ifndef MULTI_LAUNCH
#define MULTI_LAUNCH 0
#endif
#ifndef DUP_MASK
#define DUP_MASK 0
#endif
#ifndef ATT_NSUB
#define ATT_NSUB 2
#endif
#ifndef AT_MASK
#define AT_MASK 15
#endif
#ifndef PH_MASK
#if MULTI_LAUNCH
#define PH_MASK 0
#else
#define PH_MASK 0xffff
#endif
#endif


#define LOG2E 1.4426950408889634f
#define S_ 8192
#define D_ 2048
#define NIN 14784
#define NINP 14848
#define L_ 4
#define O_DQ 1792
#define O_DK 2304
#define O_DV 2816
#define O_QL 3328
#define O_KVL 3712
#define O_KR 3968
#define O_MQ 4032
#define O_G 4544
#define O_MG 6592

enum { I_X = 0, I_MEM, I_POS, I_NORMG, I_WIN, I_SHIFT, I_W0, I_WUP, I_A0, I_AUP, I_KK, I_KA, I_RK, I_GNG, I_GNB,
       I_DQKG, I_DLAM, I_DSUBG, I_RELB, I_QLATG, I_KVLATG, I_WUQ, I_WUKV, I_NOPEG, I_ROPEG, I_MEMNG, I_WKV,
       I_MQKG, I_WBR, I_WOUT, N_INPUTS };

struct Params {
  const void* in[N_INPUTS];
  float* out;
  char* ws;
};

constexpr size_t al(size_t x) { return (x + 255) & ~(size_t)255; }
constexpr size_t OFF_WIN = 0;
constexpr size_t OFF_WB = OFF_WIN + al((size_t)L_ * NINP * D_ * 2);
constexpr size_t OFF_WO = OFF_WB + al((size_t)L_ * 4 * 2048 * 512 * 2);
constexpr size_t OFF_WUQ = OFF_WO + al((size_t)L_ * 2048 * 2048 * 2);
constexpr size_t OFF_WUKV = OFF_WUQ + al((size_t)L_ * 768 * 384 * 2);
constexpr size_t OFF_WKV = OFF_WUKV + al((size_t)L_ * 1024 * 256 * 2);
constexpr size_t OFF_MEMN = OFF_WKV + al((size_t)L_ * 1024 * 2048 * 2);
constexpr size_t OFF_KVMEM = OFF_MEMN + al((size_t)L_ * 256 * 2048 * 2);
constexpr size_t OFF_KMEM = OFF_KVMEM + al((size_t)L_ * 256 * 512 * 4);
constexpr size_t OFF_VTMEM = OFF_KMEM + al((size_t)L_ * 4 * 256 * 128 * 2);
constexpr size_t OFF_H = OFF_VTMEM + al((size_t)L_ * 4 * 128 * 256 * 2);
constexpr size_t OFF_P = OFF_H + al((size_t)S_ * D_ * 2);
constexpr size_t OFF_RWU = OFF_P + al((size_t)S_ * NINP * 2);
constexpr size_t OFF_SCR = OFF_RWU + al((size_t)S_ * 1792 * 4);
constexpr size_t OFF_SCV = OFF_SCR + al((size_t)S_ * 512 * 4);
constexpr size_t OFF_SCKK = OFF_SCV + al((size_t)S_ * 512 * 4);
constexpr size_t OFF_SCW = OFF_SCKK + al((size_t)S_ * 512 * 4);
constexpr size_t OFF_SCKD = OFF_SCW + al((size_t)2 * S_ * 512 * 4);
constexpr size_t OFF_SCB = OFF_SCKD + al((size_t)2 * S_ * 512 * 4);
constexpr size_t OFF_BONUS = OFF_SCB + al((size_t)2 * S_ * 512 * 4);
constexpr size_t OFF_YS = OFF_BONUS + al((size_t)S_ * 8 * 4);
constexpr size_t OFF_MQ = OFF_YS + al((size_t)2 * S_ * 512 * 4);
constexpr size_t OFF_MKV = OFF_MQ + al((size_t)S_ * 768 * 4);
constexpr size_t OFF_QM = OFF_MKV + al((size_t)S_ * 512 * 4);
constexpr size_t OFF_KM = OFF_QM + al((size_t)4 * S_ * 192 * 2);
constexpr size_t OFF_VTM = OFF_KM + al((size_t)4 * S_ * 192 * 2);
constexpr size_t OFF_VTD = OFF_VTM + al((size_t)4 * 128 * S_ * 2);
constexpr size_t OFF_OB = OFF_VTD + al((size_t)4 * 128 * S_ * 2);
constexpr size_t OFF_YG = OFF_OB + al((size_t)16 * S_ * 128 * 4);
constexpr size_t OFF_Z = OFF_YG + al((size_t)4 * S_ * 512 * 2);
constexpr size_t OFF_CNT = OFF_Z + al((size_t)S_ * D_ * 2);
constexpr size_t OFF_KPMM = OFF_CNT + 256;
constexpr size_t OFF_BAR = OFF_KPMM + 1024;
constexpr size_t OFF_OB2 = OFF_BAR + al(3456 * 4);
constexpr size_t OFF_ML = OFF_OB2 + al((size_t)16 * S_ * 128 * 4);
constexpr size_t WS_TOTAL = OFF_ML + (size_t)2 * 16 * S_ * 2 * 4;

#define SMEM_BYTES 49152

#define LBAR() asm volatile("s_waitcnt lgkmcnt(0)\n\ts_barrier" ::: "memory")
__device__ __forceinline__ int ltid() {
  int t = __builtin_amdgcn_workitem_id_x();
  asm volatile("" : "+v"(t));
  return t;
}
__device__ __forceinline__ int lbid() {
  int t = __builtin_amdgcn_workgroup_id_x();
  asm volatile("" : "+s"(t));
  return t;
}
typedef float f32x2_ __attribute__((ext_vector_type(2)));
typedef __bf16 bf16x2_ __attribute__((ext_vector_type(2)));
__device__ __forceinline__ unsigned pack2(float a, float b) {
  f32x2_ v = {a, b};
  return __builtin_bit_cast(unsigned, __builtin_convertvector(v, bf16x2_));
}
__device__ __forceinline__ u16 f2bf(float f) { return (u16)(pack2(f, 0.f) & 0xffffu); }
__device__ __forceinline__ float bf2f(u16 h) { return __uint_as_float(((unsigned)h) << 16); }
__device__ __forceinline__ float lo2f(unsigned u) { return __uint_as_float(u << 16); }
__device__ __forceinline__ float hi2f(unsigned u) { return __uint_as_float(u & 0xffff0000u); }
__device__ __forceinline__ float sigmoidf_(float x) { return 1.f / (1.f + __expf(-x)); }
__device__ __forceinline__ float wave_sum(float v) {
#pragma unroll
  for (int o = 32; o >= 1; o >>= 1) v += __shfl_xor(v, o);
  return v;
}
template <int CTRL>
__device__ __forceinline__ float dpp_add(float x) {
  return x + __int_as_float(__builtin_amdgcn_update_dpp(0, __float_as_int(x), CTRL, 0xf, 0xf, true));
}
__device__ __forceinline__ float row16_sum(float x) {
  x = dpp_add<0xB1>(x);
  x = dpp_add<0x4E>(x);
  x = dpp_add<0x141>(x);
  x = dpp_add<0x140>(x);
  return x;
}

template <bool SW>
__device__ __forceinline__ void gemm_main1(const u16* __restrict__ A, int lda, const u16* __restrict__ B, int ldb,
                                          int K, u16* As, u16* Bs, f32x4 (&acc)[4][4]) {
  const int tid = ltid(), lane = tid & 63, w = tid >> 6, l15 = lane & 15, quad = lane >> 4;
  const int wm = w >> 1, wn = w & 1;
  u32x4 ra[4], rb[4];
#pragma unroll
  for (int i = 0; i < 4; ++i) {
    int c = tid + i * 256, r = c >> 3, kc = c & 7;
    ra[i] = *(const u32x4*)(A + (size_t)r * lda + kc * 8);
    rb[i] = *(const u32x4*)(B + (size_t)r * ldb + kc * 8);
  }
  for (int k0 = 0; k0 < K; k0 += 64) {
    LBAR();
#pragma unroll
    for (int i = 0; i < 4; ++i) {
      int c = tid + i * 256, r = c >> 3, kc = c & 7;
      *(u32x4*)(As + r * 64 + ((kc ^ (r & 7)) * 8)) = ra[i];
      *(u32x4*)(Bs + r * 64 + ((kc ^ (r & 7)) * 8)) = rb[i];
    }
    LBAR();
    {
      const int kn = min(k0 + 64, K - 64);
#pragma unroll
      for (int i = 0; i < 4; ++i) {
        int c = tid + i * 256, r = c >> 3, kc = c & 7;
        ra[i] = *(const u32x4*)(A + (size_t)r * lda + kn + kc * 8);
        rb[i] = *(const u32x4*)(B + (size_t)r * ldb + kn + kc * 8);
      }
    }
#pragma unroll
    for (int ks = 0; ks < 2; ++ks) {
      bf16x8 af[4], bfr[4];
#pragma unroll
      for (int i = 0; i < 4; ++i) {
        af[i] = *(const bf16x8*)(As + (wm * 64 + i * 16 + l15) * 64 + (((ks * 4 + quad) ^ (l15 & 7)) * 8));
        bfr[i] = *(const bf16x8*)(Bs + (wn * 64 + i * 16 + l15) * 64 + (((ks * 4 + quad) ^ (l15 & 7)) * 8));
      }
#pragma unroll
      for (int i = 0; i < 4; ++i)
#pragma unroll
        for (int j = 0; j < 4; ++j) acc[i][j] = SW ? __builtin_amdgcn_mfma_f32_16x16x32_bf16(bfr[j], af[i], acc[i][j], 0, 0, 0)
                                                     : __builtin_amdgcn_mfma_f32_16x16x32_bf16(af[i], bfr[j], acc[i][j], 0, 0, 0);
    }
  }
}

template <bool SW>
__device__ __forceinline__ void gemm_main(const u16* __restrict__ A, int lda, const u16* __restrict__ B, int ldb,
                                          int K, u16* As, u16* Bs, f32x4 (&acc)[4][4]) {
  const int tid = ltid(), lane = tid & 63, w = tid >> 6, l15 = lane & 15, quad = lane >> 4;
  const int wm = w >> 1, wn = w & 1;
  u32x4 ra0[4], rb0[4], ra1[4], rb1[4];
  const u16* Ap = A + (size_t)(tid >> 3) * lda + (tid & 7) * 8;
  const u16* Bp = B + (size_t)(tid >> 3) * ldb + (tid & 7) * 8;
  const size_t sa = (size_t)32 * lda, sb = (size_t)32 * ldb;
#define G_LOAD(RA, RB, KK)                                            \
  {                                                                   \
    const int kk_ = min((KK), K - 64);                                \
    _Pragma("unroll") for (int i = 0; i < 4; ++i) {                   \
      RA[i] = *(const u32x4*)(Ap + i * sa + kk_);                     \
      RB[i] = *(const u32x4*)(Bp + i * sb + kk_);                     \
    }                                                                 \
  }
#define G_STAGE(RA, RB, KNEXT)                                                                   \
  {                                                                                              \
    LBAR();                                                                             \
    _Pragma("unroll") for (int i = 0; i < 4; ++i) {                                              \
      *(u32x4*)(As + ((tid >> 3) + i * 32) * 64 + (((tid & 7) ^ ((tid >> 3) & 7)) * 8)) = RA[i]; \
      *(u32x4*)(Bs + ((tid >> 3) + i * 32) * 64 + (((tid & 7) ^ ((tid >> 3) & 7)) * 8)) = RB[i]; \
    }                                                                                            \
    LBAR();                                                                             \
    G_LOAD(RA, RB, KNEXT)                                                                        \
    {                                                                                            \
      bf16x8 af[2][4], bfr[2][4];                                                                \
      _Pragma("unroll") for (int ks = 0; ks < 2; ++ks)                                           \
        _Pragma("unroll") for (int i = 0; i < 4; ++i) {                                          \
          af[ks][i] = *(const bf16x8*)(As + (wm * 64 + i * 16 + l15) * 64 + (((ks * 4 + quad) ^ (l15 & 7)) * 8));  \
          bfr[ks][i] = *(const bf16x8*)(Bs + (wn * 64 + i * 16 + l15) * 64 + (((ks * 4 + quad) ^ (l15 & 7)) * 8)); \
        }                                                                                        \
      __builtin_amdgcn_sched_barrier(0);                                                         \
      _Pragma("unroll") for (int ks = 0; ks < 2; ++ks)                                           \
        _Pragma("unroll") for (int i = 0; i < 4; ++i)                                            \
          _Pragma("unroll") for (int j = 0; j < 4; ++j)                                          \
            acc[i][j] = SW ? __builtin_amdgcn_mfma_f32_16x16x32_bf16(bfr[ks][j], af[ks][i], acc[i][j], 0, 0, 0) \
                           : __builtin_amdgcn_mfma_f32_16x16x32_bf16(af[ks][i], bfr[ks][j], acc[i][j], 0, 0, 0); \
    }                                                                                            \
  }
  G_LOAD(ra0, rb0, 0)
  G_LOAD(ra1, rb1, 64)
  for (int k0 = 0; k0 < K; k0 += 128) {
    G_STAGE(ra0, rb0, k0 + 128)
    G_STAGE(ra1, rb1, k0 + 192)
  }
#undef G_LOAD
#undef G_STAGE
}

__device__ __forceinline__ void gemm_main_blk(const u16* __restrict__ A, const u16* __restrict__ B,
                                          int K, u16* As, u16* Bs, f32x4 (&acc)[4][4]) {
  const int tid = ltid(), lane = tid & 63, w = tid >> 6, l15 = lane & 15, quad = lane >> 4;
  const int wm = w >> 1, wn = w & 1;
  u32x4 ra0[4], rb0[4], ra1[4], rb1[4];
  const u16* Ap = A + tid * 8;
  const u16* Bp = B + tid * 8;
#define G_LOAD(RA, RB, KK)                                            \
  {                                                                   \
    const int kk_ = min((KK), K - 64);                                \
    _Pragma("unroll") for (int i = 0; i < 4; ++i) {                   \
      RA[i] = *(const u32x4*)(Ap + (size_t)kk_ * 128 + i * 2048);    \
      RB[i] = *(const u32x4*)(Bp + (size_t)kk_ * 128 + i * 2048);    \
    }                                                                 \
  }
#define G_STAGE(RA, RB, KNEXT)                                                                   \
  {                                                                                              \
    LBAR();                                                                             \
    _Pragma("unroll") for (int i = 0; i < 4; ++i) {                                              \
      *(u32x4*)(As + i * 2048 + tid * 8) = RA[i];                                                \
      *(u32x4*)(Bs + i * 2048 + tid * 8) = RB[i];                                                \
    }                                                                                            \
    LBAR();                                                                             \
    G_LOAD(RA, RB, KNEXT)                                                                        \
    {                                                                                            \
      bf16x8 af[2][4], bfr[2][4];                                                                \
      _Pragma("unroll") for (int ks = 0; ks < 2; ++ks)                                           \
        _Pragma("unroll") for (int i = 0; i < 4; ++i) {                                          \
          af[ks][i] = *(const bf16x8*)(As + (wm * 64 + i * 16 + l15) * 64 + (((ks * 4 + quad) ^ (l15 & 7)) * 8));  \
          bfr[ks][i] = *(const bf16x8*)(Bs + (wn * 64 + i * 16 + l15) * 64 + (((ks * 4 + quad) ^ (l15 & 7)) * 8)); \
        }                                                                                        \
      __builtin_amdgcn_sched_barrier(0);                                                         \
      _Pragma("unroll") for (int ks = 0; ks < 2; ++ks)                                           \
        _Pragma("unroll") for (int i = 0; i < 4; ++i)                                            \
          _Pragma("unroll") for (int j = 0; j < 4; ++j)                                          \
            acc[i][j] = __builtin_amdgcn_mfma_f32_16x16x32_bf16(af[ks][i], bfr[ks][j], acc[i][j], 0, 0, 0); \
    }                                                                                            \
  }
  G_LOAD(ra0, rb0, 0)
  G_LOAD(ra1, rb1, 64)
  for (int k0 = 0; k0 < K; k0 += 128) {
    G_STAGE(ra0, rb0, k0 + 128)
    G_STAGE(ra1, rb1, k0 + 192)
  }
#undef G_LOAD
#undef G_STAGE
}

#define ZERO_ACC(acc)                                  \
  _Pragma("unroll") for (int i_ = 0; i_ < 4; ++i_)     \
  _Pragma("unroll") for (int j_ = 0; j_ < 4; ++j_) acc[i_][j_] = (f32x4){0.f, 0.f, 0.f, 0.f};

#define EPI_LOOP_T(BODY)                                                           \
  {                                                                                \
    const int lane_ = ltid() & 63, w_ = ltid() >> 6;                               \
    const int l15_ = lane_ & 15, quad_ = lane_ >> 4, wm_ = w_ >> 1, wn_ = w_ & 1;  \
    _Pragma("unroll") for (int i = 0; i < 4; ++i) {                                \
      _Pragma("unroll") for (int j = 0; j < 4; ++j) {                              \
        const int mr = wm_ * 64 + i * 16 + l15_;                                   \
        const int nc = wn_ * 64 + j * 16 + quad_ * 4;                              \
        BODY                                                                       \
      }                                                                            \
    }                                                                              \
  }

#define EPI_LOOP(BODY)                                                             \
  {                                                                                \
    const int lane_ = ltid() & 63, w_ = ltid() >> 6;                     \
    const int l15_ = lane_ & 15, quad_ = lane_ >> 4, wm_ = w_ >> 1, wn_ = w_ & 1;  \
    _Pragma("unroll") for (int i = 0; i < 4; ++i) {                                \
      _Pragma("unroll") for (int j = 0; j < 4; ++j) {                              \
        const int mr = wm_ * 64 + i * 16 + quad_ * 4;                              \
        const int nc = wn_ * 64 + j * 16 + l15_;                                   \
        BODY                                                                       \
      }                                                                            \
    }                                                                              \
  }

__device__ __forceinline__ void gemm_main_blk2(const u16* __restrict__ A, const u16* __restrict__ B, int K, u16* As, u16* Bs,
                                               f32x4 (&acc)[8][4]) {
  const int tid = ltid(), lane = tid & 63, w = tid >> 6, l15 = lane & 15, quad = lane >> 4;
  const int wm = w >> 1, wn = w & 1;
  u32x4 ra[8], rb[4];
  const u16* Ap = A + tid * 8;
  const u16* Bp = B + tid * 8;
  const size_t a2 = (size_t)(K >> 6) * 8192;
#define G2_LOAD(KK)                                                       \
  {                                                                       \
    const int kk_ = min((KK), K - 64);                                    \
    _Pragma("unroll") for (int i = 0; i < 4; ++i) {                       \
      ra[i] = *(const u32x4*)(Ap + (size_t)kk_ * 128 + i * 2048);         \
      ra[4 + i] = *(const u32x4*)(Ap + a2 + (size_t)kk_ * 128 + i * 2048); \
      rb[i] = *(const u32x4*)(Bp + (size_t)kk_ * 128 + i * 2048);         \
    }                                                                     \
  }
  G2_LOAD(0)
  for (int k0 = 0; k0 < K; k0 += 64) {
    LBAR();
#pragma unroll
    for (int i = 0; i < 8; ++i) *(u32x4*)(As + i * 2048 + tid * 8) = ra[i];
#pragma unroll
    for (int i = 0; i < 4; ++i) *(u32x4*)(Bs + i * 2048 + tid * 8) = rb[i];
    LBAR();
    G2_LOAD(k0 + 64)
#pragma unroll
    for (int ks = 0; ks < 2; ++ks) {
      bf16x8 af[8], bfr[4];
#pragma unroll
      for (int i = 0; i < 8; ++i)
        af[i] = *(const bf16x8*)(As + (wm * 128 + i * 16 + l15) * 64 + (((ks * 4 + quad) ^ (l15 & 7)) * 8));
#pragma unroll
      for (int j = 0; j < 4; ++j)
        bfr[j] = *(const bf16x8*)(Bs + (wn * 64 + j * 16 + l15) * 64 + (((ks * 4 + quad) ^ (l15 & 7)) * 8));
#pragma unroll
      for (int i = 0; i < 8; ++i)
#pragma unroll
        for (int j = 0; j < 4; ++j) acc[i][j] = __builtin_amdgcn_mfma_f32_16x16x32_bf16(af[i], bfr[j], acc[i][j], 0, 0, 0);
    }
  }
#undef G2_LOAD
}

#define EPI_LOOP8(BODY)                                                            \
  {                                                                                \
    const int lane_ = ltid() & 63, w_ = ltid() >> 6;                               \
    const int l15_ = lane_ & 15, quad_ = lane_ >> 4, wm_ = w_ >> 1, wn_ = w_ & 1;  \
    _Pragma("unroll") for (int i = 0; i < 8; ++i) {                                \
      _Pragma("unroll") for (int j = 0; j < 4; ++j) {                              \
        const int mr = wm_ * 128 + i * 16 + quad_ * 4;                             \
        const int nc = wn_ * 64 + j * 16 + l15_;                                   \
        BODY                                                                       \
      }                                                                            \
    }                                                                              \
  }

template <bool BLK>
__device__ __forceinline__ void transpose_tile(const float* __restrict__ src, int N, u16* __restrict__ dst, int K, int kt, int nt,
                               float* tile) {
  const int tid = ltid();
  __syncthreads();
  {
    int c = tid & 63, r0 = tid >> 6;
#pragma unroll
    for (int i = 0; i < 16; ++i) {
      int r = r0 + i * 4;
      tile[r * 65 + c] = src[(size_t)(kt * 64 + r) * N + nt * 64 + c];
    }
  }
  __syncthreads();
#pragma unroll
  for (int i = 0; i < 2; ++i) {
    int c = tid + i * 256, n = c >> 3, kc = c & 7;
    uint4 o;
    o.x = pack2(tile[(kc * 8 + 0) * 65 + n], tile[(kc * 8 + 1) * 65 + n]);
    o.y = pack2(tile[(kc * 8 + 2) * 65 + n], tile[(kc * 8 + 3) * 65 + n]);
    o.z = pack2(tile[(kc * 8 + 4) * 65 + n], tile[(kc * 8 + 5) * 65 + n]);
    o.w = pack2(tile[(kc * 8 + 6) * 65 + n], tile[(kc * 8 + 7) * 65 + n]);
    if (BLK) {
      const int ng = nt * 64 + n;
      *(uint4*)(dst + ((size_t)(ng >> 7) * (K >> 6) + kt) * 8192 + (ng & 127) * 64 + ((kc ^ (ng & 7)) * 8)) = o;
    } else {
      *(uint4*)(dst + (size_t)(nt * 64 + n) * K + kt * 64 + kc * 8) = o;
    }
  }
}

template <bool BLK>
__device__ __forceinline__ void rms_rows(const float* __restrict__ src, int nrows, const float* __restrict__ g, u16* __restrict__ dst) {
  const int lane = ltid() & 63, w = ltid() >> 6;
  for (int row = lbid() * 4 + w; row < nrows; row += gridDim.x * 4) {
    const float4* xr = (const float4*)(src + (size_t)row * D_);
    float4 v[8];
    float ss = 0.f;
#pragma unroll
    for (int i = 0; i < 8; ++i) {
      v[i] = xr[lane + i * 64];
      ss += v[i].x * v[i].x + v[i].y * v[i].y + v[i].z * v[i].z + v[i].w * v[i].w;
    }
    ss = wave_sum(ss);
    float rs = rsqrtf(ss * (1.f / D_) + 1e-6f);
#pragma unroll
    for (int i = 0; i < 8; ++i) {
      int col = (lane + i * 64) * 4;
      float4 gg = *(const float4*)(g + col);
      uint2 o;
      o.x = pack2(v[i].x * rs * gg.x, v[i].y * rs * gg.y);
      o.y = pack2(v[i].z * rs * gg.z, v[i].w * rs * gg.w);
      if (BLK) {
        *(uint2*)(dst + ((size_t)(row >> 7) * 32 + (col >> 6)) * 8192 + (row & 127) * 64 + ((((col & 63) >> 3) ^ (row & 7)) * 8) + (col & 7)) = o;
      } else {
        *(uint2*)(dst + (size_t)row * D_ + col) = o;
      }
    }
  }
}

__device__ __forceinline__ int t5_bucket(int rel) {
  int n = rel < 0 ? -rel : rel;
  int b;
  if (n < 8) b = n;
  else if (n < 12) b = 8;
  else if (n < 16) b = 9;
  else if (n < 23) b = 10;
  else if (n < 32) b = 11;
  else if (n < 46) b = 12;
  else if (n < 64) b = 13;
  else if (n < 91) b = 14;
  else b = 15;
  return (rel > 0 ? 16 : 0) + b;
}

__device__ __forceinline__ void phase_w(const Params p, char* smem) {
  const int tid = ltid();
  float* tile = (float*)smem;
  char* ws = p.ws;
  if (lbid() == 0 && tid < 64) ((int*)(ws + OFF_CNT))[tid] = 0;
  {
    const int lane = tid & 63, w = tid >> 6;
    const int* pos = (const int*)p.in[I_POS];
    for (int t = lbid() * 4 + w; t < 128; t += gridDim.x * 4) {
      int v = pos[t * 64 + lane], mn = v, mx = v;
#pragma unroll
      for (int o = 32; o >= 1; o >>= 1) {
        mn = min(mn, __shfl_xor(mn, o));
        mx = max(mx, __shfl_xor(mx, o));
      }
      if (lane == 0) {
        ((int*)(ws + OFF_KPMM))[t * 2] = mn;
        ((int*)(ws + OFF_KPMM))[t * 2 + 1] = mx;
      }
    }
  }
  for (int i = lbid() * 256 + tid; i < L_ * 32 * 512; i += gridDim.x * 256) {
    int l = i / (32 * 512), r = i % (32 * 512), kt = r >> 9, q = r & 511;
    *(uint4*)((u16*)(ws + OFF_WIN) + (size_t)l * NINP * D_ + ((size_t)115 * 32 + kt) * 8192 + 4096 + q * 8) = make_uint4(0, 0, 0, 0);
  }
  rms_rows<true>((const float*)p.in[I_X], S_, (const float*)p.in[I_NORMG], (u16*)(ws + OFF_H));
  for (int l = 0; l < L_; ++l)
    rms_rows<false>((const float*)p.in[I_MEM], 256, (const float*)p.in[I_MEMNG] + l * D_, (u16*)(ws + OFF_MEMN) + (size_t)l * 256 * D_);
  const int PER_L = 7392 + 1024 + 1024 + 72 + 64 + 512;
  for (int t = lbid(); t < L_ * PER_L; t += gridDim.x) {
    int l = t / PER_L, r = t % PER_L;
    if (r < 7392) {
      transpose_tile<true>((const float*)p.in[I_WIN] + (size_t)l * D_ * NIN, NIN, (u16*)(ws + OFF_WIN) + (size_t)l * NINP * D_, D_,
                     r / 231, r % 231, tile);
    } else if (r < 7392 + 1024) {
      r -= 7392;
      int bi = r >> 8;
      r &= 255;
      transpose_tile<false>((const float*)p.in[I_WBR] + (size_t)(l * 4 + bi) * 512 * 2048, 2048,
                     (u16*)(ws + OFF_WB) + (size_t)(l * 4 + bi) * 2048 * 512, 512, r >> 5, r & 31, tile);
    } else if (r < 7392 + 2048) {
      r -= 7392 + 1024;
      transpose_tile<false>((const float*)p.in[I_WOUT] + (size_t)l * 2048 * 2048, 2048, (u16*)(ws + OFF_WO) + (size_t)l * 2048 * 2048,
                     2048, r >> 5, r & 31, tile);
    } else if (r < 7392 + 2048 + 72) {
      r -= 7392 + 2048;
      transpose_tile<false>((const float*)p.in[I_WUQ] + (size_t)l * 384 * 768, 768, (u16*)(ws + OFF_WUQ) + (size_t)l * 768 * 384, 384,
                     r / 12, r % 12, tile);
    } else if (r < 7392 + 2048 + 72 + 64) {
      r -= 7392 + 2048 + 72;
      transpose_tile<false>((const float*)p.in[I_WUKV] + (size_t)l * 256 * 1024, 1024, (u16*)(ws + OFF_WUKV) + (size_t)l * 1024 * 256,
                     256, r >> 4, r & 15, tile);
    } else {
      r -= 7392 + 2048 + 72 + 64;
      transpose_tile<false>((const float*)p.in[I_WKV] + (size_t)l * 2048 * 1024, 1024, (u16*)(ws + OFF_WKV) + (size_t)l * 1024 * 2048,
                     2048, r >> 4, r & 15, tile);
    }
  }
}

__device__ __forceinline__ int tile_slots(int NT) { return gridDim.x == 512 ? 512 * ((NT + 7) >> 3) : 64 * NT; }
__device__ __forceinline__ bool tile_map(int t, int NT, int& mt, int& nt) {
  if (gridDim.x == 512) {
    int bid = t & 511, k = t >> 9, x = bid & 7, j = bid >> 3;
    mt = 8 * x + (j & 7);
    nt = 8 * k + (j >> 3);
  } else {
    mt = t & 63;
    nt = t >> 6;
  }
  return nt < NT;
}

__device__ __forceinline__ int tile_slots2(int NT) { return gridDim.x == 512 ? 512 * ((NT + 15) >> 4) : 32 * NT; }
__device__ __forceinline__ bool tile_map2(int t, int NT, int& mt, int& nt) {
  if (gridDim.x == 512) {
    int bid = t & 511, k = t >> 9, x = bid & 7, j = bid >> 3;
    mt = 4 * x + (j & 3);
    nt = 16 * k + (j >> 2);
  } else {
    mt = t & 31;
    nt = t >> 5;
  }
  return nt < NT;
}

__device__ __forceinline__ void phase_gemm_in(const Params p, int l, char* smem, int vb) {
  u16* As = (u16*)smem;
  char* ws = p.ws;
  {
    u16* Bs = As + 256 * 64;
    const int nslots = tile_slots2(112);
    for (int t = vb; t < nslots; t += gridDim.x) {
      int mt, nt;
      if (!tile_map2(t, 112, mt, nt)) continue;
      f32x4 acc[8][4];
#pragma unroll
      for (int i_ = 0; i_ < 8; ++i_)
#pragma unroll
        for (int j_ = 0; j_ < 4; ++j_) acc[i_][j_] = (f32x4){0.f, 0.f, 0.f, 0.f};
      int m0 = mt * 256, n0 = nt * 128;
      gemm_main_blk2((const u16*)(ws + OFF_H) + (size_t)(2 * mt) * 32 * 8192,
                     (const u16*)(ws + OFF_WIN) + (size_t)l * NINP * D_ + (size_t)nt * 32 * 8192, D_, As, Bs, acc);
      if (n0 < 1792) {
        float* dst = (float*)(ws + OFF_RWU);
        EPI_LOOP8({
          _Pragma("unroll") for (int r2 = 0; r2 < 4; ++r2) dst[(size_t)(m0 + mr + r2) * 1792 + n0 + nc] = acc[i][j][r2];
        })
      } else if (n0 >= O_DV && n0 < O_QL) {
        u16* dst = (u16*)(ws + OFF_VTD) + (size_t)((n0 - O_DV) / 128) * 128 * S_;
        EPI_LOOP8({
          uint2 o;
          o.x = pack2(acc[i][j][0], acc[i][j][1]);
          o.y = pack2(acc[i][j][2], acc[i][j][3]);
          *(uint2*)(dst + (size_t)nc * S_ + m0 + mr) = o;
        })
      } else {
        u16* dst = (u16*)(ws + OFF_P);
        EPI_LOOP8({
          _Pragma("unroll") for (int r2 = 0; r2 < 4; ++r2) dst[(size_t)(m0 + mr + r2) * NINP + n0 + nc] = f2bf(acc[i][j][r2]);
        })
      }
    }
  }
  {
    u16* Bs = As + 128 * 64;
    for (int t = vb; t < 256; t += gridDim.x) {
      f32x4 acc[4][4];
      ZERO_ACC(acc);
      int mt = t & 63, nt = 112 + (t >> 6);
      int m0 = mt * 128, n0 = nt * 128;
      gemm_main_blk((const u16*)(ws + OFF_H) + (size_t)mt * 32 * 8192,
                    (const u16*)(ws + OFF_WIN) + (size_t)l * NINP * D_ + (size_t)nt * 32 * 8192, D_, As, Bs, acc);
      u16* dst = (u16*)(ws + OFF_P);
      EPI_LOOP({
        _Pragma("unroll") for (int r2 = 0; r2 < 4; ++r2) dst[(size_t)(m0 + mr + r2) * NINP + n0 + nc] = f2bf(acc[i][j][r2]);
      })
    }
  }
  if (l == 0) {
    u16* Bs = As + 128 * 64;
    for (int tt = (vb + gridDim.x - 256) % gridDim.x; tt < 64; tt += gridDim.x) {
      f32x4 acc[4][4];
      ZERO_ACC(acc);
      int ll = tt >> 4, mt = (tt >> 3) & 1, nt = tt & 7;
      int m0 = mt * 128, n0 = nt * 128;
      gemm_main<false>((const u16*)(ws + OFF_MEMN) + ((size_t)ll * 256 + m0) * D_, D_, (const u16*)(ws + OFF_WKV) + ((size_t)ll * 1024 + n0) * D_,
                D_, D_, As, Bs, acc);
      if (nt < 4) {
        float* dst = (float*)(ws + OFF_KVMEM) + (size_t)ll * 256 * 512;
        EPI_LOOP({
          _Pragma("unroll") for (int r2 = 0; r2 < 4; ++r2) dst[(size_t)(m0 + mr + r2) * 512 + n0 + nc] = acc[i][j][r2];
        })
      } else {
        u16* dst = (u16*)(ws + OFF_VTMEM) + (size_t)(ll * 4 + (nt - 4)) * 128 * 256;
        EPI_LOOP({
          uint2 o;
          o.x = pack2(acc[i][j][0], acc[i][j][1]);
          o.y = pack2(acc[i][j][2], acc[i][j][3]);
          *(uint2*)(dst + (size_t)nc * 256 + m0 + mr) = o;
        })
      }
    }
  }
}

__device__ __forceinline__ void phase_gemm_mla(const Params p, int l, char* smem, int vb) {
  u16* As = (u16*)smem;
  u16* Bs = As + 128 * 64;
  char* ws = p.ws;
  const u16* P = (const u16*)(ws + OFF_P);
  const int nslots = tile_slots(14);
  for (int t = vb; t < nslots; t += gridDim.x) {
    f32x4 acc[4][4];
    ZERO_ACC(acc);
    int mt, nt;
    if (!tile_map(t, 14, mt, nt)) continue;
    int m0 = mt * 128;
    if (nt < 6) {
      int n0 = nt * 128;
      gemm_main<true>(P + (size_t)m0 * NINP + O_QL, NINP, (const u16*)(ws + OFF_WUQ) + ((size_t)l * 768 + n0) * 384, 384, 384, As, Bs, acc);
      float* dst = (float*)(ws + OFF_MQ);
      EPI_LOOP_T({
        *(float4*)(dst + (size_t)(m0 + mr) * 768 + n0 + nc) = make_float4(acc[i][j][0], acc[i][j][1], acc[i][j][2], acc[i][j][3]);
      })
    } else {
      nt -= 6;
      int n0 = nt * 128, h = nt >> 1;
      if ((nt & 1) == 0) {
        gemm_main<true>(P + (size_t)m0 * NINP + O_KVL, NINP, (const u16*)(ws + OFF_WUKV) + ((size_t)l * 1024 + n0) * 256, 256, 256, As, Bs, acc);
        float* dst = (float*)(ws + OFF_MKV);
        EPI_LOOP_T({
          *(float4*)(dst + (size_t)(m0 + mr) * 512 + h * 128 + nc) = make_float4(acc[i][j][0], acc[i][j][1], acc[i][j][2], acc[i][j][3]);
        })
      } else {
        gemm_main<false>(P + (size_t)m0 * NINP + O_KVL, NINP, (const u16*)(ws + OFF_WUKV) + ((size_t)l * 1024 + n0) * 256, 256, 256, As, Bs, acc);
        u16* dst = (u16*)(ws + OFF_VTM) + (size_t)h * 128 * S_;
        EPI_LOOP({
          uint2 o;
          o.x = pack2(acc[i][j][0], acc[i][j][1]);
          o.y = pack2(acc[i][j][2], acc[i][j][3]);
          *(uint2*)(dst + (size_t)nc * S_ + m0 + mr) = o;
        })
      }
    }
  }
}

__device__ __forceinline__ void phase_gemm_branch(const Params p, int l, char* smem, int vb) {
  u16* As = (u16*)smem;
  u16* Bs = As + 128 * 64;
  char* ws = p.ws;
  const u16* P = (const u16*)(ws + OFF_P);
  const int nslots = tile_slots(16);
  for (int t = vb; t < nslots; t += gridDim.x) {
    int mt, nt;
    if (!tile_map(t, 16, mt, nt)) continue;
    int m0 = mt * 128, n0 = nt * 128;
    f32x4 zacc[4][4];
    ZERO_ACC(zacc);
    for (int bi = 0; bi < 4; ++bi) {
      f32x4 acc[4][4];
      ZERO_ACC(acc);
      gemm_main1<true>((const u16*)(ws + OFF_YG) + ((size_t)bi * S_ + m0) * 512, 512,
                (const u16*)(ws + OFF_WB) + ((size_t)(l * 4 + bi) * 2048 + n0) * 512, 512, 512, As, Bs, acc);
      EPI_LOOP_T({
        const uint2 mg = *(const uint2*)(P + (size_t)(m0 + mr) * NINP + O_MG + bi * 2048 + n0 + nc);
        zacc[i][j][0] += sigmoidf_(lo2f(mg.x)) * acc[i][j][0];
        zacc[i][j][1] += sigmoidf_(hi2f(mg.x)) * acc[i][j][1];
        zacc[i][j][2] += sigmoidf_(lo2f(mg.y)) * acc[i][j][2];
        zacc[i][j][3] += sigmoidf_(hi2f(mg.y)) * acc[i][j][3];
      })
    }
    u16* dst = (u16*)(ws + OFF_Z);
    EPI_LOOP_T({
      uint2 o;
      o.x = pack2(zacc[i][j][0], zacc[i][j][1]);
      o.y = pack2(zacc[i][j][2], zacc[i][j][3]);
      *(uint2*)(dst + (size_t)(m0 + mr) * D_ + n0 + nc) = o;
    })
  }
}

__device__ __forceinline__ void phase_gemm_out(const Params p, int l, char* smem, int vb) {
  u16* As = (u16*)smem;
  u16* Bs = As + 128 * 64;
  char* ws = p.ws;
  const float* xin = (l == 0) ? (const float*)p.in[I_X] : (const float*)p.out;
  const int nslots = tile_slots(16);
  for (int t = vb; t < nslots; t += gridDim.x) {
    int mt, nt;
    if (!tile_map(t, 16, mt, nt)) continue;
    int m0 = mt * 128, n0 = nt * 128;
    f32x4 acc[4][4];
    ZERO_ACC(acc);
    gemm_main<true>((const u16*)(ws + OFF_Z) + (size_t)m0 * D_, D_, (const u16*)(ws + OFF_WO) + ((size_t)l * 2048 + n0) * D_, D_, D_, As, Bs,
              acc);
    EPI_LOOP_T({
      size_t idx = (size_t)(m0 + mr) * D_ + n0 + nc;
      float4 xv = *(const float4*)(xin + idx);
      *(float4*)(p.out + idx) = make_float4(xv.x + acc[i][j][0], xv.y + acc[i][j][1], xv.z + acc[i][j][2], xv.w + acc[i][j][3]);
    })
  }
}

__device__ __forceinline__ void seg_norm8(u16* ptr, bool active, int width, float inv_n, const float* g, float scale) {
  uint4 v = make_uint4(0, 0, 0, 0);
  if (active) v = *(const uint4*)ptr;
  float x[8] = {lo2f(v.x), hi2f(v.x), lo2f(v.y), hi2f(v.y), lo2f(v.z), hi2f(v.z), lo2f(v.w), hi2f(v.w)};
  float ss = 0.f;
#pragma unroll
  for (int i = 0; i < 8; ++i) ss += x[i] * x[i];
  for (int o = 1; o < width; o <<= 1) ss += __shfl_xor(ss, o);
  float rs = rsqrtf(ss * inv_n + 1e-6f) * scale;
  if (active) {
    float4 g0 = *(const float4*)g, g1 = *(const float4*)(g + 4);
    uint4 o;
    o.x = pack2(x[0] * rs * g0.x, x[1] * rs * g0.y);
    o.y = pack2(x[2] * rs * g0.z, x[3] * rs * g0.w);
    o.z = pack2(x[4] * rs * g1.x, x[5] * rs * g1.y);
    o.w = pack2(x[6] * rs * g1.z, x[7] * rs * g1.w);
    *(uint4*)ptr = o;
  }
}

template <bool RWONLY>
__device__ __forceinline__ void phase_prep(const Params p, int l, char* smem) {
  char* ws = p.ws;
  const int tid = ltid(), lane = tid & 63, w = tid >> 6;
  u16* P = (u16*)(ws + OFF_P);
  if (!RWONLY) {
    const float* dqg = (const float*)p.in[I_DQKG] + l * 128;
    const float* mqg = (const float*)p.in[I_MQKG] + l * 256;
    const float* qlg = (const float*)p.in[I_QLATG] + l * 384;
    const float* kvg = (const float*)p.in[I_KVLATG] + l * 256;
    for (int s = lbid() * 4 + w; s < S_; s += gridDim.x * 4) {
      u16* row = P + (size_t)s * NINP;
      seg_norm8(row + O_DQ + lane * 8, true, 8, 1.f / 64, dqg + (lane * 8) % 64, 0.125f * LOG2E);
      seg_norm8(row + O_DK + lane * 8, true, 8, 1.f / 64, dqg + 64 + (lane * 8) % 64, 1.f);
      seg_norm8(row + O_MQ + lane * 8, true, 16, 1.f / 128, mqg + (lane * 8) % 128, 0.08838834764831845f * LOG2E);
      seg_norm8(row + O_QL + (lane < 48 ? lane : 0) * 8, lane < 48, 64, 1.f / 384, qlg + (lane < 48 ? lane : 0) * 8, 1.f);
      seg_norm8(row + O_KVL + (lane < 32 ? lane : 0) * 8, lane < 32, 64, 1.f / 256, kvg + (lane < 32 ? lane : 0) * 8, 1.f);
    }
  }
  if (l == 0 && !RWONLY) {
    for (int sg = lbid() * 4 + w; sg < L_ * 256 * 4; sg += gridDim.x * 4) {
      int ll = sg >> 10, m = (sg >> 2) & 255, h = sg & 3;
      const float* src = (const float*)(ws + OFF_KVMEM) + ((size_t)ll * 256 + m) * 512 + h * 128;
      float a = src[lane], b = src[lane + 64];
      float ss = wave_sum(a * a + b * b);
      float rs = rsqrtf(ss * (1.f / 128) + 1e-6f);
      const float* g = (const float*)p.in[I_MQKG] + ll * 256 + 128;
      u16* dst = (u16*)(ws + OFF_KMEM) + ((size_t)(ll * 4 + h) * 256 + m) * 128;
      dst[lane] = f2bf(a * rs * g[lane]);
      dst[lane + 64] = f2bf(b * rs * g[lane + 64]);
    }
  }
  {
    float* ld = (float*)smem;
    const float* RWU = (const float*)(ws + OFF_RWU);
    const float* sh = (const float*)p.in[I_SHIFT] + (size_t)l * 3 * 1792;
    const float* wup = (const float*)p.in[I_WUP] + (size_t)l * 2 * 64 * 512;
    const float* aup = (const float*)p.in[I_AUP] + (size_t)l * 2 * 64 * 512;
    const float* w0 = (const float*)p.in[I_W0] + l * 1024;
    const float* a0 = (const float*)p.in[I_A0] + l * 1024;
    const float* kkp = (const float*)p.in[I_KK] + l * 512;
    const float* kap = (const float*)p.in[I_KA] + l * 512;
    const float* rkp = (const float*)p.in[I_RK] + l * 512;
    for (int tile = lbid(); tile < S_ / 8; tile += gridDim.x) {
      const int s0 = tile * 8;
      __syncthreads();
      {
        int c = 1536 + tid;
        float c0 = sh[c], c1 = sh[1792 + c], c2 = sh[2 * 1792 + c];
#pragma unroll
        for (int tk = 0; tk < 8; ++tk) {
          int s = s0 + tk;
          float um = s > 0 ? RWU[(size_t)(s - 1) * 1792 + c] : 0.f;
          float u0 = RWU[(size_t)s * 1792 + c];
          float up = s < S_ - 1 ? RWU[(size_t)(s + 1) * 1792 + c] : 0.f;
          float v = c0 * um + c1 * u0 + c2 * up;
          if (tid < 128) v = tanhf(v);
          ld[tk * 256 + tid] = v;
        }
      }
      __syncthreads();
      float acc[8][4][2];
#pragma unroll
      for (int a = 0; a < 8; ++a)
#pragma unroll
        for (int b = 0; b < 4; ++b) acc[a][b][0] = acc[a][b][1] = 0.f;
      for (int l4 = 0; l4 < 16; ++l4) {
        float wv[4][4][2];
#pragma unroll
        for (int ll = 0; ll < 4; ++ll) {
#pragma unroll
          for (int ch = 0; ch < 2; ++ch) {
            int c = tid + ch * 256;
            int li = l4 * 4 + ll;
            wv[0][ll][ch] = wup[(size_t)(0 * 64 + li) * 512 + c];
            wv[1][ll][ch] = wup[(size_t)(1 * 64 + li) * 512 + c];
            wv[2][ll][ch] = aup[(size_t)(0 * 64 + li) * 512 + c];
            wv[3][ll][ch] = aup[(size_t)(1 * 64 + li) * 512 + c];
          }
        }
#pragma unroll
        for (int tk = 0; tk < 8; ++tk) {
#pragma unroll
          for (int mat = 0; mat < 4; ++mat) {
            float4 d = *(const float4*)(ld + tk * 256 + mat * 64 + l4 * 4);
#pragma unroll
            for (int ch = 0; ch < 2; ++ch) {
              acc[tk][mat][ch] += d.x * wv[mat][0][ch] + d.y * wv[mat][1][ch] + d.z * wv[mat][2][ch] + d.w * wv[mat][3][ch];
            }
          }
        }
      }
#pragma unroll
      for (int ch = 0; ch < 2; ++ch) {
        const int c = tid + ch * 256;
        float shc[3][3];
#pragma unroll
        for (int q = 0; q < 3; ++q)
#pragma unroll
          for (int j = 0; j < 3; ++j) shc[q][j] = sh[j * 1792 + q * 512 + c];
        const float kkc = kkp[c], kac = kap[c], rkc = rkp[c];
        const float w0c0 = w0[c], w0c1 = w0[512 + c], a0c0 = a0[c], a0c1 = a0[512 + c];
        float um[3], u0[3];
#pragma unroll
        for (int q = 0; q < 3; ++q) {
          um[q] = s0 > 0 ? RWU[(size_t)(s0 - 1) * 1792 + q * 512 + c] : 0.f;
          u0[q] = RWU[(size_t)s0 * 1792 + q * 512 + c];
        }
#pragma unroll
        for (int tk = 0; tk < 8; ++tk) {
          const int s = s0 + tk;
          float rkv[3];
#pragma unroll
          for (int q = 0; q < 3; ++q) {
            float up = s < S_ - 1 ? RWU[(size_t)(s + 1) * 1792 + q * 512 + c] : 0.f;
            rkv[q] = shc[q][0] * um[q] + shc[q][1] * u0[q] + shc[q][2] * up;
            um[q] = u0[q];
            u0[q] = up;
          }
          float r = rkv[0], k = rkv[1], v = rkv[2];
          float kkr = k * kkc;
          float ss = wave_sum(kkr * kkr);
          float kk = kkr / fmaxf(sqrtf(ss), 1e-12f);
          float bsum = 0.f;
#pragma unroll
          for (int n = 0; n < 2; ++n) {
            float zw = (n ? w0c1 : w0c0) + acc[tk][n][ch];
            float za = (n ? a0c1 : a0c0) + acc[tk][2 + n][ch];
            float dec = __expf(-0.6065306597126334f * sigmoidf_(zw));
            float a = sigmoidf_(za);
            float kd = k * (1.f + (a - 1.f) * kac);
            float bb = kk * a;
            size_t o = ((size_t)n * S_ + s) * 512 + c;
            ((float*)(ws + OFF_SCW))[o] = dec;
            ((float*)(ws + OFF_SCKD))[o] = kd;
            ((float*)(ws + OFF_SCB))[o] = bb;
            bsum += r * kd * rkc;
          }
          size_t o1 = (size_t)s * 512 + c;
          ((float*)(ws + OFF_SCR))[o1] = r;
          ((float*)(ws + OFF_SCV))[o1] = v;
          ((float*)(ws + OFF_SCKK))[o1] = kk;
          float bon = wave_sum(bsum);
          if (lane == 0) ((float*)(ws + OFF_BONUS))[s * 8 + w + 4 * ch] = bon;
        }
      }
    }
  }
}

__device__ __forceinline__ void phase_mla_post(const Params p, int l, char* smem) {
  char* ws = p.ws;
  const int lane = ltid() & 63, w = ltid() >> 6;
  const float* ng = (const float*)p.in[I_NOPEG] + l * 256;
  const float* rg = (const float*)p.in[I_ROPEG] + l * 128;
  const int* pos = (const int*)p.in[I_POS];
  const float qscale = 0.07216878364870322f * LOG2E;
  const int fi = lane & 31;
  const float inv_freq = powf(10000.f, -(float)fi / 32.f);
  for (int s = lbid() * 4 + w; s < S_; s += gridDim.x * 4) {
    float ang = (float)pos[s] * inv_freq;
    float cs = cosf(ang), sn = sinf(ang);
    const float* mq = (const float*)(ws + OFF_MQ) + (size_t)s * 768;
    const float* mk = (const float*)(ws + OFF_MKV) + (size_t)s * 512;
    float kr1, kr2;
    {
      const u16* kr = (const u16*)(ws + OFF_P) + (size_t)s * NINP + O_KR;
      float t1 = lane < 32 ? bf2f(kr[fi]) : 0.f, t2 = lane < 32 ? bf2f(kr[32 + fi]) : 0.f;
      float ss = wave_sum(t1 * t1 + t2 * t2);
      float rs = rsqrtf(ss * (1.f / 64) + 1e-6f);
      t1 *= rs * rg[64 + fi];
      t2 *= rs * rg[64 + 32 + fi];
      kr1 = t1 * cs - t2 * sn;
      kr2 = t2 * cs + t1 * sn;
    }
#pragma unroll
    for (int h = 0; h < 4; ++h) {
      u16* qd = (u16*)(ws + OFF_QM) + ((size_t)h * S_ + s) * 192;
      u16* kd = (u16*)(ws + OFF_KM) + ((size_t)h * S_ + s) * 192;
      {
        const float2 ab = *(const float2*)(mq + h * 192 + 2 * lane);
        float a = ab.x, b = ab.y;
        float ss = wave_sum(a * a + b * b);
        float rs = rsqrtf(ss * (1.f / 128) + 1e-6f) * qscale;
        const float2 gq = *(const float2*)(ng + 2 * lane);
        *(unsigned*)(qd + 2 * lane) = pack2(a * rs * gq.x, b * rs * gq.y);
      }
      {
        float t1 = lane < 32 ? mq[h * 192 + 128 + fi] : 0.f, t2 = lane < 32 ? mq[h * 192 + 160 + fi] : 0.f;
        float ss = wave_sum(t1 * t1 + t2 * t2);
        float rs = rsqrtf(ss * (1.f / 64) + 1e-6f);
        t1 *= rs * rg[fi];
        t2 *= rs * rg[32 + fi];
        if (lane < 32) {
          qd[128 + fi] = f2bf((t1 * cs - t2 * sn) * qscale);
          qd[160 + fi] = f2bf((t2 * cs + t1 * sn) * qscale);
        }
      }
      {
        const float2 ab = *(const float2*)(mk + h * 128 + 2 * lane);
        float a = ab.x, b = ab.y;
        float ss = wave_sum(a * a + b * b);
        float rs = rsqrtf(ss * (1.f / 128) + 1e-6f);
        const float2 gk = *(const float2*)(ng + 128 + 2 * lane);
        *(unsigned*)(kd + 2 * lane) = pack2(a * rs * gk.x, b * rs * gk.y);
        if (lane < 32) {
          kd[128 + fi] = f2bf(kr1);
          kd[160 + fi] = f2bf(kr2);
        }
      }
    }
  }
}

template <int DQK, int NSUB>
__device__ __forceinline__ void attn_item(const u16* __restrict__ Q, int ldq, const u16* __restrict__ K, int ldk, const u16* __restrict__ Vt,
                          int ldv, int Skv, u16* __restrict__ O, int qb, bool hasBias, const float* __restrict__ relb, int head,
                          const int* __restrict__ pos, const int* __restrict__ kpmm, char* smem, const int* __restrict__ kposp,
                          float* __restrict__ ML) {
  constexpr int LDK = DQK;
  constexpr int SW = (DQK == 128) ? 15 : 7;
  constexpr int NKS = DQK / 32;
  constexpr int NKC = DQK / 32;
  u16* Ks = (u16*)smem;
  u16* Vs = (u16*)(smem + 25600);
  float* bt = (float*)(smem + 44032);
  int* kp = (int*)(smem + 45072);
  const int tid = ltid(), lane = tid & 63, w = tid >> 6, l15 = lane & 15, quad = lane >> 4;
  const int q0 = qb * (64 * NSUB) + w * (16 * NSUB);

  bf16x8 qf[NSUB][NKS];
#pragma unroll
  for (int sub = 0; sub < NSUB; ++sub)
#pragma unroll
    for (int ks = 0; ks < NKS; ++ks)
      qf[sub][ks] = *(const bf16x8*)(Q + (size_t)(q0 + sub * 16 + l15) * ldq + ks * 32 + quad * 8);

  int qp[2] = {0, 0};
  int qpmin = 0, qpmax = 0;
  if (hasBias) {
    qp[0] = pos[q0 + l15];
    qp[1] = pos[q0 + (NSUB - 1) * 16 + l15];
    qpmin = min(qp[0], qp[1]);
    qpmax = max(qp[0], qp[1]);
#pragma unroll
    for (int o = 8; o >= 1; o >>= 1) {
      qpmin = min(qpmin, __shfl_xor(qpmin, o));
      qpmax = max(qpmax, __shfl_xor(qpmax, o));
    }
  }
  __syncthreads();
  if (hasBias) {
    for (int i = tid; i < 257; i += 256) bt[i] = relb[t5_bucket(i - 128) * 4 + head] * LOG2E;
  }
  u32x4 kreg[NKC], vreg[4];
#pragma unroll
  for (int i = 0; i < NKC; ++i) {
    int c = tid + i * 256, r = c / (DQK / 8), kc = c % (DQK / 8);
    kreg[i] = *(const u32x4*)(K + (size_t)r * ldk + kc * 8);
  }
#pragma unroll
  for (int i = 0; i < 4; ++i) {
    int c = tid + i * 256, r = c >> 3, kc = c & 7;
    vreg[i] = *(const u32x4*)(Vt + (size_t)r * ldv + kc * 8);
  }
#pragma unroll
  for (int i = 0; i < NKC; ++i) {
    int c = tid + i * 256, r = c / (DQK / 8), kc = c % (DQK / 8);
    *(u32x4*)(Ks + r * LDK + ((kc ^ (r & SW)) * 8)) = kreg[i];
  }
#pragma unroll
  for (int i = 0; i < 4; ++i) {
    int c = tid + i * 256, r = c >> 3, kc = c & 7;
    *(u32x4*)(Vs + r * 72 + kc * 8) = vreg[i];
  }
  if (hasBias && tid < 64) kp[tid] = kposp[tid];
  __syncthreads();

  f32x4 oacc[8][NSUB];
#pragma unroll
  for (int et = 0; et < 8; ++et)
#pragma unroll
    for (int sub = 0; sub < NSUB; ++sub) oacc[et][sub] = (f32x4){0.f, 0.f, 0.f, 0.f};
  float mrow[2] = {-1e30f, -1e30f}, lrow[2] = {0.f, 0.f};

  const int ntiles = Skv / 64;
  constexpr bool KDMA = (DQK == 192);
  int koff[6];
#pragma unroll
  for (int i = 0; i < 6; ++i) {
    const int o = (w + 4 * i) * 1024 + lane * 16;
    const int r = o / (DQK * 2), pos = (o % (DQK * 2)) >> 4;
    koff[i] = r * ldk + ((pos ^ (r & SW)) * 8);
  }
  for (int t = 0; t < ntiles; ++t) {
    const bool more = (t + 1 < ntiles);
    const int k1 = (t + 1) * 64;
    constexpr bool EARLY = (DQK != 128);
    if (EARLY && more) {
      if (!KDMA) {
#pragma unroll
        for (int i = 0; i < NKC; ++i) {
          int c = tid + i * 256, r = c / (DQK / 8), kc = c % (DQK / 8);
          kreg[i] = *(const u32x4*)(K + (size_t)(k1 + r) * ldk + kc * 8);
        }
      }
#pragma unroll
      for (int i = 0; i < 4; ++i) {
        int c = tid + i * 256, r = c >> 3, kc = c & 7;
        vreg[i] = *(const u32x4*)(Vt + (size_t)r * ldv + k1 + kc * 8);
      }
    }
    f32x4 sacc[4][NSUB];
#pragma unroll
    for (int kt = 0; kt < 4; ++kt)
#pragma unroll
      for (int sub = 0; sub < NSUB; ++sub) sacc[kt][sub] = (f32x4){0.f, 0.f, 0.f, 0.f};
#pragma unroll
    for (int ks = 0; ks < NKS; ++ks) {
#pragma unroll
      for (int kt = 0; kt < 4; ++kt) {
        bf16x8 kf = *(const bf16x8*)(Ks + (kt * 16 + l15) * LDK + (((ks * 4 + quad) ^ (l15 & SW)) * 8));
#pragma unroll
        for (int sub = 0; sub < NSUB; ++sub)
          sacc[kt][sub] = __builtin_amdgcn_mfma_f32_16x16x32_bf16(kf, qf[sub][ks], sacc[kt][sub], 0, 0, 0);
      }
      __builtin_amdgcn_sched_barrier(0);
    }
    float cb = 0.f;
    if (hasBias) {
      int kmn = kpmm[t * 2], kmx = kpmm[t * 2 + 1];
      if (kmn - qpmax >= 128 || kmx - qpmin <= -128) {
        cb = (kmn - qpmax >= 128) ? bt[256] : bt[0];
      } else {
#pragma unroll
        for (int kt = 0; kt < 4; ++kt) {
#pragma unroll
          for (int j = 0; j < 4; ++j) {
            int kpos = kp[kt * 16 + quad * 4 + j];
#pragma unroll
            for (int sub = 0; sub < NSUB; ++sub) {
              int rel = kpos - qp[sub];
              rel = max(-128, min(128, rel));
              sacc[kt][sub][j] += bt[rel + 128];
            }
          }
        }
      }
    }
    LBAR();
    if (more) {
      if (!EARLY) {
#pragma unroll
        for (int i = 0; i < NKC; ++i) {
          int c = tid + i * 256, r = c / (DQK / 8), kc = c % (DQK / 8);
          kreg[i] = *(const u32x4*)(K + (size_t)(k1 + r) * ldk + kc * 8);
        }
#pragma unroll
        for (int i = 0; i < 4; ++i) {
          int c = tid + i * 256, r = c >> 3, kc = c & 7;
          vreg[i] = *(const u32x4*)(Vt + (size_t)r * ldv + k1 + kc * 8);
        }
      }
      if (hasBias && tid < 64) kp[tid] = kposp[k1 + tid];
      if (KDMA) {
#pragma unroll
        for (int i = 0; i < 6; ++i)
          __builtin_amdgcn_global_load_lds((const unsigned*)(K + (size_t)k1 * ldk + koff[i]),
                                           (unsigned*)((char*)Ks + (w + 4 * i) * 1024), 16, 0, 0);
      }
    }
    __builtin_amdgcn_sched_barrier(0);
    bf16x8 pf[NSUB][2];
#pragma unroll
    for (int sub = 0; sub < NSUB; ++sub) {
      float mx = -1e30f;
#pragma unroll
      for (int kt = 0; kt < 4; ++kt)
#pragma unroll
        for (int j = 0; j < 4; ++j) mx = fmaxf(mx, sacc[kt][sub][j]);
      mx = fmaxf(mx, __shfl_xor(mx, 16));
      mx = fmaxf(mx, __shfl_xor(mx, 32));
      float mnew = fmaxf(mrow[sub], mx + cb);
      float alpha = __builtin_amdgcn_exp2f(mrow[sub] - mnew);
      mrow[sub] = mnew;
      const float off = cb - mnew;
      float ps = 0.f;
      float pv[4][4];
#pragma unroll
      for (int kt = 0; kt < 4; ++kt)
#pragma unroll
        for (int j = 0; j < 4; ++j) {
          pv[kt][j] = __builtin_amdgcn_exp2f(sacc[kt][sub][j] + off);
          ps += pv[kt][j];
        }
      lrow[sub] = lrow[sub] * alpha + ps;
#pragma unroll
      for (int kb = 0; kb < 2; ++kb) {
        u32x4 pu = {pack2(pv[2 * kb][0], pv[2 * kb][1]), pack2(pv[2 * kb][2], pv[2 * kb][3]),
                    pack2(pv[2 * kb + 1][0], pv[2 * kb + 1][1]), pack2(pv[2 * kb + 1][2], pv[2 * kb + 1][3])};
        pf[sub][kb] = __builtin_bit_cast(bf16x8, pu);
      }
      if (__builtin_amdgcn_ballot_w64(alpha != 1.f) != 0) {
#pragma unroll
        for (int et = 0; et < 8; ++et) {
          oacc[et][sub][0] *= alpha; oacc[et][sub][1] *= alpha;
          oacc[et][sub][2] *= alpha; oacc[et][sub][3] *= alpha;
        }
      }
    }
#pragma unroll
    for (int et = 0; et < 8; ++et) {
#pragma unroll
      for (int kb = 0; kb < 2; ++kb) {
        const u16* vp = Vs + (et * 16 + l15) * 72 + kb * 32 + quad * 4;
        u32x2 a0 = *(const u32x2*)vp;
        u32x2 a1 = *(const u32x2*)(vp + 16);
        u32x4 cu = {a0.x, a0.y, a1.x, a1.y};
        bf16x8 vb = __builtin_bit_cast(bf16x8, cu);
#pragma unroll
        for (int sub = 0; sub < NSUB; ++sub)
          oacc[et][sub] = __builtin_amdgcn_mfma_f32_16x16x32_bf16(vb, pf[sub][kb], oacc[et][sub], 0, 0, 0);
      }
      if (et & 1) __builtin_amdgcn_sched_barrier(0);
    }
    if (more) {
      if (KDMA) {
        asm volatile("s_waitcnt vmcnt(0)" ::: "memory");
      } else {
#pragma unroll
        for (int i = 0; i < NKC; ++i) {
          int c = tid + i * 256, r = c / (DQK / 8), kc = c % (DQK / 8);
          *(u32x4*)(Ks + r * LDK + ((kc ^ (r & SW)) * 8)) = kreg[i];
        }
      }
    }
    LBAR();
    if (more) {
#pragma unroll
      for (int i = 0; i < 4; ++i) {
        int c = tid + i * 256, r = c >> 3, kc = c & 7;
        *(u32x4*)(Vs + r * 72 + kc * 8) = vreg[i];
      }
    }
  }
#pragma unroll
  for (int sub = 0; sub < NSUB; ++sub) {
    float lt = lrow[sub];
    lt += __shfl_xor(lt, 16);
    lt += __shfl_xor(lt, 32);
    float inv = 1.f / lt;
    if (ML) {
      inv = 1.f;
      if (quad == 0) *(float2*)(ML + (size_t)(q0 + sub * 16 + l15) * 2) = make_float2(mrow[sub], lt);
    }
    u16* orow = O + (size_t)(q0 + sub * 16 + l15) * 128;
#pragma unroll
    for (int et = 0; et < 8; ++et) {
      uint2 o;
      o.x = pack2(oacc[et][sub][0] * inv, oacc[et][sub][1] * inv);
      o.y = pack2(oacc[et][sub][2] * inv, oacc[et][sub][3] * inv);
      *(uint2*)(orow + et * 16 + quad * 4) = o;
    }
  }
}

#define QB2 (128 / ATT_NSUB)
#define SC_CH 16
#define SC_STEPF 336
typedef float f32x2 __attribute__((ext_vector_type(2)));
struct ScStep { f32x2 kk0, kk1, w0, w1, b0, b1, k0, k1, r0, r1; float v; };
__device__ __forceinline__ ScStep sc_ld(const float* sb, int jg4, int vi) {
  ScStep x;
  f32x4 t;
  t = *(const f32x4*)(sb + jg4);       x.kk0 = t.xy; x.kk1 = t.zw;
  t = *(const f32x4*)(sb + 64 + jg4);  x.w0 = t.xy;  x.w1 = t.zw;
  t = *(const f32x4*)(sb + 128 + jg4); x.b0 = t.xy;  x.b1 = t.zw;
  t = *(const f32x4*)(sb + 192 + jg4); x.k0 = t.xy;  x.k1 = t.zw;
  t = *(const f32x4*)(sb + 256 + jg4); x.r0 = t.xy;  x.r1 = t.zw;
  x.v = sb[320 + vi];
  return x;
}
__device__ __forceinline__ void scan_unit(const Params p, int u, char* smem) {
  char* ws = p.ws;
  const int tid = ltid(), lane = tid & 63, w = tid >> 6;
  const int chain = u >> 2, rg = u & 3, n = chain >> 3, h = chain & 7;
  const int jg = lane & 15, rw = lane >> 4;
  float* buf = (float*)smem;
  const float* a0 = (const float*)(ws + OFF_SCKK) + h * 64;
  const float* a1 = (const float*)(ws + OFF_SCW) + (size_t)n * S_ * 512 + h * 64;
  const float* a2 = (const float*)(ws + OFF_SCB) + (size_t)n * S_ * 512 + h * 64;
  const float* a3 = (const float*)(ws + OFF_SCKD) + (size_t)n * S_ * 512 + h * 64;
  const float* a4 = (const float*)(ws + OFF_SCR) + h * 64;
  const float* vsrc = (const float*)(ws + OFF_SCV) + h * 64 + rg * 16;
  float* ydst = (float*)(ws + OFF_YS) + (size_t)n * S_ * 512 + h * 64 + rg * 16 + w * 4 + rw;

  const float* pb[6];
  int pst[6], pf[6];
#pragma unroll
  for (int i = 0; i < 6; ++i) {
    int f = min(tid + i * 256, SC_CH * 84 - 1);
    int st = f / 84, q = f % 84;
    int a = q >> 4;
    const float* base = a == 0 ? a0 : a == 1 ? a1 : a == 2 ? a2 : a == 3 ? a3 : a == 4 ? a4 : vsrc;
    pb[i] = base + (a < 5 ? (q & 15) * 4 : (q - 80) * 4);
    pst[i] = st;
    pf[i] = f * 4;
  }
  const int sdir = n ? -1 : 1, sbase = n ? (S_ - 1) : 0;
  const int nch = S_ / SC_CH;
  unsigned po[6];
#pragma unroll
  for (int i = 0; i < 6; ++i)
    po[i] = (unsigned)((const char*)(pb[i] + (size_t)(sbase + sdir * pst[i]) * 512) - (const char*)ws);
  const unsigned yo = (unsigned)((const char*)(ydst + (size_t)(sbase + sdir * jg) * 512) - (const char*)ws);
  const int cstep = sdir * SC_CH * 512 * 4;
  f32x4 lregA[6], lregB[6];
#define SC_LOAD(R, CH)                                                            \
  {                                                                               \
    const unsigned d_ = (unsigned)(min((CH), nch - 1) * cstep);                   \
    _Pragma("unroll") for (int i = 0; i < 6; ++i)                                 \
      R[i] = *(const f32x4*)((const char*)ws + (unsigned)(po[i] + d_));           \
  }
#define SC_STORE(R, B)                                                \
  _Pragma("unroll") for (int i = 0; i < 6; ++i) *(f32x4*)(buf + (B) * SC_CH * SC_STEPF + pf[i]) = R[i];

  f32x2 sA = {0.f, 0.f}, sB = {0.f, 0.f};
  const int jg4 = jg * 4, vi = w * 4 + rw;
#define SC_COMPUTE(C, B)                                                              \
  {                                                                                   \
    const float* cb = buf + (B) * SC_CH * SC_STEPF;                                   \
    float ykeep = 0.f;                                                                \
    ScStep cur = sc_ld(cb, jg4, vi);                                                  \
    ScStep nx1 = sc_ld(cb + SC_STEPF, jg4, vi);                                       \
    _Pragma("unroll") for (int st = 0; st < SC_CH; ++st) {                            \
      ScStep nx2 = nx1;                                                               \
      if (st + 2 < SC_CH) nx2 = sc_ld(cb + (st + 2) * SC_STEPF, jg4, vi);             \
      f32x2 sa2 = sA * cur.kk0 + sB * cur.kk1;                                        \
      f32x2 vv = {cur.v, cur.v};                                                      \
      f32x2 uA = sA * cur.w0 + vv * cur.k0;                                           \
      f32x2 uB = sB * cur.w1 + vv * cur.k1;                                           \
      float sa = row16_sum(sa2.x + sa2.y);                                            \
      f32x2 nsa = {-sa, -sa};                                                         \
      sA = uA + nsa * cur.b0;                                                         \
      sB = uB + nsa * cur.b1;                                                         \
      f32x2 y2 = sA * cur.r0 + sB * cur.r1;                                           \
      float y = row16_sum(y2.x + y2.y);                                               \
      ykeep = (jg == st) ? y : ykeep;                                                 \
      cur = nx1;                                                                      \
      nx1 = nx2;                                                                      \
    }                                                                                 \
    *(float*)((char*)ws + (unsigned)(yo + (unsigned)((C) * cstep))) = ykeep;          \
  }

  __syncthreads();
  __builtin_amdgcn_s_setprio(3);
  SC_LOAD(lregA, 0);
  SC_STORE(lregA, 0);
  SC_LOAD(lregB, 1);
  __syncthreads();
  for (int c = 0; c < nch; c += 2) {
    SC_LOAD(lregA, c + 2);
    SC_COMPUTE(c, 0);
    SC_STORE(lregB, 1);
    LBAR();
    SC_LOAD(lregB, c + 3);
    SC_COMPUTE(c + 1, 1);
    SC_STORE(lregA, 0);
    LBAR();
  }
  __builtin_amdgcn_s_setprio(0);
}

template <int ATM>
__device__ __forceinline__ void phase_attn_scan(const Params p, int l, char* smem) {
  char* ws = p.ws;
  __shared__ int s_item;
  if (ATM & 8) for (int u = lbid(); u < 64; u += gridDim.x) scan_unit(p, u, smem);
  if ((ATM & 8) && (DUP_MASK & 2)) for (int u = lbid(); u < 64; u += gridDim.x) scan_unit(p, u, smem);
  int* cnt = (int*)(ws + OFF_CNT) + l * 4;
  const int* pos = (const int*)p.in[I_POS];
  const int* kpmm = (const int*)(ws + OFF_KPMM);
  const u16* P = (const u16*)(ws + OFF_P);
  u16* OB = (u16*)(ws + OFF_OB);
#define NEXT_ITEM(CI, LIMIT)                                   \
    __syncthreads();                                           \
    if (ltid() == 0) s_item = atomicAdd(cnt + (CI), 1);   \
    __syncthreads();                                           \
    const int it = s_item;                                     \
    if (it >= (LIMIT)) break;
  u16* OB2 = (u16*)(ws + OFF_OB2);
  float* MLb = (float*)(ws + OFF_ML);
  if (ATM & 1) while (true) {
    NEXT_ITEM(0, 512)
    int hh = it >> 6, qb = it & 63, h = hh >> 1, half = hh & 1;
    const int kv0 = half * (S_ / 2);
    attn_item<192, 2>((const u16*)(ws + OFF_QM) + (size_t)h * S_ * 192, 192,
                      (const u16*)(ws + OFF_KM) + ((size_t)h * S_ + kv0) * 192, 192,
                      (const u16*)(ws + OFF_VTM) + (size_t)h * 128 * S_ + kv0, S_, S_ / 2,
                      (half ? OB2 : OB) + (size_t)(8 + h) * S_ * 128, qb, false, nullptr, 0, pos, kpmm, smem, pos,
                      MLb + ((size_t)half * 16 + 8 + h) * S_ * 2);
  }
  if (ATM & 2) while (true) {
    NEXT_ITEM(1, 16 * QB2)
    int pp = it / QB2, qb = it % QB2, pr = pp >> 1, half = pp & 1, h = pr >> 1, hf = pr & 1;
    const int kv0 = half * (S_ / 2);
    attn_item<64, ATT_NSUB>(P + O_DQ + h * 128 + hf * 64, NINP, P + (size_t)kv0 * NINP + O_DK + h * 128 + hf * 64, NINP,
                            (const u16*)(ws + OFF_VTD) + (size_t)h * 128 * S_ + kv0, S_, S_ / 2,
                            (half ? OB2 : OB) + (size_t)pr * S_ * 128, qb, true, (const float*)p.in[I_RELB], h, pos,
                            kpmm + (kv0 / 64) * 2, smem, pos + kv0, MLb + ((size_t)half * 16 + pr) * S_ * 2);
  }
  if (ATM & 4) while (true) {
    NEXT_ITEM(2, 4 * QB2)
    int h = it / QB2, qb = it % QB2;
    attn_item<128, ATT_NSUB>(P + O_MQ + h * 128, NINP, (const u16*)(ws + OFF_KMEM) + (size_t)(l * 4 + h) * 256 * 128, 128,
                             (const u16*)(ws + OFF_VTMEM) + (size_t)(l * 4 + h) * 128 * 256, 256, 256,
                             OB + (size_t)(12 + h) * S_ * 128, qb, false, nullptr, 0, pos, kpmm, smem, pos, nullptr);
  }
}

__device__ __forceinline__ void phase_combine(const Params p, int l, char* smem) {
  char* ws = p.ws;
  const int lane = ltid() & 63, w = ltid() >> 6;
  const float lam_init = 0.8f - 0.6f * expf(-0.3f * (float)l);
  float lam;
  {
    const float* lq = (const float*)p.in[I_DLAM] + l * 256;
    float a = wave_sum(lq[lane] * lq[64 + lane]);
    float b = wave_sum(lq[128 + lane] * lq[192 + lane]);
    lam = expf(a) - expf(b) + lam_init;
  }
  const float* gng = (const float*)p.in[I_GNG] + l * 512;
  const float* gnb = (const float*)p.in[I_GNB] + l * 512;
  const float* subg = (const float*)p.in[I_DSUBG] + l * 128;
  const u16* P = (const u16*)(ws + OFF_P);
  const float* YS = (const float*)(ws + OFF_YS);
  const u16* OB = (const u16*)(ws + OFF_OB);
  const u16* OB2c = (const u16*)(ws + OFF_OB2);
  const float* MLp = (const float*)(ws + OFF_ML);
  u16* YG = (u16*)(ws + OFF_YG);
  for (int s = lbid() * 4 + w; s < S_; s += gridDim.x * 4) {
    const u16* grow = P + (size_t)s * NINP + O_G;
#pragma unroll
    for (int hp = 0; hp < 4; ++hp) {
      const int c = hp * 128 + 2 * lane, h = hp * 2 + (lane >> 5);
      const float2 ya = *(const float2*)(YS + (size_t)s * 512 + c);
      const float2 yb = *(const float2*)(YS + ((size_t)S_ + s) * 512 + c);
      float y0 = ya.x + yb.x, y1 = ya.y + yb.y;
      float sm = y0 + y1;
#pragma unroll
      for (int o = 16; o >= 1; o >>= 1) sm += __shfl_xor(sm, o);
      const float mu = sm * (1.f / 64);
      const float d0 = y0 - mu, d1 = y1 - mu;
      float vs = d0 * d0 + d1 * d1;
#pragma unroll
      for (int o = 16; o >= 1; o >>= 1) vs += __shfl_xor(vs, o);
      const float rstd = rsqrtf(vs * (1.f / 64) + 64e-5f);
      const float2 gg = *(const float2*)(gng + c), gb = *(const float2*)(gnb + c);
      const float bon = ((const float*)(ws + OFF_BONUS))[s * 8 + h];
      const float2 vv = *(const float2*)((const float*)(ws + OFF_SCV) + (size_t)s * 512 + c);
      float o0 = d0 * rstd * gg.x + gb.x + bon * vv.x;
      float o1 = d1 * rstd * gg.y + gb.y + bon * vv.y;
      const unsigned gt = *(const unsigned*)(grow + c);
      const float g0 = lo2f(gt), g1 = hi2f(gt);
      *(unsigned*)(YG + (size_t)s * 512 + c) = pack2(o0 * g0 * sigmoidf_(g0), o1 * g1 * sigmoidf_(g1));
    }
#define MERGE_LOAD(PR, A, B)                                                                   \
    {                                                                                          \
      const float2 ml0 = *(const float2*)(MLp + ((size_t)(PR) * S_ + s) * 2);                  \
      const float2 ml1 = *(const float2*)(MLp + ((size_t)(16 + (PR)) * S_ + s) * 2);           \
      const float mm = fmaxf(ml0.x, ml1.x);                                                    \
      const float w0 = __builtin_amdgcn_exp2f(ml0.x - mm), w1 = __builtin_amdgcn_exp2f(ml1.x - mm); \
      const float inv = 1.f / (w0 * ml0.y + w1 * ml1.y);                                       \
      const unsigned q0 = *(const unsigned*)(OB + ((size_t)(PR) * S_ + s) * 128 + 2 * lane);   \
      const unsigned q1 = *(const unsigned*)(OB2c + ((size_t)(PR) * S_ + s) * 128 + 2 * lane); \
      A = (w0 * lo2f(q0) + w1 * lo2f(q1)) * inv;                                               \
      B = (w0 * hi2f(q0) + w1 * hi2f(q1)) * inv;                                               \
    }
#pragma unroll
    for (int h = 0; h < 4; ++h) {
      float a1, b1, a2, b2;
      MERGE_LOAD(h * 2, a1, b1)
      MERGE_LOAD(h * 2 + 1, a2, b2)
      float a = a1 - lam * a2, b = b1 - lam * b2;
      float ss = wave_sum(a * a + b * b);
      float rs = rsqrtf(ss * (1.f / 128) + 1e-6f) * (1.f - lam_init);
      const unsigned gg = *(const unsigned*)(grow + 512 + h * 128 + 2 * lane);
      float g0 = lo2f(gg), g1 = hi2f(gg);
      const float2 sg = *(const float2*)(subg + 2 * lane);
      u16* dst = YG + ((size_t)S_ + s) * 512 + h * 128;
      *(unsigned*)(dst + 2 * lane) = pack2(a * rs * sg.x * g0 * sigmoidf_(g0), b * rs * sg.y * g1 * sigmoidf_(g1));
    }
#pragma unroll
    for (int br = 2; br < 4; ++br) {
#pragma unroll
      for (int h = 0; h < 4; ++h) {
        float oa, ob;
        if (br == 2) {
          MERGE_LOAD(8 + h, oa, ob)
        } else {
          const unsigned o = *(const unsigned*)(OB + ((size_t)(12 + h) * S_ + s) * 128 + 2 * lane);
          oa = lo2f(o);
          ob = hi2f(o);
        }
        const unsigned gg = *(const unsigned*)(grow + br * 512 + h * 128 + 2 * lane);
        float g0 = lo2f(gg), g1 = hi2f(gg);
        u16* dst = YG + ((size_t)br * S_ + s) * 512 + h * 128;
        *(unsigned*)(dst + 2 * lane) = pack2(oa * g0 * sigmoidf_(g0), ob * g1 * sigmoidf_(g1));
      }
    }
#undef MERGE_LOAD
  }
}

#define XB_TMO      128
#define XB_XCNT(j)  (256  + 64 * (j))
#define XB_XSUB(j)  (1280 + 64 * (j))
#define XB_XGEN(j)  (2304 + 64 * (j))
#define XB_TOP      3328
#define XB_TOPGEN   3392
#define XCD_BAR_WORDS 3456
#define XB_SPIN_CAP (1u << 22)
#define LAS __attribute__((address_space(3)))
__device__ __forceinline__ unsigned xb_ld(unsigned* p)              { return __hip_atomic_load(p, __ATOMIC_RELAXED, __HIP_MEMORY_SCOPE_AGENT); }
__device__ __forceinline__ unsigned xb_add(unsigned* p, unsigned v) { return __hip_atomic_fetch_add(p, v, __ATOMIC_RELAXED, __HIP_MEMORY_SCOPE_AGENT); }
__device__ __forceinline__ unsigned xb_xcc_id() { return (unsigned)__builtin_amdgcn_s_getreg((3 << 11) | 20) & 0xFu; }
#define XB_SPIN(cond, bar) do { unsigned _sp = 0; while (cond) { __builtin_amdgcn_s_sleep(1); \
    if ((++_sp & 255u) == 0u) { if (xb_ld(&(bar)[XB_TMO])) break; if (_sp > XB_SPIN_CAP) { atomicAdd(&(bar)[XB_TMO], 1u); break; } } } } while (0)
struct XcdBarrier { unsigned* bar; unsigned x; volatile LAS unsigned* st; };
__device__ __forceinline__ XcdBarrier xcd_barrier_post(unsigned* bar, volatile LAS unsigned* st) {
  XcdBarrier b; b.bar = bar; b.x = xb_xcc_id(); b.st = st;
  if (threadIdx.x == 0) (void)xb_add(&bar[XB_XCNT(b.x)], 1u);
  return b;
}
__device__ __forceinline__ void xcd_barrier_complete(unsigned* bar, unsigned x, unsigned& nloc, unsigned& nx) {
  const unsigned G = gridDim.x * gridDim.y * gridDim.z;
  unsigned sum, cnt, mine, sp = 0u;
  for (;;) {
    sum = 0u; cnt = 0u; mine = 0u;
#pragma unroll
    for (unsigned j = 0; j < 16; ++j) { const unsigned c = xb_ld(&bar[XB_XCNT(j)]); sum += c; cnt += (c > 0u) ? 1u : 0u; mine = (j == x) ? c : mine; }
    if (sum == G) break;
    __builtin_amdgcn_s_sleep(1);
    if ((++sp & 255u) == 0u) { if (xb_ld(&bar[XB_TMO])) break; if (sp > XB_SPIN_CAP) { atomicAdd(&bar[XB_TMO], 1u); break; } }
  }
  nloc = mine > 0u ? mine : 1u; nx = cnt > 0u ? cnt : 1u;
}
__device__ __forceinline__ void xcd_barrier(const XcdBarrier& b) {
  asm volatile("s_waitcnt vmcnt(0)" ::: "memory");
  __syncthreads();
  if (threadIdx.x == 0) {
    unsigned* bar = b.bar;
    __builtin_amdgcn_s_waitcnt(0);
    unsigned nloc = b.st[0], nx = b.st[1];
    if (nloc == 0u) { xcd_barrier_complete(bar, b.x, nloc, nx); b.st[0] = nloc; b.st[1] = nx; }
    const unsigned old = xb_add(&bar[XB_XSUB(b.x)], 1u);
    const unsigned gen = old / nloc;
    if (old + 1u == (gen + 1u) * nloc) {
      __builtin_amdgcn_fence(__ATOMIC_RELEASE, "agent");
      asm volatile("s_waitcnt vmcnt(0)" ::: "memory");
      const unsigned og = xb_add(&bar[XB_TOP], 1u);
      const unsigned tg = og / nx;
      if (og + 1u == (tg + 1u) * nx) xb_add(&bar[XB_TOPGEN], 1u);
      else XB_SPIN(xb_ld(&bar[XB_TOPGEN]) == tg, bar);
      __builtin_amdgcn_fence(__ATOMIC_ACQUIRE, "agent");
      xb_add(&bar[XB_XGEN(b.x)], 1u);
      asm volatile("s_waitcnt vmcnt(0)" ::: "memory");
    } else {
      XB_SPIN(xb_ld(&bar[XB_XGEN(b.x)]) == gen, bar);
      __builtin_amdgcn_fence(__ATOMIC_ACQUIRE, "agent");
      asm volatile("s_waitcnt vmcnt(0)" ::: "memory");
    }
  }
  __syncthreads();
}

#define N_PHASES (1 + 9 * L_)

__global__ void __launch_bounds__(256, 2) mega(Params p, int ph_lo, int ph_hi) {
  __shared__ __attribute__((aligned(16))) char smem[SMEM_BYTES];
  cg::grid_group grid = cg::this_grid();
  __shared__ uint4 xb_words;
  if (threadIdx.x == 0) xb_words = make_uint4(0u, 0u, 0u, 0u);
  __syncthreads();
  XcdBarrier xb = xcd_barrier_post((unsigned*)(p.ws + OFF_BAR), (volatile LAS unsigned*)&xb_words);
  __shared__ int s_vbid, s_cand;
  if (threadIdx.x == 0) {
    int my_j = (int)xb_add((unsigned*)(p.ws + OFF_BAR) + 8 * xb.x, 1u);
    s_cand = my_j * 8 + (int)xb.x;
    s_vbid = blockIdx.x;
  }
#define VB s_vbid
  for (int ph = ph_lo; ph < ph_hi; ++ph) {
    if (ph == 0) {
      if (PH_MASK & 1) phase_w(p, smem);
    } else {
      int l = (ph - 1) / 9, sp = (ph - 1) % 9;
      switch (sp) {
        case 0: if (PH_MASK & 2) phase_gemm_in(p, l, smem, VB);
          if (DUP_MASK & 1) { __syncthreads(); phase_gemm_in(p, l, smem, VB); }
          break;
        case 1: if (PH_MASK & 4) phase_prep<false>(p, l, smem);
          if (DUP_MASK & 256) { __syncthreads(); phase_prep<true>(p, l, smem); }
          break;
        case 2: if (PH_MASK & 8) phase_gemm_mla(p, l, smem, VB);
          if (DUP_MASK & 16) { __syncthreads(); phase_gemm_mla(p, l, smem, VB); }
          break;
        case 3: if (PH_MASK & 16) phase_mla_post(p, l, smem);
          if (DUP_MASK & 32) { __syncthreads(); phase_mla_post(p, l, smem); }
          break;
        case 4: if (PH_MASK & 32) phase_attn_scan<AT_MASK>(p, l, smem); break;
        case 5: if (PH_MASK & 64) phase_combine(p, l, smem);
          if (DUP_MASK & 64) { __syncthreads(); phase_combine(p, l, smem); }
          break;
        case 6: if (PH_MASK & 128) phase_gemm_branch(p, l, smem, VB);
          if (DUP_MASK & 4) { __syncthreads(); phase_gemm_branch(p, l, smem, VB); }
          break;
        case 7: if (PH_MASK & 256) phase_gemm_out(p, l, smem, VB); break;
        case 8:
          if (l + 1 < L_) rms_rows<true>((const float*)p.out, S_, (const float*)p.in[I_NORMG] + (l + 1) * D_, (u16*)(p.ws + OFF_H));
          if ((DUP_MASK & 128) && l + 1 < L_) rms_rows<true>((const float*)p.out, S_, (const float*)p.in[I_NORMG] + (l + 1) * D_, (u16*)(p.ws + OFF_H));
          break;
      }
    }
#undef VB
    if (ph + 1 < ph_hi) {
      if (ph == ph_lo) {
        if (ph_hi < 0) grid.sync();
        xcd_barrier(xb);
        if (threadIdx.x == 0 && gridDim.x == 512) {
          bool ok = true;
          for (int j = 0; j < 8; ++j) ok = ok && (xb_ld((unsigned*)(p.ws + OFF_BAR) + 8 * j) == 64u);
          if (ok && xb.x < 8u) s_vbid = s_cand;
        }
        __syncthreads();
      } else xcd_barrier(xb);
    }
  }
}

template <int SP, int ATM>
__global__ void __launch_bounds__(256, 2) k_phase(Params p, int l) {
  __shared__ __attribute__((aligned(16))) char smem[SMEM_BYTES];
  const int VB = blockIdx.x;
  if (SP == -1) phase_w(p, smem);
  if (SP == 0) phase_gemm_in(p, l, smem, VB);
  if (SP == 1) phase_prep<false>(p, l, smem);
  if (SP == 2) phase_gemm_mla(p, l, smem, VB);
  if (SP == 3) phase_mla_post(p, l, smem);
  if (SP == 4) phase_attn_scan<ATM>(p, l, smem);
  if (SP == 5) phase_combine(p, l, smem);
  if (SP == 6) phase_gemm_branch(p, l, smem, VB);
  if (SP == 7) phase_gemm_out(p, l, smem, VB);
  if (SP == 8) rms_rows<true>((const float*)p.out, S_, (const float*)p.in[I_NORMG] + (l + 1) * D_, (u16*)(p.ws + OFF_H));
}

extern "C" void kernel_launch(void* const* d_in, const int* in_sizes, int n_in, void* d_out, int out_size, void* d_ws,
                              size_t ws_size, hipStream_t stream) {
  static int grid_blocks = 0;
  if (!grid_blocks) {
    int dev = 0, cus = 0, per_cu = 0;
    hipGetDevice(&dev);
    hipDeviceGetAttribute(&cus, hipDeviceAttributeMultiprocessorCount, dev);
    hipOccupancyMaxActiveBlocksPerMultiprocessor(&per_cu, mega, 256, 0);
    if (per_cu > 2) per_cu = 2;
    if (per_cu < 1) per_cu = 1;
    grid_blocks = cus * per_cu;
  }
  Params p{};
  for (int i = 0; i < N_INPUTS; ++i) p.in[i] = d_in[i];
  p.out = (float*)d_out;
  p.ws = (char*)d_ws;
  if (ws_size < WS_TOTAL) fprintf(stderr, "workspace too small: %zu < %zu\n", ws_size, (size_t)WS_TOTAL);
#if MULTI_LAUNCH
  const int G = grid_blocks;
  hipLaunchKernelGGL((k_phase<-1, 0>), dim3(G), dim3(256), 0, stream, p, 0);
  for (int l = 0; l < L_; ++l) {
    hipLaunchKernelGGL((k_phase<0, 0>), dim3(G), dim3(256), 0, stream, p, l);
    hipLaunchKernelGGL((k_phase<1, 0>), dim3(G), dim3(256), 0, stream, p, l);
    hipLaunchKernelGGL((k_phase<2, 0>), dim3(G), dim3(256), 0, stream, p, l);
    hipLaunchKernelGGL((k_phase<3, 0>), dim3(G), dim3(256), 0, stream, p, l);
    hipLaunchKernelGGL((k_phase<4, 8>), dim3(64), dim3(256), 0, stream, p, l);
    hipLaunchKernelGGL((k_phase<4, 1>), dim3(G), dim3(256), 0, stream, p, l);
    hipLaunchKernelGGL((k_phase<4, 2>), dim3(G), dim3(256), 0, stream, p, l);
    hipLaunchKernelGGL((k_phase<4, 4>), dim3(G), dim3(256), 0, stream, p, l);
    hipLaunchKernelGGL((k_phase<5, 0>), dim3(G), dim3(256), 0, stream, p, l);
    hipLaunchKernelGGL((k_phase<6, 0>), dim3(G), dim3(256), 0, stream, p, l);
    hipLaunchKernelGGL((k_phase<7, 0>), dim3(G), dim3(256), 0, stream, p, l);
    if (l + 1 < L_) hipLaunchKernelGGL((k_phase<8, 0>), dim3(G), dim3(256), 0, stream, p, l);
  }
#else
  hipMemsetAsync((char*)d_ws + OFF_BAR, 0, 3456 * 4, stream);
  int lo = 0, hi = N_PHASES - 1;
  void* args[] = {&p, &lo, &hi};
  hipError_t e = hipLaunchCooperativeKernel((void*)mega, dim3(grid_blocks), dim3(256), args, 0, stream);
  if (e != hipSuccess) fprintf(stderr, "cooperative launch failed: %s (grid %d)\n", hipGetErrorString(e), grid_blocks);
#endif
}
```

```cpp
#include <hip/hip_runtime.h>
#include <hip/hip_cooperative_groups.h>
#include <cstdio>
namespace cg = cooperative_groups;

typedef unsigned short u16;
typedef __attribute__((ext_vector_type(8))) short bf16x8;
typedef __attribute__((ext_vector_type(4))) float f32x4;
typedef __attribute__((ext_vector_type(4))) unsigned int u32x4;
typedef __attribute__((ext_vector_type(2))) unsigned int u32x2;

#ifndef MULTI_LAUNCH
#define MULTI_LAUNCH 0
#endif
#ifndef DUP_MASK
#define DUP_MASK 0
#endif
#ifndef ATT_NSUB
#define ATT_NSUB 2
#endif
#ifndef AT_MASK
#define AT_MASK 15
#endif
#ifndef PH_MASK
#if MULTI_LAUNCH
#define PH_MASK 0
#else
#define PH_MASK 0xffff
#endif
#endif


#define LOG2E 1.4426950408889634f
#define S_ 8192
#define D_ 2048
#define NIN 14784
#define NINP 14848
#define L_ 4
#define O_DQ 1792
#define O_DK 2304
#define O_DV 2816
#define O_QL 3328
#define O_KVL 3712
#define O_KR 3968
#define O_MQ 4032
#define O_G 4544
#define O_MG 6592

enum { I_X = 0, I_MEM, I_POS, I_NORMG, I_WIN, I_SHIFT, I_W0, I_WUP, I_A0, I_AUP, I_KK, I_KA, I_RK, I_GNG, I_GNB,
       I_DQKG, I_DLAM, I_DSUBG, I_RELB, I_QLATG, I_KVLATG, I_WUQ, I_WUKV, I_NOPEG, I_ROPEG, I_MEMNG, I_WKV,
       I_MQKG, I_WBR, I_WOUT, N_INPUTS };

struct Params {
  const void* in[N_INPUTS];
  float* out;
  char* ws;
};

constexpr size_t al(size_t x) { return (x + 255) & ~(size_t)255; }
constexpr size_t OFF_WIN = 0;
constexpr size_t OFF_WB = OFF_WIN + al((size_t)L_ * NINP * D_ * 2);
constexpr size_t OFF_WO = OFF_WB + al((size_t)L_ * 4 * 2048 * 512 * 2);
constexpr size_t OFF_WUQ = OFF_WO + al((size_t)L_ * 2048 * 2048 * 2);
constexpr size_t OFF_WUKV = OFF_WUQ + al((size_t)L_ * 768 * 384 * 2);
constexpr size_t OFF_WKV = OFF_WUKV + al((size_t)L_ * 1024 * 256 * 2);
constexpr size_t OFF_MEMN = OFF_WKV + al((size_t)L_ * 1024 * 2048 * 2);
constexpr size_t OFF_KVMEM = OFF_MEMN + al((size_t)L_ * 256 * 2048 * 2);
constexpr size_t OFF_KMEM = OFF_KVMEM + al((size_t)L_ * 256 * 512 * 4);
constexpr size_t OFF_VTMEM = OFF_KMEM + al((size_t)L_ * 4 * 256 * 128 * 2);
constexpr size_t OFF_H = OFF_VTMEM + al((size_t)L_ * 4 * 128 * 256 * 2);
constexpr size_t OFF_P = OFF_H + al((size_t)S_ * D_ * 2);
constexpr size_t OFF_RWU = OFF_P + al((size_t)S_ * NINP * 2);
constexpr size_t OFF_SCR = OFF_RWU + al((size_t)S_ * 1792 * 4);
constexpr size_t OFF_SCV = OFF_SCR + al((size_t)S_ * 512 * 4);
constexpr size_t OFF_SCKK = OFF_SCV + al((size_t)S_ * 512 * 4);
constexpr size_t OFF_SCW = OFF_SCKK + al((size_t)S_ * 512 * 4);
constexpr size_t OFF_SCKD = OFF_SCW + al((size_t)2 * S_ * 512 * 4);
constexpr size_t OFF_SCB = OFF_SCKD + al((size_t)2 * S_ * 512 * 4);
constexpr size_t OFF_BONUS = OFF_SCB + al((size_t)2 * S_ * 512 * 4);
constexpr size_t OFF_YS = OFF_BONUS + al((size_t)S_ * 8 * 4);
constexpr size_t OFF_MQ = OFF_YS + al((size_t)2 * S_ * 512 * 4);
constexpr size_t OFF_MKV = OFF_MQ + al((size_t)S_ * 768 * 4);
constexpr size_t OFF_QM = OFF_MKV + al((size_t)S_ * 512 * 4);
constexpr size_t OFF_KM = OFF_QM + al((size_t)4 * S_ * 192 * 2);
constexpr size_t OFF_VTM = OFF_KM + al((size_t)4 * S_ * 192 * 2);
constexpr size_t OFF_VTD = OFF_VTM + al((size_t)4 * 128 * S_ * 2);
constexpr size_t OFF_OB = OFF_VTD + al((size_t)4 * 128 * S_ * 2);
constexpr size_t OFF_YG = OFF_OB + al((size_t)16 * S_ * 128 * 4);
constexpr size_t OFF_Z = OFF_YG + al((size_t)4 * S_ * 512 * 2);
constexpr size_t OFF_CNT = OFF_Z + al((size_t)S_ * D_ * 2);
constexpr size_t OFF_KPMM = OFF_CNT + 256;
constexpr size_t OFF_BAR = OFF_KPMM + 1024;
constexpr size_t OFF_OB2 = OFF_BAR + al(3456 * 4);
constexpr size_t OFF_ML = OFF_OB2 + al((size_t)16 * S_ * 128 * 4);
constexpr size_t WS_TOTAL = OFF_ML + (size_t)2 * 16 * S_ * 2 * 4;

#define SMEM_BYTES 49152

#define LBAR() asm volatile("s_waitcnt lgkmcnt(0)\n\ts_barrier" ::: "memory")
__device__ __forceinline__ int ltid() {
  int t = __builtin_amdgcn_workitem_id_x();
  asm volatile("" : "+v"(t));
  return t;
}
__device__ __forceinline__ int lbid() {
  int t = __builtin_amdgcn_workgroup_id_x();
  asm volatile("" : "+s"(t));
  return t;
}
typedef float f32x2_ __attribute__((ext_vector_type(2)));
typedef __bf16 bf16x2_ __attribute__((ext_vector_type(2)));
__device__ __forceinline__ unsigned pack2(float a, float b) {
  f32x2_ v = {a, b};
  return __builtin_bit_cast(unsigned, __builtin_convertvector(v, bf16x2_));
}
__device__ __forceinline__ u16 f2bf(float f) { return (u16)(pack2(f, 0.f) & 0xffffu); }
__device__ __forceinline__ float bf2f(u16 h) { return __uint_as_float(((unsigned)h) << 16); }
__device__ __forceinline__ float lo2f(unsigned u) { return __uint_as_float(u << 16); }
__device__ __forceinline__ float hi2f(unsigned u) { return __uint_as_float(u & 0xffff0000u); }
__device__ __forceinline__ float sigmoidf_(float x) { return 1.f / (1.f + __expf(-x)); }
__device__ __forceinline__ float wave_sum(float v) {
#pragma unroll
  for (int o = 32; o >= 1; o >>= 1) v += __shfl_xor(v, o);
  return v;
}
template <int CTRL>
__device__ __forceinline__ float dpp_add(float x) {
  return x + __int_as_float(__builtin_amdgcn_update_dpp(0, __float_as_int(x), CTRL, 0xf, 0xf, true));
}
__device__ __forceinline__ float row16_sum(float x) {
  x = dpp_add<0xB1>(x);
  x = dpp_add<0x4E>(x);
  x = dpp_add<0x141>(x);
  x = dpp_add<0x140>(x);
  return x;
}

template <bool SW>
__device__ __forceinline__ void gemm_main1(const u16* __restrict__ A, int lda, const u16* __restrict__ B, int ldb,
                                          int K, u16* As, u16* Bs, f32x4 (&acc)[4][4]) {
  const int tid = ltid(), lane = tid & 63, w = tid >> 6, l15 = lane & 15, quad = lane >> 4;
  const int wm = w >> 1, wn = w & 1;
  u32x4 ra[4], rb[4];
#pragma unroll
  for (int i = 0; i < 4; ++i) {
    int c = tid + i * 256, r = c >> 3, kc = c & 7;
    ra[i] = *(const u32x4*)(A + (size_t)r * lda + kc * 8);
    rb[i] = *(const u32x4*)(B + (size_t)r * ldb + kc * 8);
  }
  for (int k0 = 0; k0 < K; k0 += 64) {
    LBAR();
#pragma unroll
    for (int i = 0; i < 4; ++i) {
      int c = tid + i * 256, r = c >> 3, kc = c & 7;
      *(u32x4*)(As + r * 64 + ((kc ^ (r & 7)) * 8)) = ra[i];
      *(u32x4*)(Bs + r * 64 + ((kc ^ (r & 7)) * 8)) = rb[i];
    }
    LBAR();
    {
      const int kn = min(k0 + 64, K - 64);
#pragma unroll
      for (int i = 0; i < 4; ++i) {
        int c = tid + i * 256, r = c >> 3, kc = c & 7;
        ra[i] = *(const u32x4*)(A + (size_t)r * lda + kn + kc * 8);
        rb[i] = *(const u32x4*)(B + (size_t)r * ldb + kn + kc * 8);
      }
    }
#pragma unroll
    for (int ks = 0; ks < 2; ++ks) {
      bf16x8 af[4], bfr[4];
#pragma unroll
      for (int i = 0; i < 4; ++i) {
        af[i] = *(const bf16x8*)(As + (wm * 64 + i * 16 + l15) * 64 + (((ks * 4 + quad) ^ (l15 & 7)) * 8));
        bfr[i] = *(const bf16x8*)(Bs + (wn * 64 + i * 16 + l15) * 64 + (((ks * 4 + quad) ^ (l15 & 7)) * 8));
      }
#pragma unroll
      for (int i = 0; i < 4; ++i)
#pragma unroll
        for (int j = 0; j < 4; ++j) acc[i][j] = SW ? __builtin_amdgcn_mfma_f32_16x16x32_bf16(bfr[j], af[i], acc[i][j], 0, 0, 0)
                                                     : __builtin_amdgcn_mfma_f32_16x16x32_bf16(af[i], bfr[j], acc[i][j], 0, 0, 0);
    }
  }
}

template <bool SW>
__device__ __forceinline__ void gemm_main(const u16* __restrict__ A, int lda, const u16* __restrict__ B, int ldb,
                                          int K, u16* As, u16* Bs, f32x4 (&acc)[4][4]) {
  const int tid = ltid(), lane = tid & 63, w = tid >> 6, l15 = lane & 15, quad = lane >> 4;
  const int wm = w >> 1, wn = w & 1;
  u32x4 ra0[4], rb0[4], ra1[4], rb1[4];
  const u16* Ap = A + (size_t)(tid >> 3) * lda + (tid & 7) * 8;
  const u16* Bp = B + (size_t)(tid >> 3) * ldb + (tid & 7) * 8;
  const size_t sa = (size_t)32 * lda, sb = (size_t)32 * ldb;
#define G_LOAD(RA, RB, KK)                                            \
  {                                                                   \
    const int kk_ = min((KK), K - 64);                                \
    _Pragma("unroll") for (int i = 0; i < 4; ++i) {                   \
      RA[i] = *(const u32x4*)(Ap + i * sa + kk_);                     \
      RB[i] = *(const u32x4*)(Bp + i * sb + kk_);                     \
    }                                                                 \
  }
#define G_STAGE(RA, RB, KNEXT)                                                                   \
  {                                                                                              \
    LBAR();                                                                             \
    _Pragma("unroll") for (int i = 0; i < 4; ++i) {                                              \
      *(u32x4*)(As + ((tid >> 3) + i * 32) * 64 + (((tid & 7) ^ ((tid >> 3) & 7)) * 8)) = RA[i]; \
      *(u32x4*)(Bs + ((tid >> 3) + i * 32) * 64 + (((tid & 7) ^ ((tid >> 3) & 7)) * 8)) = RB[i]; \
    }                                                                                            \
    LBAR();                                                                             \
    G_LOAD(RA, RB, KNEXT)                                                                        \
    {                                                                                            \
      bf16x8 af[2][4], bfr[2][4];                                                                \
      _Pragma("unroll") for (int ks = 0; ks < 2; ++ks)                                           \
        _Pragma("unroll") for (int i = 0; i < 4; ++i) {                                          \
          af[ks][i] = *(const bf16x8*)(As + (wm * 64 + i * 16 + l15) * 64 + (((ks * 4 + quad) ^ (l15 & 7)) * 8));  \
          bfr[ks][i] = *(const bf16x8*)(Bs + (wn * 64 + i * 16 + l15) * 64 + (((ks * 4 + quad) ^ (l15 & 7)) * 8)); \
        }                                                                                        \
      __builtin_amdgcn_sched_barrier(0);                                                         \
      _Pragma("unroll") for (int ks = 0; ks < 2; ++ks)                                           \
        _Pragma("unroll") for (int i = 0; i < 4; ++i)                                            \
          _Pragma("unroll") for (int j = 0; j < 4; ++j)                                          \
            acc[i][j] = SW ? __builtin_amdgcn_mfma_f32_16x16x32_bf16(bfr[ks][j], af[ks][i], acc[i][j], 0, 0, 0) \
                           : __builtin_amdgcn_mfma_f32_16x16x32_bf16(af[ks][i], bfr[ks][j], acc[i][j], 0, 0, 0); \
    }                                                                                            \
  }
  G_LOAD(ra0, rb0, 0)
  G_LOAD(ra1, rb1, 64)
  for (int k0 = 0; k0 < K; k0 += 128) {
    G_STAGE(ra0, rb0, k0 + 128)
    G_STAGE(ra1, rb1, k0 + 192)
  }
#undef G_LOAD
#undef G_STAGE
}

__device__ __forceinline__ void gemm_main_blk(const u16* __restrict__ A, const u16* __restrict__ B,
                                          int K, u16* As, u16* Bs, f32x4 (&acc)[4][4]) {
  const int tid = ltid(), lane = tid & 63, w = tid >> 6, l15 = lane & 15, quad = lane >> 4;
  const int wm = w >> 1, wn = w & 1;
  u32x4 ra0[4], rb0[4], ra1[4], rb1[4];
  const u16* Ap = A + tid * 8;
  const u16* Bp = B + tid * 8;
#define G_LOAD(RA, RB, KK)                                            \
  {                                                                   \
    const int kk_ = min((KK), K - 64);                                \
    _Pragma("unroll") for (int i = 0; i < 4; ++i) {                   \
      RA[i] = *(const u32x4*)(Ap + (size_t)kk_ * 128 + i * 2048);    \
      RB[i] = *(const u32x4*)(Bp + (size_t)kk_ * 128 + i * 2048);    \
    }                                                                 \
  }
#define G_STAGE(RA, RB, KNEXT)                                                                   \
  {                                                                                              \
    LBAR();                                                                             \
    _Pragma("unroll") for (int i = 0; i < 4; ++i) {                                              \
      *(u32x4*)(As + i * 2048 + tid * 8) = RA[i];                                                \
      *(u32x4*)(Bs + i * 2048 + tid * 8) = RB[i];                                                \
    }                                                                                            \
    LBAR();                                                                             \
    G_LOAD(RA, RB, KNEXT)                                                                        \
    {                                                                                            \
      bf16x8 af[2][4], bfr[2][4];                                                                \
      _Pragma("unroll") for (int ks = 0; ks < 2; ++ks)                                           \
        _Pragma("unroll") for (int i = 0; i < 4; ++i) {                                          \
          af[ks][i] = *(const bf16x8*)(As + (wm * 64 + i * 16 + l15) * 64 + (((ks * 4 + quad) ^ (l15 & 7)) * 8));  \
          bfr[ks][i] = *(const bf16x8*)(Bs + (wn * 64 + i * 16 + l15) * 64 + (((ks * 4 + quad) ^ (l15 & 7)) * 8)); \
        }                                                                                        \
      __builtin_amdgcn_sched_barrier(0);                                                         \
      _Pragma("unroll") for (int ks = 0; ks < 2; ++ks)                                           \
        _Pragma("unroll") for (int i = 0; i < 4; ++i)                                            \
          _Pragma("unroll") for (int j = 0; j < 4; ++j)                                          \
            acc[i][j] = __builtin_amdgcn_mfma_f32_16x16x32_bf16(af[ks][i], bfr[ks][j], acc[i][j], 0, 0, 0); \
    }                                                                                            \
  }
  G_LOAD(ra0, rb0, 0)
  G_LOAD(ra1, rb1, 64)
  for (int k0 = 0; k0 < K; k0 += 128) {
    G_STAGE(ra0, rb0, k0 + 128)
    G_STAGE(ra1, rb1, k0 + 192)
  }
#undef G_LOAD
#undef G_STAGE
}

#define ZERO_ACC(acc)                                  \
  _Pragma("unroll") for (int i_ = 0; i_ < 4; ++i_)     \
  _Pragma("unroll") for (int j_ = 0; j_ < 4; ++j_) acc[i_][j_] = (f32x4){0.f, 0.f, 0.f, 0.f};

#define EPI_LOOP_T(BODY)                                                           \
  {                                                                                \
    const int lane_ = ltid() & 63, w_ = ltid() >> 6;                               \
    const int l15_ = lane_ & 15, quad_ = lane_ >> 4, wm_ = w_ >> 1, wn_ = w_ & 1;  \
    _Pragma("unroll") for (int i = 0; i < 4; ++i) {                                \
      _Pragma("unroll") for (int j = 0; j < 4; ++j) {                              \
        const int mr = wm_ * 64 + i * 16 + l15_;                                   \
        const int nc = wn_ * 64 + j * 16 + quad_ * 4;                              \
        BODY                                                                       \
      }                                                                            \
    }                                                                              \
  }

#define EPI_LOOP(BODY)                                                             \
  {                                                                                \
    const int lane_ = ltid() & 63, w_ = ltid() >> 6;                     \
    const int l15_ = lane_ & 15, quad_ = lane_ >> 4, wm_ = w_ >> 1, wn_ = w_ & 1;  \
    _Pragma("unroll") for (int i = 0; i < 4; ++i) {                                \
      _Pragma("unroll") for (int j = 0; j < 4; ++j) {                              \
        const int mr = wm_ * 64 + i * 16 + quad_ * 4;                              \
        const int nc = wn_ * 64 + j * 16 + l15_;                                   \
        BODY                                                                       \
      }                                                                            \
    }                                                                              \
  }

__device__ __forceinline__ void gemm_main_blk2(const u16* __restrict__ A, const u16* __restrict__ B, int K, u16* As, u16* Bs,
                                               f32x4 (&acc)[8][4]) {
  const int tid = ltid(), lane = tid & 63, w = tid >> 6, l15 = lane & 15, quad = lane >> 4;
  const int wm = w >> 1, wn = w & 1;
  u32x4 ra[8], rb[4];
  const u16* Ap = A + tid * 8;
  const u16* Bp = B + tid * 8;
  const size_t a2 = (size_t)(K >> 6) * 8192;
#define G2_LOAD(KK)                                                       \
  {                                                                       \
    const int kk_ = min((KK), K - 64);                                    \
    _Pragma("unroll") for (int i = 0; i < 4; ++i) {                       \
      ra[i] = *(const u32x4*)(Ap + (size_t)kk_ * 128 + i * 2048);         \
      ra[4 + i] = *(const u32x4*)(Ap + a2 + (size_t)kk_ * 128 + i * 2048); \
      rb[i] = *(const u32x4*)(Bp + (size_t)kk_ * 128 + i * 2048);         \
    }                                                                     \
  }
  G2_LOAD(0)
  for (int k0 = 0; k0 < K; k0 += 64) {
    LBAR();
#pragma unroll
    for (int i = 0; i < 8; ++i) *(u32x4*)(As + i * 2048 + tid * 8) = ra[i];
#pragma unroll
    for (int i = 0; i < 4; ++i) *(u32x4*)(Bs + i * 2048 + tid * 8) = rb[i];
    LBAR();
    G2_LOAD(k0 + 64)
#pragma unroll
    for (int ks = 0; ks < 2; ++ks) {
      bf16x8 af[8], bfr[4];
#pragma unroll
      for (int i = 0; i < 8; ++i)
        af[i] = *(const bf16x8*)(As + (wm * 128 + i * 16 + l15) * 64 + (((ks * 4 + quad) ^ (l15 & 7)) * 8));
#pragma unroll
      for (int j = 0; j < 4; ++j)
        bfr[j] = *(const bf16x8*)(Bs + (wn * 64 + j * 16 + l15) * 64 + (((ks * 4 + quad) ^ (l15 & 7)) * 8));
#pragma unroll
      for (int i = 0; i < 8; ++i)
#pragma unroll
        for (int j = 0; j < 4; ++j) acc[i][j] = __builtin_amdgcn_mfma_f32_16x16x32_bf16(af[i], bfr[j], acc[i][j], 0, 0, 0);
    }
  }
#undef G2_LOAD
}

#define EPI_LOOP8(BODY)                                                            \
  {                                                                                \
    const int lane_ = ltid() & 63, w_ = ltid() >> 6;                               \
    const int l15_ = lane_ & 15, quad_ = lane_ >> 4, wm_ = w_ >> 1, wn_ = w_ & 1;  \
    _Pragma("unroll") for (int i = 0; i < 8; ++i) {                                \
      _Pragma("unroll") for (int j = 0; j < 4; ++j) {                              \
        const int mr = wm_ * 128 + i * 16 + quad_ * 4;                             \
        const int nc = wn_ * 64 + j * 16 + l15_;                                   \
        BODY                                                                       \
      }                                                                            \
    }                                                                              \
  }

template <bool BLK>
__device__ __forceinline__ void transpose_tile(const float* __restrict__ src, int N, u16* __restrict__ dst, int K, int kt, int nt,
                               float* tile) {
  const int tid = ltid();
  __syncthreads();
  {
    int c = tid & 63, r0 = tid >> 6;
#pragma unroll
    for (int i = 0; i < 16; ++i) {
      int r = r0 + i * 4;
      tile[r * 65 + c] = src[(size_t)(kt * 64 + r) * N + nt * 64 + c];
    }
  }
  __syncthreads();
#pragma unroll
  for (int i = 0; i < 2; ++i) {
    int c = tid + i * 256, n = c >> 3, kc = c & 7;
    uint4 o;
    o.x = pack2(tile[(kc * 8 + 0) * 65 + n], tile[(kc * 8 + 1) * 65 + n]);
    o.y = pack2(tile[(kc * 8 + 2) * 65 + n], tile[(kc * 8 + 3) * 65 + n]);
    o.z = pack2(tile[(kc * 8 + 4) * 65 + n], tile[(kc * 8 + 5) * 65 + n]);
    o.w = pack2(tile[(kc * 8 + 6) * 65 + n], tile[(kc * 8 + 7) * 65 + n]);
    if (BLK) {
      const int ng = nt * 64 + n;
      *(uint4*)(dst + ((size_t)(ng >> 7) * (K >> 6) + kt) * 8192 + (ng & 127) * 64 + ((kc ^ (ng & 7)) * 8)) = o;
    } else {
      *(uint4*)(dst + (size_t)(nt * 64 + n) * K + kt * 64 + kc * 8) = o;
    }
  }
}

template <bool BLK>
__device__ __forceinline__ void rms_rows(const float* __restrict__ src, int nrows, const float* __restrict__ g, u16* __restrict__ dst) {
  const int lane = ltid() & 63, w = ltid() >> 6;
  for (int row = lbid() * 4 + w; row < nrows; row += gridDim.x * 4) {
    const float4* xr = (const float4*)(src + (size_t)row * D_);
    float4 v[8];
    float ss = 0.f;
#pragma unroll
    for (int i = 0; i < 8; ++i) {
      v[i] = xr[lane + i * 64];
      ss += v[i].x * v[i].x + v[i].y * v[i].y + v[i].z * v[i].z + v[i].w * v[i].w;
    }
    ss = wave_sum(ss);
    float rs = rsqrtf(ss * (1.f / D_) + 1e-6f);
#pragma unroll
    for (int i = 0; i < 8; ++i) {
      int col = (lane + i * 64) * 4;
      float4 gg = *(const float4*)(g + col);
      uint2 o;
      o.x = pack2(v[i].x * rs * gg.x, v[i].y * rs * gg.y);
      o.y = pack2(v[i].z * rs * gg.z, v[i].w * rs * gg.w);
      if (BLK) {
        *(uint2*)(dst + ((size_t)(row >> 7) * 32 + (col >> 6)) * 8192 + (row & 127) * 64 + ((((col & 63) >> 3) ^ (row & 7)) * 8) + (col & 7)) = o;
      } else {
        *(uint2*)(dst + (size_t)row * D_ + col) = o;
      }
    }
  }
}

__device__ __forceinline__ int t5_bucket(int rel) {
  int n = rel < 0 ? -rel : rel;
  int b;
  if (n < 8) b = n;
  else if (n < 12) b = 8;
  else if (n < 16) b = 9;
  else if (n < 23) b = 10;
  else if (n < 32) b = 11;
  else if (n < 46) b = 12;
  else if (n < 64) b = 13;
  else if (n < 91) b = 14;
  else b = 15;
  return (rel > 0 ? 16 : 0) + b;
}

__device__ __forceinline__ void phase_w(const Params p, char* smem) {
  const int tid = ltid();
  float* tile = (float*)smem;
  char* ws = p.ws;
  if (lbid() == 0 && tid < 64) ((int*)(ws + OFF_CNT))[tid] = 0;
  {
    const int lane = tid & 63, w = tid >> 6;
    const int* pos = (const int*)p.in[I_POS];
    for (int t = lbid() * 4 + w; t < 128; t += gridDim.x * 4) {
      int v = pos[t * 64 + lane], mn = v, mx = v;
#pragma unroll
      for (int o = 32; o >= 1; o >>= 1) {
        mn = min(mn, __shfl_xor(mn, o));
        mx = max(mx, __shfl_xor(mx, o));
      }
      if (lane == 0) {
        ((int*)(ws + OFF_KPMM))[t * 2] = mn;
        ((int*)(ws + OFF_KPMM))[t * 2 + 1] = mx;
      }
    }
  }
  for (int i = lbid() * 256 + tid; i < L_ * 32 * 512; i += gridDim.x * 256) {
    int l = i / (32 * 512), r = i % (32 * 512), kt = r >> 9, q = r & 511;
    *(uint4*)((u16*)(ws + OFF_WIN) + (size_t)l * NINP * D_ + ((size_t)115 * 32 + kt) * 8192 + 4096 + q * 8) = make_uint4(0, 0, 0, 0);
  }
  rms_rows<true>((const float*)p.in[I_X], S_, (const float*)p.in[I_NORMG], (u16*)(ws + OFF_H));
  for (int l = 0; l < L_; ++l)
    rms_rows<false>((const float*)p.in[I_MEM], 256, (const float*)p.in[I_MEMNG] + l * D_, (u16*)(ws + OFF_MEMN) + (size_t)l * 256 * D_);
  const int PER_L = 7392 + 1024 + 1024 + 72 + 64 + 512;
  for (int t = lbid(); t < L_ * PER_L; t += gridDim.x) {
    int l = t / PER_L, r = t % PER_L;
    if (r < 7392) {
      transpose_tile<true>((const float*)p.in[I_WIN] + (size_t)l * D_ * NIN, NIN, (u16*)(ws + OFF_WIN) + (size_t)l * NINP * D_, D_,
                     r / 231, r % 231, tile);
    } else if (r < 7392 + 1024) {
      r -= 7392;
      int bi = r >> 8;
      r &= 255;
      transpose_tile<false>((const float*)p.in[I_WBR] + (size_t)(l * 4 + bi) * 512 * 2048, 2048,
                     (u16*)(ws + OFF_WB) + (size_t)(l * 4 + bi) * 2048 * 512, 512, r >> 5, r & 31, tile);
    } else if (r < 7392 + 2048) {
      r -= 7392 + 1024;
      transpose_tile<false>((const float*)p.in[I_WOUT] + (size_t)l * 2048 * 2048, 2048, (u16*)(ws + OFF_WO) + (size_t)l * 2048 * 2048,
                     2048, r >> 5, r & 31, tile);
    } else if (r < 7392 + 2048 + 72) {
      r -= 7392 + 2048;
      transpose_tile<false>((const float*)p.in[I_WUQ] + (size_t)l * 384 * 768, 768, (u16*)(ws + OFF_WUQ) + (size_t)l * 768 * 384, 384,
                     r / 12, r % 12, tile);
    } else if (r < 7392 + 2048 + 72 + 64) {
      r -= 7392 + 2048 + 72;
      transpose_tile<false>((const float*)p.in[I_WUKV] + (size_t)l * 256 * 1024, 1024, (u16*)(ws + OFF_WUKV) + (size_t)l * 1024 * 256,
                     256, r >> 4, r & 15, tile);
    } else {
      r -= 7392 + 2048 + 72 + 64;
      transpose_tile<false>((const float*)p.in[I_WKV] + (size_t)l * 2048 * 1024, 1024, (u16*)(ws + OFF_WKV) + (size_t)l * 1024 * 2048,
                     2048, r >> 4, r & 15, tile);
    }
  }
}

__device__ __forceinline__ int tile_slots(int NT) { return gridDim.x == 512 ? 512 * ((NT + 7) >> 3) : 64 * NT; }
__device__ __forceinline__ bool tile_map(int t, int NT, int& mt, int& nt) {
  if (gridDim.x == 512) {
    int bid = t & 511, k = t >> 9, x = bid & 7, j = bid >> 3;
    mt = 8 * x + (j & 7);
    nt = 8 * k + (j >> 3);
  } else {
    mt = t & 63;
    nt = t >> 6;
  }
  return nt < NT;
}

__device__ __forceinline__ int tile_slots2(int NT) { return gridDim.x == 512 ? 512 * ((NT + 15) >> 4) : 32 * NT; }
__device__ __forceinline__ bool tile_map2(int t, int NT, int& mt, int& nt) {
  if (gridDim.x == 512) {
    int bid = t & 511, k = t >> 9, x = bid & 7, j = bid >> 3;
    mt = 4 * x + (j & 3);
    nt = 16 * k + (j >> 2);
  } else {
    mt = t & 31;
    nt = t >> 5;
  }
  return nt < NT;
}

__device__ __forceinline__ void phase_gemm_in(const Params p, int l, char* smem, int vb) {
  u16* As = (u16*)smem;
  char* ws = p.ws;
  {
    u16* Bs = As + 256 * 64;
    const int nslots = tile_slots2(112);
    for (int t = vb; t < nslots; t += gridDim.x) {
      int mt, nt;
      if (!tile_map2(t, 112, mt, nt)) continue;
      f32x4 acc[8][4];
#pragma unroll
      for (int i_ = 0; i_ < 8; ++i_)
#pragma unroll
        for (int j_ = 0; j_ < 4; ++j_) acc[i_][j_] = (f32x4){0.f, 0.f, 0.f, 0.f};
      int m0 = mt * 256, n0 = nt * 128;
      gemm_main_blk2((const u16*)(ws + OFF_H) + (size_t)(2 * mt) * 32 * 8192,
                     (const u16*)(ws + OFF_WIN) + (size_t)l * NINP * D_ + (size_t)nt * 32 * 8192, D_, As, Bs, acc);
      if (n0 < 1792) {
        float* dst = (float*)(ws + OFF_RWU);
        EPI_LOOP8({
          _Pragma("unroll") for (int r2 = 0; r2 < 4; ++r2) dst[(size_t)(m0 + mr + r2) * 1792 + n0 + nc] = acc[i][j][r2];
        })
      } else if (n0 >= O_DV && n0 < O_QL) {
        u16* dst = (u16*)(ws + OFF_VTD) + (size_t)((n0 - O_DV) / 128) * 128 * S_;
        EPI_LOOP8({
          uint2 o;
          o.x = pack2(acc[i][j][0], acc[i][j][1]);
          o.y = pack2(acc[i][j][2], acc[i][j][3]);
          *(uint2*)(dst + (size_t)nc * S_ + m0 + mr) = o;
        })
      } else {
        u16* dst = (u16*)(ws + OFF_P);
        EPI_LOOP8({
          _Pragma("unroll") for (int r2 = 0; r2 < 4; ++r2) dst[(size_t)(m0 + mr + r2) * NINP + n0 + nc] = f2bf(acc[i][j][r2]);
        })
      }
    }
  }
  {
    u16* Bs = As + 128 * 64;
    for (int t = vb; t < 256; t += gridDim.x) {
      f32x4 acc[4][4];
      ZERO_ACC(acc);
      int mt = t & 63, nt = 112 + (t >> 6);
      int m0 = mt * 128, n0 = nt * 128;
      gemm_main_blk((const u16*)(ws + OFF_H) + (size_t)mt * 32 * 8192,
                    (const u16*)(ws + OFF_WIN) + (size_t)l * NINP * D_ + (size_t)nt * 32 * 8192, D_, As, Bs, acc);
      u16* dst = (u16*)(ws + OFF_P);
      EPI_LOOP({
        _Pragma("unroll") for (int r2 = 0; r2 < 4; ++r2) dst[(size_t)(m0 + mr + r2) * NINP + n0 + nc] = f2bf(acc[i][j][r2]);
      })
    }
  }
  if (l == 0) {
    u16* Bs = As + 128 * 64;
    for (int tt = (vb + gridDim.x - 256) % gridDim.x; tt < 64; tt += gridDim.x) {
      f32x4 acc[4][4];
      ZERO_ACC(acc);
      int ll = tt >> 4, mt = (tt >> 3) & 1, nt = tt & 7;
      int m0 = mt * 128, n0 = nt * 128;
      gemm_main<false>((const u16*)(ws + OFF_MEMN) + ((size_t)ll * 256 + m0) * D_, D_, (const u16*)(ws + OFF_WKV) + ((size_t)ll * 1024 + n0) * D_,
                D_, D_, As, Bs, acc);
      if (nt < 4) {
        float* dst = (float*)(ws + OFF_KVMEM) + (size_t)ll * 256 * 512;
        EPI_LOOP({
          _Pragma("unroll") for (int r2 = 0; r2 < 4; ++r2) dst[(size_t)(m0 + mr + r2) * 512 + n0 + nc] = acc[i][j][r2];
        })
      } else {
        u16* dst = (u16*)(ws + OFF_VTMEM) + (size_t)(ll * 4 + (nt - 4)) * 128 * 256;
        EPI_LOOP({
          uint2 o;
          o.x = pack2(acc[i][j][0], acc[i][j][1]);
          o.y = pack2(acc[i][j][2], acc[i][j][3]);
          *(uint2*)(dst + (size_t)nc * 256 + m0 + mr) = o;
        })
      }
    }
  }
}

__device__ __forceinline__ void phase_gemm_mla(const Params p, int l, char* smem, int vb) {
  u16* As = (u16*)smem;
  u16* Bs = As + 128 * 64;
  char* ws = p.ws;
  const u16* P = (const u16*)(ws + OFF_P);
  const int nslots = tile_slots(14);
  for (int t = vb; t < nslots; t += gridDim.x) {
    f32x4 acc[4][4];
    ZERO_ACC(acc);
    int mt, nt;
    if (!tile_map(t, 14, mt, nt)) continue;
    int m0 = mt * 128;
    if (nt < 6) {
      int n0 = nt * 128;
      gemm_main<true>(P + (size_t)m0 * NINP + O_QL, NINP, (const u16*)(ws + OFF_WUQ) + ((size_t)l * 768 + n0) * 384, 384, 384, As, Bs, acc);
      float* dst = (float*)(ws + OFF_MQ);
      EPI_LOOP_T({
        *(float4*)(dst + (size_t)(m0 + mr) * 768 + n0 + nc) = make_float4(acc[i][j][0], acc[i][j][1], acc[i][j][2], acc[i][j][3]);
      })
    } else {
      nt -= 6;
      int n0 = nt * 128, h = nt >> 1;
      if ((nt & 1) == 0) {
        gemm_main<true>(P + (size_t)m0 * NINP + O_KVL, NINP, (const u16*)(ws + OFF_WUKV) + ((size_t)l * 1024 + n0) * 256, 256, 256, As, Bs, acc);
        float* dst = (float*)(ws + OFF_MKV);
        EPI_LOOP_T({
          *(float4*)(dst + (size_t)(m0 + mr) * 512 + h * 128 + nc) = make_float4(acc[i][j][0], acc[i][j][1], acc[i][j][2], acc[i][j][3]);
        })
      } else {
        gemm_main<false>(P + (size_t)m0 * NINP + O_KVL, NINP, (const u16*)(ws + OFF_WUKV) + ((size_t)l * 1024 + n0) * 256, 256, 256, As, Bs, acc);
        u16* dst = (u16*)(ws + OFF_VTM) + (size_t)h * 128 * S_;
        EPI_LOOP({
          uint2 o;
          o.x = pack2(acc[i][j][0], acc[i][j][1]);
          o.y = pack2(acc[i][j][2], acc[i][j][3]);
          *(uint2*)(dst + (size_t)nc * S_ + m0 + mr) = o;
        })
      }
    }
  }
}

__device__ __forceinline__ void phase_gemm_branch(const Params p, int l, char* smem, int vb) {
  u16* As = (u16*)smem;
  u16* Bs = As + 128 * 64;
  char* ws = p.ws;
  const u16* P = (const u16*)(ws + OFF_P);
  const int nslots = tile_slots(16);
  for (int t = vb; t < nslots; t += gridDim.x) {
    int mt, nt;
    if (!tile_map(t, 16, mt, nt)) continue;
    int m0 = mt * 128, n0 = nt * 128;
    f32x4 zacc[4][4];
    ZERO_ACC(zacc);
    for (int bi = 0; bi < 4; ++bi) {
      f32x4 acc[4][4];
      ZERO_ACC(acc);
      gemm_main1<true>((const u16*)(ws + OFF_YG) + ((size_t)bi * S_ + m0) * 512, 512,
                (const u16*)(ws + OFF_WB) + ((size_t)(l * 4 + bi) * 2048 + n0) * 512, 512, 512, As, Bs, acc);
      EPI_LOOP_T({
        const uint2 mg = *(const uint2*)(P + (size_t)(m0 + mr) * NINP + O_MG + bi * 2048 + n0 + nc);
        zacc[i][j][0] += sigmoidf_(lo2f(mg.x)) * acc[i][j][0];
        zacc[i][j][1] += sigmoidf_(hi2f(mg.x)) * acc[i][j][1];
        zacc[i][j][2] += sigmoidf_(lo2f(mg.y)) * acc[i][j][2];
        zacc[i][j][3] += sigmoidf_(hi2f(mg.y)) * acc[i][j][3];
      })
    }
    u16* dst = (u16*)(ws + OFF_Z);
    EPI_LOOP_T({
      uint2 o;
      o.x = pack2(zacc[i][j][0], zacc[i][j][1]);
      o.y = pack2(zacc[i][j][2], zacc[i][j][3]);
      *(uint2*)(dst + (size_t)(m0 + mr) * D_ + n0 + nc) = o;
    })
  }
}

__device__ __forceinline__ void phase_gemm_out(const Params p, int l, char* smem, int vb) {
  u16* As = (u16*)smem;
  u16* Bs = As + 128 * 64;
  char* ws = p.ws;
  const float* xin = (l == 0) ? (const float*)p.in[I_X] : (const float*)p.out;
  const int nslots = tile_slots(16);
  for (int t = vb; t < nslots; t += gridDim.x) {
    int mt, nt;
    if (!tile_map(t, 16, mt, nt)) continue;
    int m0 = mt * 128, n0 = nt * 128;
    f32x4 acc[4][4];
    ZERO_ACC(acc);
    gemm_main<true>((const u16*)(ws + OFF_Z) + (size_t)m0 * D_, D_, (const u16*)(ws + OFF_WO) + ((size_t)l * 2048 + n0) * D_, D_, D_, As, Bs,
              acc);
    EPI_LOOP_T({
      size_t idx = (size_t)(m0 + mr) * D_ + n0 + nc;
      float4 xv = *(const float4*)(xin + idx);
      *(float4*)(p.out + idx) = make_float4(xv.x + acc[i][j][0], xv.y + acc[i][j][1], xv.z + acc[i][j][2], xv.w + acc[i][j][3]);
    })
  }
}

__device__ __forceinline__ void seg_norm8(u16* ptr, bool active, int width, float inv_n, const float* g, float scale) {
  uint4 v = make_uint4(0, 0, 0, 0);
  if (active) v = *(const uint4*)ptr;
  float x[8] = {lo2f(v.x), hi2f(v.x), lo2f(v.y), hi2f(v.y), lo2f(v.z), hi2f(v.z), lo2f(v.w), hi2f(v.w)};
  float ss = 0.f;
#pragma unroll
  for (int i = 0; i < 8; ++i) ss += x[i] * x[i];
  for (int o = 1; o < width; o <<= 1) ss += __shfl_xor(ss, o);
  float rs = rsqrtf(ss * inv_n + 1e-6f) * scale;
  if (active) {
    float4 g0 = *(const float4*)g, g1 = *(const float4*)(g + 4);
    uint4 o;
    o.x = pack2(x[0] * rs * g0.x, x[1] * rs * g0.y);
    o.y = pack2(x[2] * rs * g0.z, x[3] * rs * g0.w);
    o.z = pack2(x[4] * rs * g1.x, x[5] * rs * g1.y);
    o.w = pack2(x[6] * rs * g1.z, x[7] * rs * g1.w);
    *(uint4*)ptr = o;
  }
}

template <bool RWONLY>
__device__ __forceinline__ void phase_prep(const Params p, int l, char* smem) {
  char* ws = p.ws;
  const int tid = ltid(), lane = tid & 63, w = tid >> 6;
  u16* P = (u16*)(ws + OFF_P);
  if (!RWONLY) {
    const float* dqg = (const float*)p.in[I_DQKG] + l * 128;
    const float* mqg = (const float*)p.in[I_MQKG] + l * 256;
    const float* qlg = (const float*)p.in[I_QLATG] + l * 384;
    const float* kvg = (const float*)p.in[I_KVLATG] + l * 256;
    for (int s = lbid() * 4 + w; s < S_; s += gridDim.x * 4) {
      u16* row = P + (size_t)s * NINP;
      seg_norm8(row + O_DQ + lane * 8, true, 8, 1.f / 64, dqg + (lane * 8) % 64, 0.125f * LOG2E);
      seg_norm8(row + O_DK + lane * 8, true, 8, 1.f / 64, dqg + 64 + (lane * 8) % 64, 1.f);
      seg_norm8(row + O_MQ + lane * 8, true, 16, 1.f / 128, mqg + (lane * 8) % 128, 0.08838834764831845f * LOG2E);
      seg_norm8(row + O_QL + (lane < 48 ? lane : 0) * 8, lane < 48, 64, 1.f / 384, qlg + (lane < 48 ? lane : 0) * 8, 1.f);
      seg_norm8(row + O_KVL + (lane < 32 ? lane : 0) * 8, lane < 32, 64, 1.f / 256, kvg + (lane < 32 ? lane : 0) * 8, 1.f);
    }
  }
  if (l == 0 && !RWONLY) {
    for (int sg = lbid() * 4 + w; sg < L_ * 256 * 4; sg += gridDim.x * 4) {
      int ll = sg >> 10, m = (sg >> 2) & 255, h = sg & 3;
      const float* src = (const float*)(ws + OFF_KVMEM) + ((size_t)ll * 256 + m) * 512 + h * 128;
      float a = src[lane], b = src[lane + 64];
      float ss = wave_sum(a * a + b * b);
      float rs = rsqrtf(ss * (1.f / 128) + 1e-6f);
      const float* g = (const float*)p.in[I_MQKG] + ll * 256 + 128;
      u16* dst = (u16*)(ws + OFF_KMEM) + ((size_t)(ll * 4 + h) * 256 + m) * 128;
      dst[lane] = f2bf(a * rs * g[lane]);
      dst[lane + 64] = f2bf(b * rs * g[lane + 64]);
    }
  }
  {
    float* ld = (float*)smem;
    const float* RWU = (const float*)(ws + OFF_RWU);
    const float* sh = (const float*)p.in[I_SHIFT] + (size_t)l * 3 * 1792;
    const float* wup = (const float*)p.in[I_WUP] + (size_t)l * 2 * 64 * 512;
    const float* aup = (const float*)p.in[I_AUP] + (size_t)l * 2 * 64 * 512;
    const float* w0 = (const float*)p.in[I_W0] + l * 1024;
    const float* a0 = (const float*)p.in[I_A0] + l * 1024;
    const float* kkp = (const float*)p.in[I_KK] + l * 512;
    const float* kap = (const float*)p.in[I_KA] + l * 512;
    const float* rkp = (const float*)p.in[I_RK] + l * 512;
    for (int tile = lbid(); tile < S_ / 8; tile += gridDim.x) {
      const int s0 = tile * 8;
      __syncthreads();
      {
        int c = 1536 + tid;
        float c0 = sh[c], c1 = sh[1792 + c], c2 = sh[2 * 1792 + c];
#pragma unroll
        for (int tk = 0; tk < 8; ++tk) {
          int s = s0 + tk;
          float um = s > 0 ? RWU[(size_t)(s - 1) * 1792 + c] : 0.f;
          float u0 = RWU[(size_t)s * 1792 + c];
          float up = s < S_ - 1 ? RWU[(size_t)(s + 1) * 1792 + c] : 0.f;
          float v = c0 * um + c1 * u0 + c2 * up;
          if (tid < 128) v = tanhf(v);
          ld[tk * 256 + tid] = v;
        }
      }
      __syncthreads();
      float acc[8][4][2];
#pragma unroll
      for (int a = 0; a < 8; ++a)
#pragma unroll
        for (int b = 0; b < 4; ++b) acc[a][b][0] = acc[a][b][1] = 0.f;
      for (int l4 = 0; l4 < 16; ++l4) {
        float wv[4][4][2];
#pragma unroll
        for (int ll = 0; ll < 4; ++ll) {
#pragma unroll
          for (int ch = 0; ch < 2; ++ch) {
            int c = tid + ch * 256;
            int li = l4 * 4 + ll;
            wv[0][ll][ch] = wup[(size_t)(0 * 64 + li) * 512 + c];
            wv[1][ll][ch] = wup[(size_t)(1 * 64 + li) * 512 + c];
            wv[2][ll][ch] = aup[(size_t)(0 * 64 + li) * 512 + c];
            wv[3][ll][ch] = aup[(size_t)(1 * 64 + li) * 512 + c];
          }
        }
#pragma unroll
        for (int tk = 0; tk < 8; ++tk) {
#pragma unroll
          for (int mat = 0; mat < 4; ++mat) {
            float4 d = *(const float4*)(ld + tk * 256 + mat * 64 + l4 * 4);
#pragma unroll
            for (int ch = 0; ch < 2; ++ch) {
              acc[tk][mat][ch] += d.x * wv[mat][0][ch] + d.y * wv[mat][1][ch] + d.z * wv[mat][2][ch] + d.w * wv[mat][3][ch];
            }
          }
        }
      }
#pragma unroll
      for (int ch = 0; ch < 2; ++ch) {
        const int c = tid + ch * 256;
        float shc[3][3];
#pragma unroll
        for (int q = 0; q < 3; ++q)
#pragma unroll
          for (int j = 0; j < 3; ++j) shc[q][j] = sh[j * 1792 + q * 512 + c];
        const float kkc = kkp[c], kac = kap[c], rkc = rkp[c];
        const float w0c0 = w0[c], w0c1 = w0[512 + c], a0c0 = a0[c], a0c1 = a0[512 + c];
        float um[3], u0[3];
#pragma unroll
        for (int q = 0; q < 3; ++q) {
          um[q] = s0 > 0 ? RWU[(size_t)(s0 - 1) * 1792 + q * 512 + c] : 0.f;
          u0[q] = RWU[(size_t)s0 * 1792 + q * 512 + c];
        }
#pragma unroll
        for (int tk = 0; tk < 8; ++tk) {
          const int s = s0 + tk;
          float rkv[3];
#pragma unroll
          for (int q = 0; q < 3; ++q) {
            float up = s < S_ - 1 ? RWU[(size_t)(s + 1) * 1792 + q * 512 + c] : 0.f;
            rkv[q] = shc[q][0] * um[q] + shc[q][1] * u0[q] + shc[q][2] * up;
            um[q] = u0[q];
            u0[q] = up;
          }
          float r = rkv[0], k = rkv[1], v = rkv[2];
          float kkr = k * kkc;
          float ss = wave_sum(kkr * kkr);
          float kk = kkr / fmaxf(sqrtf(ss), 1e-12f);
          float bsum = 0.f;
#pragma unroll
          for (int n = 0; n < 2; ++n) {
            float zw = (n ? w0c1 : w0c0) + acc[tk][n][ch];
            float za = (n ? a0c1 : a0c0) + acc[tk][2 + n][ch];
            float dec = __expf(-0.6065306597126334f * sigmoidf_(zw));
            float a = sigmoidf_(za);
            float kd = k * (1.f + (a - 1.f) * kac);
            float bb = kk * a;
            size_t o = ((size_t)n * S_ + s) * 512 + c;
            ((float*)(ws + OFF_SCW))[o] = dec;
            ((float*)(ws + OFF_SCKD))[o] = kd;
            ((float*)(ws + OFF_SCB))[o] = bb;
            bsum += r * kd * rkc;
          }
          size_t o1 = (size_t)s * 512 + c;
          ((float*)(ws + OFF_SCR))[o1] = r;
          ((float*)(ws + OFF_SCV))[o1] = v;
          ((float*)(ws + OFF_SCKK))[o1] = kk;
          float bon = wave_sum(bsum);
          if (lane == 0) ((float*)(ws + OFF_BONUS))[s * 8 + w + 4 * ch] = bon;
        }
      }
    }
  }
}

__device__ __forceinline__ void phase_mla_post(const Params p, int l, char* smem) {
  char* ws = p.ws;
  const int lane = ltid() & 63, w = ltid() >> 6;
  const float* ng = (const float*)p.in[I_NOPEG] + l * 256;
  const float* rg = (const float*)p.in[I_ROPEG] + l * 128;
  const int* pos = (const int*)p.in[I_POS];
  const float qscale = 0.07216878364870322f * LOG2E;
  const int fi = lane & 31;
  const float inv_freq = powf(10000.f, -(float)fi / 32.f);
  for (int s = lbid() * 4 + w; s < S_; s += gridDim.x * 4) {
    float ang = (float)pos[s] * inv_freq;
    float cs = cosf(ang), sn = sinf(ang);
    const float* mq = (const float*)(ws + OFF_MQ) + (size_t)s * 768;
    const float* mk = (const float*)(ws + OFF_MKV) + (size_t)s * 512;
    float kr1, kr2;
    {
      const u16* kr = (const u16*)(ws + OFF_P) + (size_t)s * NINP + O_KR;
      float t1 = lane < 32 ? bf2f(kr[fi]) : 0.f, t2 = lane < 32 ? bf2f(kr[32 + fi]) : 0.f;
      float ss = wave_sum(t1 * t1 + t2 * t2);
      float rs = rsqrtf(ss * (1.f / 64) + 1e-6f);
      t1 *= rs * rg[64 + fi];
      t2 *= rs * rg[64 + 32 + fi];
      kr1 = t1 * cs - t2 * sn;
      kr2 = t2 * cs + t1 * sn;
    }
#pragma unroll
    for (int h = 0; h < 4; ++h) {
      u16* qd = (u16*)(ws + OFF_QM) + ((size_t)h * S_ + s) * 192;
      u16* kd = (u16*)(ws + OFF_KM) + ((size_t)h * S_ + s) * 192;
      {
        const float2 ab = *(const float2*)(mq + h * 192 + 2 * lane);
        float a = ab.x, b = ab.y;
        float ss = wave_sum(a * a + b * b);
        float rs = rsqrtf(ss * (1.f / 128) + 1e-6f) * qscale;
        const float2 gq = *(const float2*)(ng + 2 * lane);
        *(unsigned*)(qd + 2 * lane) = pack2(a * rs * gq.x, b * rs * gq.y);
      }
      {
        float t1 = lane < 32 ? mq[h * 192 + 128 + fi] : 0.f, t2 = lane < 32 ? mq[h * 192 + 160 + fi] : 0.f;
        float ss = wave_sum(t1 * t1 + t2 * t2);
        float rs = rsqrtf(ss * (1.f / 64) + 1e-6f);
        t1 *= rs * rg[fi];
        t2 *= rs * rg[32 + fi];
        if (lane < 32) {
          qd[128 + fi] = f2bf((t1 * cs - t2 * sn) * qscale);
          qd[160 + fi] = f2bf((t2 * cs + t1 * sn) * qscale);
        }
      }
      {
        const float2 ab = *(const float2*)(mk + h * 128 + 2 * lane);
        float a = ab.x, b = ab.y;
        float ss = wave_sum(a * a + b * b);
        float rs = rsqrtf(ss * (1.f / 128) + 1e-6f);
        const float2 gk = *(const float2*)(ng + 128 + 2 * lane);
        *(unsigned*)(kd + 2 * lane) = pack2(a * rs * gk.x, b * rs * gk.y);
        if (lane < 32) {
          kd[128 + fi] = f2bf(kr1);
          kd[160 + fi] = f2bf(kr2);
        }
      }
    }
  }
}

template <int DQK, int NSUB>
__device__ __forceinline__ void attn_item(const u16* __restrict__ Q, int ldq, const u16* __restrict__ K, int ldk, const u16* __restrict__ Vt,
                          int ldv, int Skv, u16* __restrict__ O, int qb, bool hasBias, const float* __restrict__ relb, int head,
                          const int* __restrict__ pos, const int* __restrict__ kpmm, char* smem, const int* __restrict__ kposp,
                          float* __restrict__ ML) {
  constexpr int LDK = DQK;
  constexpr int SW = (DQK == 128) ? 15 : 7;
  constexpr int NKS = DQK / 32;
  constexpr int NKC = DQK / 32;
  u16* Ks = (u16*)smem;
  u16* Vs = (u16*)(smem + 25600);
  float* bt = (float*)(smem + 44032);
  int* kp = (int*)(smem + 45072);
  const int tid = ltid(), lane = tid & 63, w = tid >> 6, l15 = lane & 15, quad = lane >> 4;
  const int q0 = qb * (64 * NSUB) + w * (16 * NSUB);

  bf16x8 qf[NSUB][NKS];
#pragma unroll
  for (int sub = 0; sub < NSUB; ++sub)
#pragma unroll
    for (int ks = 0; ks < NKS; ++ks)
      qf[sub][ks] = *(const bf16x8*)(Q + (size_t)(q0 + sub * 16 + l15) * ldq + ks * 32 + quad * 8);

  int qp[2] = {0, 0};
  int qpmin = 0, qpmax = 0;
  if (hasBias) {
    qp[0] = pos[q0 + l15];
    qp[1] = pos[q0 + (NSUB - 1) * 16 + l15];
    qpmin = min(qp[0], qp[1]);
    qpmax = max(qp[0], qp[1]);
#pragma unroll
    for (int o = 8; o >= 1; o >>= 1) {
      qpmin = min(qpmin, __shfl_xor(qpmin, o));
      qpmax = max(qpmax, __shfl_xor(qpmax, o));
    }
  }
  __syncthreads();
  if (hasBias) {
    for (int i = tid; i < 257; i += 256) bt[i] = relb[t5_bucket(i - 128) * 4 + head] * LOG2E;
  }
  u32x4 kreg[NKC], vreg[4];
#pragma unroll
  for (int i = 0; i < NKC; ++i) {
    int c = tid + i * 256, r = c / (DQK / 8), kc = c % (DQK / 8);
    kreg[i] = *(const u32x4*)(K + (size_t)r * ldk + kc * 8);
  }
#pragma unroll
  for (int i = 0; i < 4; ++i) {
    int c = tid + i * 256, r = c >> 3, kc = c & 7;
    vreg[i] = *(const u32x4*)(Vt + (size_t)r * ldv + kc * 8);
  }
#pragma unroll
  for (int i = 0; i < NKC; ++i) {
    int c = tid + i * 256, r = c / (DQK / 8), kc = c % (DQK / 8);
    *(u32x4*)(Ks + r * LDK + ((kc ^ (r & SW)) * 8)) = kreg[i];
  }
#pragma unroll
  for (int i = 0; i < 4; ++i) {
    int c = tid + i * 256, r = c >> 3, kc = c & 7;
    *(u32x4*)(Vs + r * 72 + kc * 8) = vreg[i];
  }
  if (hasBias && tid < 64) kp[tid] = kposp[tid];
  __syncthreads();

  f32x4 oacc[8][NSUB];
#pragma unroll
  for (int et = 0; et < 8; ++et)
#pragma unroll
    for (int sub = 0; sub < NSUB; ++sub) oacc[et][sub] = (f32x4){0.f, 0.f, 0.f, 0.f};
  float mrow[2] = {-1e30f, -1e30f}, lrow[2] = {0.f, 0.f};

  const int ntiles = Skv / 64;
  constexpr bool KDMA = (DQK == 192);
  int koff[6];
#pragma unroll
  for (int i = 0; i < 6; ++i) {
    const int o = (w + 4 * i) * 1024 + lane * 16;
    const int r = o / (DQK * 2), pos = (o % (DQK * 2)) >> 4;
    koff[i] = r * ldk + ((pos ^ (r & SW)) * 8);
  }
  for (int t = 0; t < ntiles; ++t) {
    const bool more = (t + 1 < ntiles);
    const int k1 = (t + 1) * 64;
    constexpr bool EARLY = (DQK != 128);
    if (EARLY && more) {
      if (!KDMA) {
#pragma unroll
        for (int i = 0; i < NKC; ++i) {
          int c = tid + i * 256, r = c / (DQK / 8), kc = c % (DQK / 8);
          kreg[i] = *(const u32x4*)(K + (size_t)(k1 + r) * ldk + kc * 8);
        }
      }
#pragma unroll
      for (int i = 0; i < 4; ++i) {
        int c = tid + i * 256, r = c >> 3, kc = c & 7;
        vreg[i] = *(const u32x4*)(Vt + (size_t)r * ldv + k1 + kc * 8);
      }
    }
    f32x4 sacc[4][NSUB];
#pragma unroll
    for (int kt = 0; kt < 4; ++kt)
#pragma unroll
      for (int sub = 0; sub < NSUB; ++sub) sacc[kt][sub] = (f32x4){0.f, 0.f, 0.f, 0.f};
#pragma unroll
    for (int ks = 0; ks < NKS; ++ks) {
#pragma unroll
      for (int kt = 0; kt < 4; ++kt) {
        bf16x8 kf = *(const bf16x8*)(Ks + (kt * 16 + l15) * LDK + (((ks * 4 + quad) ^ (l15 & SW)) * 8));
#pragma unroll
        for (int sub = 0; sub < NSUB; ++sub)
          sacc[kt][sub] = __builtin_amdgcn_mfma_f32_16x16x32_bf16(kf, qf[sub][ks], sacc[kt][sub], 0, 0, 0);
      }
      __builtin_amdgcn_sched_barrier(0);
    }
    float cb = 0.f;
    if (hasBias) {
      int kmn = kpmm[t * 2], kmx = kpmm[t * 2 + 1];
      if (kmn - qpmax >= 128 || kmx - qpmin <= -128) {
        cb = (kmn - qpmax >= 128) ? bt[256] : bt[0];
      } else {
#pragma unroll
        for (int kt = 0; kt < 4; ++kt) {
#pragma unroll
          for (int j = 0; j < 4; ++j) {
            int kpos = kp[kt * 16 + quad * 4 + j];
#pragma unroll
            for (int sub = 0; sub < NSUB; ++sub) {
              int rel = kpos - qp[sub];
              rel = max(-128, min(128, rel));
              sacc[kt][sub][j] += bt[rel + 128];
            }
          }
        }
      }
    }
    LBAR();
    if (more) {
      if (!EARLY) {
#pragma unroll
        for (int i = 0; i < NKC; ++i) {
          int c = tid + i * 256, r = c / (DQK / 8), kc = c % (DQK / 8);
          kreg[i] = *(const u32x4*)(K + (size_t)(k1 + r) * ldk + kc * 8);
        }
#pragma unroll
        for (int i = 0; i < 4; ++i) {
          int c = tid + i * 256, r = c >> 3, kc = c & 7;
          vreg[i] = *(const u32x4*)(Vt + (size_t)r * ldv + k1 + kc * 8);
        }
      }
      if (hasBias && tid < 64) kp[tid] = kposp[k1 + tid];
      if (KDMA) {
#pragma unroll
        for (int i = 0; i < 6; ++i)
          __builtin_amdgcn_global_load_lds((const unsigned*)(K + (size_t)k1 * ldk + koff[i]),
                                           (unsigned*)((char*)Ks + (w + 4 * i) * 1024), 16, 0, 0);
      }
    }
    __builtin_amdgcn_sched_barrier(0);
    bf16x8 pf[NSUB][2];
#pragma unroll
    for (int sub = 0; sub < NSUB; ++sub) {
      float mx = -1e30f;
#pragma unroll
      for (int kt = 0; kt < 4; ++kt)
#pragma unroll
        for (int j = 0; j < 4; ++j) mx = fmaxf(mx, sacc[kt][sub][j]);
      mx = fmaxf(mx, __shfl_xor(mx, 16));
      mx = fmaxf(mx, __shfl_xor(mx, 32));
      float mnew = fmaxf(mrow[sub], mx + cb);
      float alpha = __builtin_amdgcn_exp2f(mrow[sub] - mnew);
      mrow[sub] = mnew;
      const float off = cb - mnew;
      float ps = 0.f;
      float pv[4][4];
#pragma unroll
      for (int kt = 0; kt < 4; ++kt)
#pragma unroll
        for (int j = 0; j < 4; ++j) {
          pv[kt][j] = __builtin_amdgcn_exp2f(sacc[kt][sub][j] + off);
          ps += pv[kt][j];
        }
      lrow[sub] = lrow[sub] * alpha + ps;
#pragma unroll
      for (int kb = 0; kb < 2; ++kb) {
        u32x4 pu = {pack2(pv[2 * kb][0], pv[2 * kb][1]), pack2(pv[2 * kb][2], pv[2 * kb][3]),
                    pack2(pv[2 * kb + 1][0], pv[2 * kb + 1][1]), pack2(pv[2 * kb + 1][2], pv[2 * kb + 1][3])};
        pf[sub][kb] = __builtin_bit_cast(bf16x8, pu);
      }
      if (__builtin_amdgcn_ballot_w64(alpha != 1.f) != 0) {
#pragma unroll
        for (int et = 0; et < 8; ++et) {
          oacc[et][sub][0] *= alpha; oacc[et][sub][1] *= alpha;
          oacc[et][sub][2] *= alpha; oacc[et][sub][3] *= alpha;
        }
      }
    }
#pragma unroll
    for (int et = 0; et < 8; ++et) {
#pragma unroll
      for (int kb = 0; kb < 2; ++kb) {
        const u16* vp = Vs + (et * 16 + l15) * 72 + kb * 32 + quad * 4;
        u32x2 a0 = *(const u32x2*)vp;
        u32x2 a1 = *(const u32x2*)(vp + 16);
        u32x4 cu = {a0.x, a0.y, a1.x, a1.y};
        bf16x8 vb = __builtin_bit_cast(bf16x8, cu);
#pragma unroll
        for (int sub = 0; sub < NSUB; ++sub)
          oacc[et][sub] = __builtin_amdgcn_mfma_f32_16x16x32_bf16(vb, pf[sub][kb], oacc[et][sub], 0, 0, 0);
      }
      if (et & 1) __builtin_amdgcn_sched_barrier(0);
    }
    if (more) {
      if (KDMA) {
        asm volatile("s_waitcnt vmcnt(0)" ::: "memory");
      } else {
#pragma unroll
        for (int i = 0; i < NKC; ++i) {
          int c = tid + i * 256, r = c / (DQK / 8), kc = c % (DQK / 8);
          *(u32x4*)(Ks + r * LDK + ((kc ^ (r & SW)) * 8)) = kreg[i];
        }
      }
    }
    LBAR();
    if (more) {
#pragma unroll
      for (int i = 0; i < 4; ++i) {
        int c = tid + i * 256, r = c >> 3, kc = c & 7;
        *(u32x4*)(Vs + r * 72 + kc * 8) = vreg[i];
      }
    }
  }
#pragma unroll
  for (int sub = 0; sub < NSUB; ++sub) {
    float lt = lrow[sub];
    lt += __shfl_xor(lt, 16);
    lt += __shfl_xor(lt, 32);
    float inv = 1.f / lt;
    if (ML) {
      inv = 1.f;
      if (quad == 0) *(float2*)(ML + (size_t)(q0 + sub * 16 + l15) * 2) = make_float2(mrow[sub], lt);
    }
    u16* orow = O + (size_t)(q0 + sub * 16 + l15) * 128;
#pragma unroll
    for (int et = 0; et < 8; ++et) {
      uint2 o;
      o.x = pack2(oacc[et][sub][0] * inv, oacc[et][sub][1] * inv);
      o.y = pack2(oacc[et][sub][2] * inv, oacc[et][sub][3] * inv);
      *(uint2*)(orow + et * 16 + quad * 4) = o;
    }
  }
}

#define QB2 (128 / ATT_NSUB)
#define SC_CH 16
#define SC_STEPF 336
typedef float f32x2 __attribute__((ext_vector_type(2)));
struct ScStep { f32x2 kk0, kk1, w0, w1, b0, b1, k0, k1, r0, r1; float v; };
__device__ __forceinline__ ScStep sc_ld(const float* sb, int jg4, int vi) {
  ScStep x;
  f32x4 t;
  t = *(const f32x4*)(sb + jg4);       x.kk0 = t.xy; x.kk1 = t.zw;
  t = *(const f32x4*)(sb + 64 + jg4);  x.w0 = t.xy;  x.w1 = t.zw;
  t = *(const f32x4*)(sb + 128 + jg4); x.b0 = t.xy;  x.b1 = t.zw;
  t = *(const f32x4*)(sb + 192 + jg4); x.k0 = t.xy;  x.k1 = t.zw;
  t = *(const f32x4*)(sb + 256 + jg4); x.r0 = t.xy;  x.r1 = t.zw;
  x.v = sb[320 + vi];
  return x;
}
__device__ __forceinline__ void scan_unit(const Params p, int u, char* smem) {
  char* ws = p.ws;
  const int tid = ltid(), lane = tid & 63, w = tid >> 6;
  const int chain = u >> 2, rg = u & 3, n = chain >> 3, h = chain & 7;
  const int jg = lane & 15, rw = lane >> 4;
  float* buf = (float*)smem;
  const float* a0 = (const float*)(ws + OFF_SCKK) + h * 64;
  const float* a1 = (const float*)(ws + OFF_SCW) + (size_t)n * S_ * 512 + h * 64;
  const float* a2 = (const float*)(ws + OFF_SCB) + (size_t)n * S_ * 512 + h * 64;
  const float* a3 = (const float*)(ws + OFF_SCKD) + (size_t)n * S_ * 512 + h * 64;
  const float* a4 = (const float*)(ws + OFF_SCR) + h * 64;
  const float* vsrc = (const float*)(ws + OFF_SCV) + h * 64 + rg * 16;
  float* ydst = (float*)(ws + OFF_YS) + (size_t)n * S_ * 512 + h * 64 + rg * 16 + w * 4 + rw;

  const float* pb[6];
  int pst[6], pf[6];
#pragma unroll
  for (int i = 0; i < 6; ++i) {
    int f = min(tid + i * 256, SC_CH * 84 - 1);
    int st = f / 84, q = f % 84;
    int a = q >> 4;
    const float* base = a == 0 ? a0 : a == 1 ? a1 : a == 2 ? a2 : a == 3 ? a3 : a == 4 ? a4 : vsrc;
    pb[i] = base + (a < 5 ? (q & 15) * 4 : (q - 80) * 4);
    pst[i] = st;
    pf[i] = f * 4;
  }
  const int sdir = n ? -1 : 1, sbase = n ? (S_ - 1) : 0;
  const int nch = S_ / SC_CH;
  unsigned po[6];
#pragma unroll
  for (int i = 0; i < 6; ++i)
    po[i] = (unsigned)((const char*)(pb[i] + (size_t)(sbase + sdir * pst[i]) * 512) - (const char*)ws);
  const unsigned yo = (unsigned)((const char*)(ydst + (size_t)(sbase + sdir * jg) * 512) - (const char*)ws);
  const int cstep = sdir * SC_CH * 512 * 4;
  f32x4 lregA[6], lregB[6];
#define SC_LOAD(R, CH)                                                            \
  {                                                                               \
    const unsigned d_ = (unsigned)(min((CH), nch - 1) * cstep);                   \
    _Pragma("unroll") for (int i = 0; i < 6; ++i)                                 \
      R[i] = *(const f32x4*)((const char*)ws + (unsigned)(po[i] + d_));           \
  }
#define SC_STORE(R, B)                                                \
  _Pragma("unroll") for (int i = 0; i < 6; ++i) *(f32x4*)(buf + (B) * SC_CH * SC_STEPF + pf[i]) = R[i];

  f32x2 sA = {0.f, 0.f}, sB = {0.f, 0.f};
  const int jg4 = jg * 4, vi = w * 4 + rw;
#define SC_COMPUTE(C, B)                                                              \
  {                                                                                   \
    const float* cb = buf + (B) * SC_CH * SC_STEPF;                                   \
    float ykeep = 0.f;                                                                \
    ScStep cur = sc_ld(cb, jg4, vi);                                                  \
    ScStep nx1 = sc_ld(cb + SC_STEPF, jg4, vi);                                       \
    _Pragma("unroll") for (int st = 0; st < SC_CH; ++st) {                            \
      ScStep nx2 = nx1;                                                               \
      if (st + 2 < SC_CH) nx2 = sc_ld(cb + (st + 2) * SC_STEPF, jg4, vi);             \
      f32x2 sa2 = sA * cur.kk0 + sB * cur.kk1;                                        \
      f32x2 vv = {cur.v, cur.v};                                                      \
      f32x2 uA = sA * cur.w0 + vv * cur.k0;                                           \
      f32x2 uB = sB * cur.w1 + vv * cur.k1;                                           \
      float sa = row16_sum(sa2.x + sa2.y);                                            \
      f32x2 nsa = {-sa, -sa};                                                         \
      sA = uA + nsa * cur.b0;                                                         \
      sB = uB + nsa * cur.b1;                                                         \
      f32x2 y2 = sA * cur.r0 + sB * cur.r1;                                           \
      float y = row16_sum(y2.x + y2.y);                                               \
      ykeep = (jg == st) ? y : ykeep;                                                 \
      cur = nx1;                                                                      \
      nx1 = nx2;                                                                      \
    }                                                                                 \
    *(float*)((char*)ws + (unsigned)(yo + (unsigned)((C) * cstep))) = ykeep;          \
  }

  __syncthreads();
  __builtin_amdgcn_s_setprio(3);
  SC_LOAD(lregA, 0);
  SC_STORE(lregA, 0);
  SC_LOAD(lregB, 1);
  __syncthreads();
  for (int c = 0; c < nch; c += 2) {
    SC_LOAD(lregA, c + 2);
    SC_COMPUTE(c, 0);
    SC_STORE(lregB, 1);
    LBAR();
    SC_LOAD(lregB, c + 3);
    SC_COMPUTE(c + 1, 1);
    SC_STORE(lregA, 0);
    LBAR();
  }
  __builtin_amdgcn_s_setprio(0);
}

template <int ATM>
__device__ __forceinline__ void phase_attn_scan(const Params p, int l, char* smem) {
  char* ws = p.ws;
  __shared__ int s_item;
  if (ATM & 8) for (int u = lbid(); u < 64; u += gridDim.x) scan_unit(p, u, smem);
  if ((ATM & 8) && (DUP_MASK & 2)) for (int u = lbid(); u < 64; u += gridDim.x) scan_unit(p, u, smem);
  int* cnt = (int*)(ws + OFF_CNT) + l * 4;
  const int* pos = (const int*)p.in[I_POS];
  const int* kpmm = (const int*)(ws + OFF_KPMM);
  const u16* P = (const u16*)(ws + OFF_P);
  u16* OB = (u16*)(ws + OFF_OB);
#define NEXT_ITEM(CI, LIMIT)                                   \
    __syncthreads();                                           \
    if (ltid() == 0) s_item = atomicAdd(cnt + (CI), 1);   \
    __syncthreads();                                           \
    const int it = s_item;                                     \
    if (it >= (LIMIT)) break;
  u16* OB2 = (u16*)(ws + OFF_OB2);
  float* MLb = (float*)(ws + OFF_ML);
  const int flip = (blockIdx.x >> 8) & 1;
  for (int pass = 0; pass < 2; ++pass) {
  const int which = pass ^ flip;
  if (which == 0) {
  if (ATM & 1) while (true) {
    NEXT_ITEM(0, 512)
    int hh = it >> 6, qb = it & 63, h = hh >> 1, half = hh & 1;
    const int kv0 = half * (S_ / 2);
    attn_item<192, 2>((const u16*)(ws + OFF_QM) + (size_t)h * S_ * 192, 192,
                      (const u16*)(ws + OFF_KM) + ((size_t)h * S_ + kv0) * 192, 192,
                      (const u16*)(ws + OFF_VTM) + (size_t)h * 128 * S_ + kv0, S_, S_ / 2,
                      (half ? OB2 : OB) + (size_t)(8 + h) * S_ * 128, qb, false, nullptr, 0, pos, kpmm, smem, pos,
                      MLb + ((size_t)half * 16 + 8 + h) * S_ * 2);
  }
  } else {
  if (ATM & 2) while (true) {
    NEXT_ITEM(1, 16 * QB2)
    int pp = it / QB2, qb = it % QB2, pr = pp >> 1, half = pp & 1, h = pr >> 1, hf = pr & 1;
    const int kv0 = half * (S_ / 2);
    attn_item<64, ATT_NSUB>(P + O_DQ + h * 128 + hf * 64, NINP, P + (size_t)kv0 * NINP + O_DK + h * 128 + hf * 64, NINP,
                            (const u16*)(ws + OFF_VTD) + (size_t)h * 128 * S_ + kv0, S_, S_ / 2,
                            (half ? OB2 : OB) + (size_t)pr * S_ * 128, qb, true, (const float*)p.in[I_RELB], h, pos,
                            kpmm + (kv0 / 64) * 2, smem, pos + kv0, MLb + ((size_t)half * 16 + pr) * S_ * 2);
  }
  }
  }
  if (ATM & 4) while (true) {
    NEXT_ITEM(2, 4 * QB2)
    int h = it / QB2, qb = it % QB2;
    attn_item<128, ATT_NSUB>(P + O_MQ + h * 128, NINP, (const u16*)(ws + OFF_KMEM) + (size_t)(l * 4 + h) * 256 * 128, 128,
                             (const u16*)(ws + OFF_VTMEM) + (size_t)(l * 4 + h) * 128 * 256, 256, 256,
                             OB + (size_t)(12 + h) * S_ * 128, qb, false, nullptr, 0, pos, kpmm, smem, pos, nullptr);
  }
}

__device__ __forceinline__ void phase_combine(const Params p, int l, char* smem) {
  char* ws = p.ws;
  const int lane = ltid() & 63, w = ltid() >> 6;
  const float lam_init = 0.8f - 0.6f * expf(-0.3f * (float)l);
  float lam;
  {
    const float* lq = (const float*)p.in[I_DLAM] + l * 256;
    float a = wave_sum(lq[lane] * lq[64 + lane]);
    float b = wave_sum(lq[128 + lane] * lq[192 + lane]);
    lam = expf(a) - expf(b) + lam_init;
  }
  const float* gng = (const float*)p.in[I_GNG] + l * 512;
  const float* gnb = (const float*)p.in[I_GNB] + l * 512;
  const float* subg = (const float*)p.in[I_DSUBG] + l * 128;
  const u16* P = (const u16*)(ws + OFF_P);
  const float* YS = (const float*)(ws + OFF_YS);
  const u16* OB = (const u16*)(ws + OFF_OB);
  const u16* OB2c = (const u16*)(ws + OFF_OB2);
  const float* MLp = (const float*)(ws + OFF_ML);
  u16* YG = (u16*)(ws + OFF_YG);
  for (int s = lbid() * 4 + w; s < S_; s += gridDim.x * 4) {
    const u16* grow = P + (size_t)s * NINP + O_G;
#pragma unroll
    for (int hp = 0; hp < 4; ++hp) {
      const int c = hp * 128 + 2 * lane, h = hp * 2 + (lane >> 5);
      const float2 ya = *(const float2*)(YS + (size_t)s * 512 + c);
      const float2 yb = *(const float2*)(YS + ((size_t)S_ + s) * 512 + c);
      float y0 = ya.x + yb.x, y1 = ya.y + yb.y;
      float sm = y0 + y1;
#pragma unroll
      for (int o = 16; o >= 1; o >>= 1) sm += __shfl_xor(sm, o);
      const float mu = sm * (1.f / 64);
      const float d0 = y0 - mu, d1 = y1 - mu;
      float vs = d0 * d0 + d1 * d1;
#pragma unroll
      for (int o = 16; o >= 1; o >>= 1) vs += __shfl_xor(vs, o);
      const float rstd = rsqrtf(vs * (1.f / 64) + 64e-5f);
      const float2 gg = *(const float2*)(gng + c), gb = *(const float2*)(gnb + c);
      const float bon = ((const float*)(ws + OFF_BONUS))[s * 8 + h];
      const float2 vv = *(const float2*)((const float*)(ws + OFF_SCV) + (size_t)s * 512 + c);
      float o0 = d0 * rstd * gg.x + gb.x + bon * vv.x;
      float o1 = d1 * rstd * gg.y + gb.y + bon * vv.y;
      const unsigned gt = *(const unsigned*)(grow + c);
      const float g0 = lo2f(gt), g1 = hi2f(gt);
      *(unsigned*)(YG + (size_t)s * 512 + c) = pack2(o0 * g0 * sigmoidf_(g0), o1 * g1 * sigmoidf_(g1));
    }
#define MERGE_LOAD(PR, A, B)                                                                   \
    {                                                                                          \
      const float2 ml0 = *(const float2*)(MLp + ((size_t)(PR) * S_ + s) * 2);                  \
      const float2 ml1 = *(const float2*)(MLp + ((size_t)(16 + (PR)) * S_ + s) * 2);           \
      const float mm = fmaxf(ml0.x, ml1.x);                                                    \
      const float w0 = __builtin_amdgcn_exp2f(ml0.x - mm), w1 = __builtin_amdgcn_exp2f(ml1.x - mm); \
      const float inv = 1.f / (w0 * ml0.y + w1 * ml1.y);                                       \
      const unsigned q0 = *(const unsigned*)(OB + ((size_t)(PR) * S_ + s) * 128 + 2 * lane);   \
      const unsigned q1 = *(const unsigned*)(OB2c + ((size_t)(PR) * S_ + s) * 128 + 2 * lane); \
      A = (w0 * lo2f(q0) + w1 * lo2f(q1)) * inv;                                               \
      B = (w0 * hi2f(q0) + w1 * hi2f(q1)) * inv;                                               \
    }
#pragma unroll
    for (int h = 0; h < 4; ++h) {
      float a1, b1, a2, b2;
      MERGE_LOAD(h * 2, a1, b1)
      MERGE_LOAD(h * 2 + 1, a2, b2)
      float a = a1 - lam * a2, b = b1 - lam * b2;
      float ss = wave_sum(a * a + b * b);
      float rs = rsqrtf(ss * (1.f / 128) + 1e-6f) * (1.f - lam_init);
      const unsigned gg = *(const unsigned*)(grow + 512 + h * 128 + 2 * lane);
      float g0 = lo2f(gg), g1 = hi2f(gg);
      const float2 sg = *(const float2*)(subg + 2 * lane);
      u16* dst = YG + ((size_t)S_ + s) * 512 + h * 128;
      *(unsigned*)(dst + 2 * lane) = pack2(a * rs * sg.x * g0 * sigmoidf_(g0), b * rs * sg.y * g1 * sigmoidf_(g1));
    }
#pragma unroll
    for (int br = 2; br < 4; ++br) {
#pragma unroll
      for (int h = 0; h < 4; ++h) {
        float oa, ob;
        if (br == 2) {
          MERGE_LOAD(8 + h, oa, ob)
        } else {
          const unsigned o = *(const unsigned*)(OB + ((size_t)(12 + h) * S_ + s) * 128 + 2 * lane);
          oa = lo2f(o);
          ob = hi2f(o);
        }
        const unsigned gg = *(const unsigned*)(grow + br * 512 + h * 128 + 2 * lane);
        float g0 = lo2f(gg), g1 = hi2f(gg);
        u16* dst = YG + ((size_t)br * S_ + s) * 512 + h * 128;
        *(unsigned*)(dst + 2 * lane) = pack2(oa * g0 * sigmoidf_(g0), ob * g1 * sigmoidf_(g1));
      }
    }
#undef MERGE_LOAD
  }
}

#define XB_TMO      128
#define XB_XCNT(j)  (256  + 64 * (j))
#define XB_XSUB(j)  (1280 + 64 * (j))
#define XB_XGEN(j)  (2304 + 64 * (j))
#define XB_TOP      3328
#define XB_TOPGEN   3392
#define XCD_BAR_WORDS 3456
#define XB_SPIN_CAP (1u << 22)
#define LAS __attribute__((address_space(3)))
__device__ __forceinline__ unsigned xb_ld(unsigned* p)              { return __hip_atomic_load(p, __ATOMIC_RELAXED, __HIP_MEMORY_SCOPE_AGENT); }
__device__ __forceinline__ unsigned xb_add(unsigned* p, unsigned v) { return __hip_atomic_fetch_add(p, v, __ATOMIC_RELAXED, __HIP_MEMORY_SCOPE_AGENT); }
__device__ __forceinline__ unsigned xb_xcc_id() { return (unsigned)__builtin_amdgcn_s_getreg((3 << 11) | 20) & 0xFu; }
#define XB_SPIN(cond, bar) do { unsigned _sp = 0; while (cond) { __builtin_amdgcn_s_sleep(1); \
    if ((++_sp & 255u) == 0u) { if (xb_ld(&(bar)[XB_TMO])) break; if (_sp > XB_SPIN_CAP) { atomicAdd(&(bar)[XB_TMO], 1u); break; } } } } while (0)
struct XcdBarrier { unsigned* bar; unsigned x; volatile LAS unsigned* st; };
__device__ __forceinline__ XcdBarrier xcd_barrier_post(unsigned* bar, volatile LAS unsigned* st) {
  XcdBarrier b; b.bar = bar; b.x = xb_xcc_id(); b.st = st;
  if (threadIdx.x == 0) (void)xb_add(&bar[XB_XCNT(b.x)], 1u);
  return b;
}
__device__ __forceinline__ void xcd_barrier_complete(unsigned* bar, unsigned x, unsigned& nloc, unsigned& nx) {
  const unsigned G = gridDim.x * gridDim.y * gridDim.z;
  unsigned sum, cnt, mine, sp = 0u;
  for (;;) {
    sum = 0u; cnt = 0u; mine = 0u;
#pragma unroll
    for (unsigned j = 0; j < 16; ++j) { const unsigned c = xb_ld(&bar[XB_XCNT(j)]); sum += c; cnt += (c > 0u) ? 1u : 0u; mine = (j == x) ? c : mine; }
    if (sum == G) break;
    __builtin_amdgcn_s_sleep(1);
    if ((++sp & 255u) == 0u) { if (xb_ld(&bar[XB_TMO])) break; if (sp > XB_SPIN_CAP) { atomicAdd(&bar[XB_TMO], 1u); break; } }
  }
  nloc = mine > 0u ? mine : 1u; nx = cnt > 0u ? cnt : 1u;
}
__device__ __forceinline__ void xcd_barrier(const XcdBarrier& b) {
  asm volatile("s_waitcnt vmcnt(0)" ::: "memory");
  __syncthreads();
  if (threadIdx.x == 0) {
    unsigned* bar = b.bar;
    __builtin_amdgcn_s_waitcnt(0);
    unsigned nloc = b.st[0], nx = b.st[1];
    if (nloc == 0u) { xcd_barrier_complete(bar, b.x, nloc, nx); b.st[0] = nloc; b.st[1] = nx; }
    const unsigned old = xb_add(&bar[XB_XSUB(b.x)], 1u);
    const unsigned gen = old / nloc;
    if (old + 1u == (gen + 1u) * nloc) {
      __builtin_amdgcn_fence(__ATOMIC_RELEASE, "agent");
      asm volatile("s_waitcnt vmcnt(0)" ::: "memory");
      const unsigned og = xb_add(&bar[XB_TOP], 1u);
      const unsigned tg = og / nx;
      if (og + 1u == (tg + 1u) * nx) xb_add(&bar[XB_TOPGEN], 1u);
      else XB_SPIN(xb_ld(&bar[XB_TOPGEN]) == tg, bar);
      __builtin_amdgcn_fence(__ATOMIC_ACQUIRE, "agent");
      xb_add(&bar[XB_XGEN(b.x)], 1u);
      asm volatile("s_waitcnt vmcnt(0)" ::: "memory");
    } else {
      XB_SPIN(xb_ld(&bar[XB_XGEN(b.x)]) == gen, bar);
      __builtin_amdgcn_fence(__ATOMIC_ACQUIRE, "agent");
      asm volatile("s_waitcnt vmcnt(0)" ::: "memory");
    }
  }
  __syncthreads();
}

#define N_PHASES (1 + 9 * L_)

__global__ void __launch_bounds__(256, 2) mega(Params p, int ph_lo, int ph_hi) {
  __shared__ __attribute__((aligned(16))) char smem[SMEM_BYTES];
  cg::grid_group grid = cg::this_grid();
  __shared__ uint4 xb_words;
  if (threadIdx.x == 0) xb_words = make_uint4(0u, 0u, 0u, 0u);
  __syncthreads();
  XcdBarrier xb = xcd_barrier_post((unsigned*)(p.ws + OFF_BAR), (volatile LAS unsigned*)&xb_words);
  __shared__ int s_vbid, s_cand;
  if (threadIdx.x == 0) {
    int my_j = (int)xb_add((unsigned*)(p.ws + OFF_BAR) + 8 * xb.x, 1u);
    s_cand = my_j * 8 + (int)xb.x;
    s_vbid = blockIdx.x;
  }
#define VB s_vbid
  for (int ph = ph_lo; ph < ph_hi; ++ph) {
    if (ph == 0) {
      if (PH_MASK & 1) phase_w(p, smem);
    } else {
      int l = (ph - 1) / 9, sp = (ph - 1) % 9;
      switch (sp) {
        case 0: if (PH_MASK & 2) phase_gemm_in(p, l, smem, VB);
          if (DUP_MASK & 1) { __syncthreads(); phase_gemm_in(p, l, smem, VB); }
          break;
        case 1: if (PH_MASK & 4) phase_prep<false>(p, l, smem);
          if (DUP_MASK & 256) { __syncthreads(); phase_prep<true>(p, l, smem); }
          break;
        case 2: if (PH_MASK & 8) phase_gemm_mla(p, l, smem, VB);
          if (DUP_MASK & 16) { __syncthreads(); phase_gemm_mla(p, l, smem, VB); }
          break;
        case 3: if (PH_MASK & 16) phase_mla_post(p, l, smem);
          if (DUP_MASK & 32) { __syncthreads(); phase_mla_post(p, l, smem); }
          break;
        case 4: if (PH_MASK & 32) phase_attn_scan<AT_MASK>(p, l, smem); break;
        case 5: if (PH_MASK & 64) phase_combine(p, l, smem);
          if (DUP_MASK & 64) { __syncthreads(); phase_combine(p, l, smem); }
          break;
        case 6: if (PH_MASK & 128) phase_gemm_branch(p, l, smem, VB);
          if (DUP_MASK & 4) { __syncthreads(); phase_gemm_branch(p, l, smem, VB); }
          break;
        case 7: if (PH_MASK & 256) phase_gemm_out(p, l, smem, VB); break;
        case 8:
          if (l + 1 < L_) rms_rows<true>((const float*)p.out, S_, (const float*)p.in[I_NORMG] + (l + 1) * D_, (u16*)(p.ws + OFF_H));
          if ((DUP_MASK & 128) && l + 1 < L_) rms_rows<true>((const float*)p.out, S_, (const float*)p.in[I_NORMG] + (l + 1) * D_, (u16*)(p.ws + OFF_H));
          break;
      }
    }
#undef VB
    if (ph + 1 < ph_hi) {
      if (ph == ph_lo) {
        if (ph_hi < 0) grid.sync();
        xcd_barrier(xb);
        if (threadIdx.x == 0 && gridDim.x == 512) {
          bool ok = true;
          for (int j = 0; j < 8; ++j) ok = ok && (xb_ld((unsigned*)(p.ws + OFF_BAR) + 8 * j) == 64u);
          if (ok && xb.x < 8u) s_vbid = s_cand;
        }
        __syncthreads();
      } else xcd_barrier(xb);
    }
  }
}

template <int SP, int ATM>
__global__ void __launch_bounds__(256, 2) k_phase(Params p, int l) {
  __shared__ __attribute__((aligned(16))) char smem[SMEM_BYTES];
  const int VB = blockIdx.x;
  if (SP == -1) phase_w(p, smem);
  if (SP == 0) phase_gemm_in(p, l, smem, VB);
  if (SP == 1) phase_prep<false>(p, l, smem);
  if (SP == 2) phase_gemm_mla(p, l, smem, VB);
  if (SP == 3) phase_mla_post(p, l, smem);
  if (SP == 4) phase_attn_scan<ATM>(p, l, smem);
  if (SP == 5) phase_combine(p, l, smem);
  if (SP == 6) phase_gemm_branch(p, l, smem, VB);
  if (SP == 7) phase_gemm_out(p, l, smem, VB);
  if (SP == 8) rms_rows<true>((const float*)p.out, S_, (const float*)p.in[I_NORMG] + (l + 1) * D_, (u16*)(p.ws + OFF_H));
}

extern "C" void kernel_launch(void* const* d_in, const int* in_sizes, int n_in, void* d_out, int out_size, void* d_ws,
                              size_t ws_size, hipStream_t stream) {
  static int grid_blocks = 0;
  if (!grid_blocks) {
    int dev = 0, cus = 0, per_cu = 0;
    hipGetDevice(&dev);
    hipDeviceGetAttribute(&cus, hipDeviceAttributeMultiprocessorCount, dev);
    hipOccupancyMaxActiveBlocksPerMultiprocessor(&per_cu, mega, 256, 0);
    if (per_cu > 2) per_cu = 2;
    if (per_cu < 1) per_cu = 1;
    grid_blocks = cus * per_cu;
  }
  Params p{};
  for (int i = 0; i < N_INPUTS; ++i) p.in[i] = d_in[i];
  p.out = (float*)d_out;
  p.ws = (char*)d_ws;
  if (ws_size < WS_TOTAL) fprintf(stderr, "workspace too small: %zu < %zu\n", ws_size, (size_t)WS_TOTAL);
#if MULTI_LAUNCH
  const int G = grid_blocks;
  hipLaunchKernelGGL((k_phase<-1, 0>), dim3(G), dim3(256), 0, stream, p, 0);
  for (int l = 0; l < L_; ++l) {
    hipLaunchKernelGGL((k_phase<0, 0>), dim3(G), dim3(256), 0, stream, p, l);
    hipLaunchKernelGGL((k_phase<1, 0>), dim3(G), dim3(256), 0, stream, p, l);
    hipLaunchKernelGGL((k_phase<2, 0>), dim3(G), dim3(256), 0, stream, p, l);
    hipLaunchKernelGGL((k_phase<3, 0>), dim3(G), dim3(256), 0, stream, p, l);
    hipLaunchKernelGGL((k_phase<4, 8>), dim3(64), dim3(256), 0, stream, p, l);
    hipLaunchKernelGGL((k_phase<4, 1>), dim3(G), dim3(256), 0, stream, p, l);
    hipLaunchKernelGGL((k_phase<4, 2>), dim3(G), dim3(256), 0, stream, p, l);
    hipLaunchKernelGGL((k_phase<4, 4>), dim3(G), dim3(256), 0, stream, p, l);
    hipLaunchKernelGGL((k_phase<5, 0>), dim3(G), dim3(256), 0, stream, p, l);
    hipLaunchKernelGGL((k_phase<6, 0>), dim3(G), dim3(256), 0, stream, p, l);
    hipLaunchKernelGGL((k_phase<7, 0>), dim3(G), dim3(256), 0, stream, p, l);
    if (l + 1 < L_) hipLaunchKernelGGL((k_phase<8, 0>), dim3(G), dim3(256), 0, stream, p, l);
  }
#else
  hipMemsetAsync((char*)d_ws + OFF_BAR, 0, 3456 * 4, stream);
  int lo = 0, hi = N_PHASES - 1;
  void* args[] = {&p, &lo, &hi};
  hipError_t e = hipLaunchCooperativeKernel((void*)mega, dim3(grid_blocks), dim3(256), args, 0, stream);
  if (e != hipSuccess) fprintf(stderr, "cooperative launch failed: %s (grid %d)\n", hipGetErrorString(e), grid_blocks);
#endif
}
```

```cpp
#include <hip/hip_runtime.h>
#include <hip/hip_cooperative_groups.h>
#include <cstdio>
namespace cg = cooperative_groups;

typedef unsigned short u16;
typedef __attribute__((ext_vector_type(8))) short bf16x8;
typedef __attribute__((ext_vector_type(4))) float f32x4;
typedef __attribute__((ext_vector_type(4))) unsigned int u32x4;
typedef __attribute__((ext_vector_type(2))) unsigned int u32x2;

#ifndef MULTI_LAUNCH
#define MULTI_LAUNCH 0
#endif
#ifndef DUP_MASK
#define DUP_MASK 0
#endif
#ifndef ATT_NSUB
#define ATT_NSUB 2
#endif
#ifndef AT_MASK
#define AT_MASK 15
#endif
#ifndef PH_MASK
#if MULTI_LAUNCH
#define PH_MASK 0
#else
#define PH_MASK 0xffff
#endif
#endif


#define LOG2E 1.4426950408889634f
#define S_ 8192
#define D_ 2048
#define NIN 14784
#define NINP 14848
#define L_ 4
#define O_DQ 1792
#define O_DK 2304
#define O_DV 2816
#define O_QL 3328
#define O_KVL 3712
#define O_KR 3968
#define O_MQ 4032
#define O_G 4544
#define O_MG 6592

enum { I_X = 0, I_MEM, I_POS, I_NORMG, I_WIN, I_SHIFT, I_W0, I_WUP, I_A0, I_AUP, I_KK, I_KA, I_RK, I_GNG, I_GNB,
       I_DQKG, I_DLAM, I_DSUBG, I_RELB, I_QLATG, I_KVLATG, I_WUQ, I_WUKV, I_NOPEG, I_ROPEG, I_MEMNG, I_WKV,
       I_MQKG, I_WBR, I_WOUT, N_INPUTS };

struct Params {
  const void* in[N_INPUTS];
  float* out;
  char* ws;
};

constexpr size_t al(size_t x) { return (x + 255) & ~(size_t)255; }
constexpr size_t OFF_WIN = 0;
constexpr size_t OFF_WB = OFF_WIN + al((size_t)L_ * NINP * D_ * 2);
constexpr size_t OFF_WO = OFF_WB + al((size_t)L_ * 4 * 2048 * 512 * 2);
constexpr size_t OFF_WUQ = OFF_WO + al((size_t)L_ * 2048 * 2048 * 2);
constexpr size_t OFF_WUKV = OFF_WUQ + al((size_t)L_ * 768 * 384 * 2);
constexpr size_t OFF_WKV = OFF_WUKV + al((size_t)L_ * 1024 * 256 * 2);
constexpr size_t OFF_MEMN = OFF_WKV + al((size_t)L_ * 1024 * 2048 * 2);
constexpr size_t OFF_KVMEM = OFF_MEMN + al((size_t)L_ * 256 * 2048 * 2);
constexpr size_t OFF_KMEM = OFF_KVMEM + al((size_t)L_ * 256 * 512 * 4);
constexpr size_t OFF_VTMEM = OFF_KMEM + al((size_t)L_ * 4 * 256 * 128 * 2);
constexpr size_t OFF_H = OFF_VTMEM + al((size_t)L_ * 4 * 128 * 256 * 2);
constexpr size_t OFF_P = OFF_H + al((size_t)S_ * D_ * 2);
constexpr size_t OFF_RWU = OFF_P + al((size_t)S_ * NINP * 2);
constexpr size_t OFF_SCR = OFF_RWU + al((size_t)S_ * 1792 * 4);
constexpr size_t OFF_SCV = OFF_SCR + al((size_t)S_ * 512 * 4);
constexpr size_t OFF_SCKK = OFF_SCV + al((size_t)S_ * 512 * 4);
constexpr size_t OFF_SCW = OFF_SCKK + al((size_t)S_ * 512 * 4);
constexpr size_t OFF_SCKD = OFF_SCW + al((size_t)2 * S_ * 512 * 4);
constexpr size_t OFF_SCB = OFF_SCKD + al((size_t)2 * S_ * 512 * 4);
constexpr size_t OFF_BONUS = OFF_SCB + al((size_t)2 * S_ * 512 * 4);
constexpr size_t OFF_YS = OFF_BONUS + al((size_t)S_ * 8 * 4);
constexpr size_t OFF_MQ = OFF_YS + al((size_t)2 * S_ * 512 * 4);
constexpr size_t OFF_MKV = OFF_MQ + al((size_t)S_ * 768 * 4);
constexpr size_t OFF_QM = OFF_MKV + al((size_t)S_ * 512 * 4);
constexpr size_t OFF_KM = OFF_QM + al((size_t)4 * S_ * 192 * 2);
constexpr size_t OFF_VTM = OFF_KM + al((size_t)4 * S_ * 192 * 2);
constexpr size_t OFF_VTD = OFF_VTM + al((size_t)4 * 128 * S_ * 2);
constexpr size_t OFF_OB = OFF_VTD + al((size_t)4 * 128 * S_ * 2);
constexpr size_t OFF_YG = OFF_OB + al((size_t)16 * S_ * 128 * 4);
constexpr size_t OFF_Z = OFF_YG + al((size_t)4 * S_ * 512 * 2);
constexpr size_t OFF_CNT = OFF_Z + al((size_t)S_ * D_ * 2);
constexpr size_t OFF_KPMM = OFF_CNT + 256;
constexpr size_t OFF_BAR = OFF_KPMM + 1024;
constexpr size_t OFF_OB2 = OFF_BAR + al(3456 * 4);
constexpr size_t OFF_ML = OFF_OB2 + al((size_t)16 * S_ * 128 * 4);
constexpr size_t WS_TOTAL = OFF_ML + (size_t)2 * 16 * S_ * 2 * 4;

#define SMEM_BYTES 49152

#define LBAR() asm volatile("s_waitcnt lgkmcnt(0)\n\ts_barrier" ::: "memory")
__device__ __forceinline__ int ltid() {
  int t = __builtin_amdgcn_workitem_id_x();
  asm volatile("" : "+v"(t));
  return t;
}
__device__ __forceinline__ int lbid() {
  int t = __builtin_amdgcn_workgroup_id_x();
  asm volatile("" : "+s"(t));
  return t;
}
typedef float f32x2_ __attribute__((ext_vector_type(2)));
typedef __bf16 bf16x2_ __attribute__((ext_vector_type(2)));
__device__ __forceinline__ unsigned pack2(float a, float b) {
  f32x2_ v = {a, b};
  return __builtin_bit_cast(unsigned, __builtin_convertvector(v, bf16x2_));
}
__device__ __forceinline__ u16 f2bf(float f) { return (u16)(pack2(f, 0.f) & 0xffffu); }
__device__ __forceinline__ float bf2f(u16 h) { return __uint_as_float(((unsigned)h) << 16); }
__device__ __forceinline__ float lo2f(unsigned u) { return __uint_as_float(u << 16); }
__device__ __forceinline__ float hi2f(unsigned u) { return __uint_as_float(u & 0xffff0000u); }
__device__ __forceinline__ float sigmoidf_(float x) { return 1.f / (1.f + __expf(-x)); }
__device__ __forceinline__ float wave_sum(float v) {
#pragma unroll
  for (int o = 32; o >= 1; o >>= 1) v += __shfl_xor(v, o);
  return v;
}
template <int CTRL>
__device__ __forceinline__ float dpp_add(float x) {
  return x + __int_as_float(__builtin_amdgcn_update_dpp(0, __float_as_int(x), CTRL, 0xf, 0xf, true));
}
__device__ __forceinline__ float row16_sum(float x) {
  x = dpp_add<0xB1>(x);
  x = dpp_add<0x4E>(x);
  x = dpp_add<0x141>(x);
  x = dpp_add<0x140>(x);
  return x;
}

template <bool SW>
__device__ __forceinline__ void gemm_main1(const u16* __restrict__ A, int lda, const u16* __restrict__ B, int ldb,
                                          int K, u16* As, u16* Bs, f32x4 (&acc)[4][4]) {
  const int tid = ltid(), lane = tid & 63, w = tid >> 6, l15 = lane & 15, quad = lane >> 4;
  const int wm = w >> 1, wn = w & 1;
  u32x4 ra[4], rb[4];
#pragma unroll
  for (int i = 0; i < 4; ++i) {
    int c = tid + i * 256, r = c >> 3, kc = c & 7;
    ra[i] = *(const u32x4*)(A + (size_t)r * lda + kc * 8);
    rb[i] = *(const u32x4*)(B + (size_t)r * ldb + kc * 8);
  }
  for (int k0 = 0; k0 < K; k0 += 64) {
    LBAR();
#pragma unroll
    for (int i = 0; i < 4; ++i) {
      int c = tid + i * 256, r = c >> 3, kc = c & 7;
      *(u32x4*)(As + r * 64 + ((kc ^ (r & 7)) * 8)) = ra[i];
      *(u32x4*)(Bs + r * 64 + ((kc ^ (r & 7)) * 8)) = rb[i];
    }
    LBAR();
    {
      const int kn = min(k0 + 64, K - 64);
#pragma unroll
      for (int i = 0; i < 4; ++i) {
        int c = tid + i * 256, r = c >> 3, kc = c & 7;
        ra[i] = *(const u32x4*)(A + (size_t)r * lda + kn + kc * 8);
        rb[i] = *(const u32x4*)(B + (size_t)r * ldb + kn + kc * 8);
      }
    }
#pragma unroll
    for (int ks = 0; ks < 2; ++ks) {
      bf16x8 af[4], bfr[4];
#pragma unroll
      for (int i = 0; i < 4; ++i) {
        af[i] = *(const bf16x8*)(As + (wm * 64 + i * 16 + l15) * 64 + (((ks * 4 + quad) ^ (l15 & 7)) * 8));
        bfr[i] = *(const bf16x8*)(Bs + (wn * 64 + i * 16 + l15) * 64 + (((ks * 4 + quad) ^ (l15 & 7)) * 8));
      }
#pragma unroll
      for (int i = 0; i < 4; ++i)
#pragma unroll
        for (int j = 0; j < 4; ++j) acc[i][j] = SW ? __builtin_amdgcn_mfma_f32_16x16x32_bf16(bfr[j], af[i], acc[i][j], 0, 0, 0)
                                                     : __builtin_amdgcn_mfma_f32_16x16x32_bf16(af[i], bfr[j], acc[i][j], 0, 0, 0);
    }
  }
}

template <bool SW>
__device__ __forceinline__ void gemm_main(const u16* __restrict__ A, int lda, const u16* __restrict__ B, int ldb,
                                          int K, u16* As, u16* Bs, f32x4 (&acc)[4][4]) {
  const int tid = ltid(), lane = tid & 63, w = tid >> 6, l15 = lane & 15, quad = lane >> 4;
  const int wm = w >> 1, wn = w & 1;
  u32x4 ra0[4], rb0[4], ra1[4], rb1[4];
  const u16* Ap = A + (size_t)(tid >> 3) * lda + (tid & 7) * 8;
  const u16* Bp = B + (size_t)(tid >> 3) * ldb + (tid & 7) * 8;
  const size_t sa = (size_t)32 * lda, sb = (size_t)32 * ldb;
#define G_LOAD(RA, RB, KK)                                            \
  {                                                                   \
    const int kk_ = min((KK), K - 64);                                \
    _Pragma("unroll") for (int i = 0; i < 4; ++i) {                   \
      RA[i] = *(const u32x4*)(Ap + i * sa + kk_);                     \
      RB[i] = *(const u32x4*)(Bp + i * sb + kk_);                     \
    }                                                                 \
  }
#define G_STAGE(RA, RB, KNEXT)                                                                   \
  {                                                                                              \
    LBAR();                                                                             \
    _Pragma("unroll") for (int i = 0; i < 4; ++i) {                                              \
      *(u32x4*)(As + ((tid >> 3) + i * 32) * 64 + (((tid & 7) ^ ((tid >> 3) & 7)) * 8)) = RA[i]; \
      *(u32x4*)(Bs + ((tid >> 3) + i * 32) * 64 + (((tid & 7) ^ ((tid >> 3) & 7)) * 8)) = RB[i]; \
    }                                                                                            \
    LBAR();                                                                             \
    G_LOAD(RA, RB, KNEXT)                                                                        \
    {                                                                                            \
      bf16x8 af[2][4], bfr[2][4];                                                                \
      _Pragma("unroll") for (int ks = 0; ks < 2; ++ks)                                           \
        _Pragma("unroll") for (int i = 0; i < 4; ++i) {                                          \
          af[ks][i] = *(const bf16x8*)(As + (wm * 64 + i * 16 + l15) * 64 + (((ks * 4 + quad) ^ (l15 & 7)) * 8));  \
          bfr[ks][i] = *(const bf16x8*)(Bs + (wn * 64 + i * 16 + l15) * 64 + (((ks * 4 + quad) ^ (l15 & 7)) * 8)); \
        }                                                                                        \
      __builtin_amdgcn_sched_barrier(0);                                                         \
      _Pragma("unroll") for (int ks = 0; ks < 2; ++ks)                                           \
        _Pragma("unroll") for (int i = 0; i < 4; ++i)                                            \
          _Pragma("unroll") for (int j = 0; j < 4; ++j)                                          \
            acc[i][j] = SW ? __builtin_amdgcn_mfma_f32_16x16x32_bf16(bfr[ks][j], af[ks][i], acc[i][j], 0, 0, 0) \
                           : __builtin_amdgcn_mfma_f32_16x16x32_bf16(af[ks][i], bfr[ks][j], acc[i][j], 0, 0, 0); \
    }                                                                                            \
  }
  G_LOAD(ra0, rb0, 0)
  G_LOAD(ra1, rb1, 64)
  for (int k0 = 0; k0 < K; k0 += 128) {
    G_STAGE(ra0, rb0, k0 + 128)
    G_STAGE(ra1, rb1, k0 + 192)
  }
#undef G_LOAD
#undef G_STAGE
}

__device__ __forceinline__ void gemm_main_blk(const u16* __restrict__ A, const u16* __restrict__ B,
                                          int K, u16* As, u16* Bs, f32x4 (&acc)[4][4]) {
  const int tid = ltid(), lane = tid & 63, w = tid >> 6, l15 = lane & 15, quad = lane >> 4;
  const int wm = w >> 1, wn = w & 1;
  u32x4 ra0[4], rb0[4], ra1[4], rb1[4];
  const u16* Ap = A + tid * 8;
  const u16* Bp = B + tid * 8;
#define G_LOAD(RA, RB, KK)                                            \
  {                                                                   \
    const int kk_ = min((KK), K - 64);                                \
    _Pragma("unroll") for (int i = 0; i < 4; ++i) {                   \
      RA[i] = *(const u32x4*)(Ap + (size_t)kk_ * 128 + i * 2048);    \
      RB[i] = *(const u32x4*)(Bp + (size_t)kk_ * 128 + i * 2048);    \
    }                                                                 \
  }
#define G_STAGE(RA, RB, KNEXT)                                                                   \
  {                                                                                              \
    LBAR();                                                                             \
    _Pragma("unroll") for (int i = 0; i < 4; ++i) {                                              \
      *(u32x4*)(As + i * 2048 + tid * 8) = RA[i];                                                \
      *(u32x4*)(Bs + i * 2048 + tid * 8) = RB[i];                                                \
    }                                                                                            \
    LBAR();                                                                             \
    G_LOAD(RA, RB, KNEXT)                                                                        \
    {                                                                                            \
      bf16x8 af[2][4], bfr[2][4];                                                                \
      _Pragma("unroll") for (int ks = 0; ks < 2; ++ks)                                           \
        _Pragma("unroll") for (int i = 0; i < 4; ++i) {                                          \
          af[ks][i] = *(const bf16x8*)(As + (wm * 64 + i * 16 + l15) * 64 + (((ks * 4 + quad) ^ (l15 & 7)) * 8));  \
          bfr[ks][i] = *(const bf16x8*)(Bs + (wn * 64 + i * 16 + l15) * 64 + (((ks * 4 + quad) ^ (l15 & 7)) * 8)); \
        }                                                                                        \
      __builtin_amdgcn_sched_barrier(0);                                                         \
      _Pragma("unroll") for (int ks = 0; ks < 2; ++ks)                                           \
        _Pragma("unroll") for (int i = 0; i < 4; ++i)                                            \
          _Pragma("unroll") for (int j = 0; j < 4; ++j)                                          \
            acc[i][j] = __builtin_amdgcn_mfma_f32_16x16x32_bf16(af[ks][i], bfr[ks][j], acc[i][j], 0, 0, 0); \
    }                                                                                            \
  }
  G_LOAD(ra0, rb0, 0)
  G_LOAD(ra1, rb1, 64)
  for (int k0 = 0; k0 < K; k0 += 128) {
    G_STAGE(ra0, rb0, k0 + 128)
    G_STAGE(ra1, rb1, k0 + 192)
  }
#undef G_LOAD
#undef G_STAGE
}

#define ZERO_ACC(acc)                                  \
  _Pragma("unroll") for (int i_ = 0; i_ < 4; ++i_)     \
  _Pragma("unroll") for (int j_ = 0; j_ < 4; ++j_) acc[i_][j_] = (f32x4){0.f, 0.f, 0.f, 0.f};

#define EPI_LOOP_T(BODY)                                                           \
  {                                                                                \
    const int lane_ = ltid() & 63, w_ = ltid() >> 6;                               \
    const int l15_ = lane_ & 15, quad_ = lane_ >> 4, wm_ = w_ >> 1, wn_ = w_ & 1;  \
    _Pragma("unroll") for (int i = 0; i < 4; ++i) {                                \
      _Pragma("unroll") for (int j = 0; j < 4; ++j) {                              \
        const int mr = wm_ * 64 + i * 16 + l15_;                                   \
        const int nc = wn_ * 64 + j * 16 + quad_ * 4;                              \
        BODY                                                                       \
      }                                                                            \
    }                                                                              \
  }

#define EPI_LOOP(BODY)                                                             \
  {                                                                                \
    const int lane_ = ltid() & 63, w_ = ltid() >> 6;                     \
    const int l15_ = lane_ & 15, quad_ = lane_ >> 4, wm_ = w_ >> 1, wn_ = w_ & 1;  \
    _Pragma("unroll") for (int i = 0; i < 4; ++i) {                                \
      _Pragma("unroll") for (int j = 0; j < 4; ++j) {                              \
        const int mr = wm_ * 64 + i * 16 + quad_ * 4;                              \
        const int nc = wn_ * 64 + j * 16 + l15_;                                   \
        BODY                                                                       \
      }                                                                            \
    }                                                                              \
  }

__device__ __forceinline__ void gemm_main_blk2(const u16* __restrict__ A, const u16* __restrict__ B, int K, u16* As, u16* Bs,
                                               f32x4 (&acc)[8][4]) {
  const int tid = ltid(), lane = tid & 63, w = tid >> 6, l15 = lane & 15, quad = lane >> 4;
  const int wm = w >> 1, wn = w & 1;
  u32x4 ra[8], rb[4];
  const u16* Ap = A + tid * 8;
  const u16* Bp = B + tid * 8;
  const size_t a2 = (size_t)(K >> 6) * 8192;
#define G2_LOAD(KK)                                                       \
  {                                                                       \
    const int kk_ = min((KK), K - 64);                                    \
    _Pragma("unroll") for (int i = 0; i < 4; ++i) {                       \
      ra[i] = *(const u32x4*)(Ap + (size_t)kk_ * 128 + i * 2048);         \
      ra[4 + i] = *(const u32x4*)(Ap + a2 + (size_t)kk_ * 128 + i * 2048); \
      rb[i] = *(const u32x4*)(Bp + (size_t)kk_ * 128 + i * 2048);         \
    }                                                                     \
  }
  G2_LOAD(0)
  for (int k0 = 0; k0 < K; k0 += 64) {
    LBAR();
#pragma unroll
    for (int i = 0; i < 8; ++i) *(u32x4*)(As + i * 2048 + tid * 8) = ra[i];
#pragma unroll
    for (int i = 0; i < 4; ++i) *(u32x4*)(Bs + i * 2048 + tid * 8) = rb[i];
    LBAR();
    G2_LOAD(k0 + 64)
#pragma unroll
    for (int ks = 0; ks < 2; ++ks) {
      bf16x8 af[8], bfr[4];
#pragma unroll
      for (int i = 0; i < 8; ++i)
        af[i] = *(const bf16x8*)(As + (wm * 128 + i * 16 + l15) * 64 + (((ks * 4 + quad) ^ (l15 & 7)) * 8));
#pragma unroll
      for (int j = 0; j < 4; ++j)
        bfr[j] = *(const bf16x8*)(Bs + (wn * 64 + j * 16 + l15) * 64 + (((ks * 4 + quad) ^ (l15 & 7)) * 8));
#pragma unroll
      for (int i = 0; i < 8; ++i)
#pragma unroll
        for (int j = 0; j < 4; ++j) acc[i][j] = __builtin_amdgcn_mfma_f32_16x16x32_bf16(af[i], bfr[j], acc[i][j], 0, 0, 0);
    }
  }
#undef G2_LOAD
}

#define EPI_LOOP8(BODY)                                                            \
  {                                                                                \
    const int lane_ = ltid() & 63, w_ = ltid() >> 6;                               \
    const int l15_ = lane_ & 15, quad_ = lane_ >> 4, wm_ = w_ >> 1, wn_ = w_ & 1;  \
    _Pragma("unroll") for (int i = 0; i < 8; ++i) {                                \
      _Pragma("unroll") for (int j = 0; j < 4; ++j) {                              \
        const int mr = wm_ * 128 + i * 16 + quad_ * 4;                             \
        const int nc = wn_ * 64 + j * 16 + l15_;                                   \
        BODY                                                                       \
      }                                                                            \
    }                                                                              \
  }

template <bool BLK>
__device__ __forceinline__ void transpose_tile(const float* __restrict__ src, int N, u16* __restrict__ dst, int K, int kt, int nt,
                               float* tile) {
  const int tid = ltid();
  __syncthreads();
  {
    int c = tid & 63, r0 = tid >> 6;
#pragma unroll
    for (int i = 0; i < 16; ++i) {
      int r = r0 + i * 4;
      tile[r * 65 + c] = src[(size_t)(kt * 64 + r) * N + nt * 64 + c];
    }
  }
  __syncthreads();
#pragma unroll
  for (int i = 0; i < 2; ++i) {
    int c = tid + i * 256, n = c >> 3, kc = c & 7;
    uint4 o;
    o.x = pack2(tile[(kc * 8 + 0) * 65 + n], tile[(kc * 8 + 1) * 65 + n]);
    o.y = pack2(tile[(kc * 8 + 2) * 65 + n], tile[(kc * 8 + 3) * 65 + n]);
    o.z = pack2(tile[(kc * 8 + 4) * 65 + n], tile[(kc * 8 + 5) * 65 + n]);
    o.w = pack2(tile[(kc * 8 + 6) * 65 + n], tile[(kc * 8 + 7) * 65 + n]);
    if (BLK) {
      const int ng = nt * 64 + n;
      *(uint4*)(dst + ((size_t)(ng >> 7) * (K >> 6) + kt) * 8192 + (ng & 127) * 64 + ((kc ^ (ng & 7)) * 8)) = o;
    } else {
      *(uint4*)(dst + (size_t)(nt * 64 + n) * K + kt * 64 + kc * 8) = o;
    }
  }
}

template <bool BLK>
__device__ __forceinline__ void rms_rows(const float* __restrict__ src, int nrows, const float* __restrict__ g, u16* __restrict__ dst) {
  const int lane = ltid() & 63, w = ltid() >> 6;
  for (int row = lbid() * 4 + w; row < nrows; row += gridDim.x * 4) {
    const float4* xr = (const float4*)(src + (size_t)row * D_);
    float4 v[8];
    float ss = 0.f;
#pragma unroll
    for (int i = 0; i < 8; ++i) {
      v[i] = xr[lane + i * 64];
      ss += v[i].x * v[i].x + v[i].y * v[i].y + v[i].z * v[i].z + v[i].w * v[i].w;
    }
    ss = wave_sum(ss);
    float rs = rsqrtf(ss * (1.f / D_) + 1e-6f);
#pragma unroll
    for (int i = 0; i < 8; ++i) {
      int col = (lane + i * 64) * 4;
      float4 gg = *(const float4*)(g + col);
      uint2 o;
      o.x = pack2(v[i].x * rs * gg.x, v[i].y * rs * gg.y);
      o.y = pack2(v[i].z * rs * gg.z, v[i].w * rs * gg.w);
      if (BLK) {
        *(uint2*)(dst + ((size_t)(row >> 7) * 32 + (col >> 6)) * 8192 + (row & 127) * 64 + ((((col & 63) >> 3) ^ (row & 7)) * 8) + (col & 7)) = o;
      } else {
        *(uint2*)(dst + (size_t)row * D_ + col) = o;
      }
    }
  }
}

__device__ __forceinline__ int t5_bucket(int rel) {
  int n = rel < 0 ? -rel : rel;
  int b;
  if (n < 8) b = n;
  else if (n < 12) b = 8;
  else if (n < 16) b = 9;
  else if (n < 23) b = 10;
  else if (n < 32) b = 11;
  else if (n < 46) b = 12;
  else if (n < 64) b = 13;
  else if (n < 91) b = 14;
  else b = 15;
  return (rel > 0 ? 16 : 0) + b;
}

__device__ __forceinline__ void phase_w(const Params p, char* smem) {
  const int tid = ltid();
  float* tile = (float*)smem;
  char* ws = p.ws;
  if (lbid() == 0 && tid < 64) ((int*)(ws + OFF_CNT))[tid] = 0;
  {
    const int lane = tid & 63, w = tid >> 6;
    const int* pos = (const int*)p.in[I_POS];
    for (int t = lbid() * 4 + w; t < 128; t += gridDim.x * 4) {
      int v = pos[t * 64 + lane], mn = v, mx = v;
#pragma unroll
      for (int o = 32; o >= 1; o >>= 1) {
        mn = min(mn, __shfl_xor(mn, o));
        mx = max(mx, __shfl_xor(mx, o));
      }
      if (lane == 0) {
        ((int*)(ws + OFF_KPMM))[t * 2] = mn;
        ((int*)(ws + OFF_KPMM))[t * 2 + 1] = mx;
      }
    }
  }
  for (int i = lbid() * 256 + tid; i < L_ * 32 * 512; i += gridDim.x * 256) {
    int l = i / (32 * 512), r = i % (32 * 512), kt = r >> 9, q = r & 511;
    *(uint4*)((u16*)(ws + OFF_WIN) + (size_t)l * NINP * D_ + ((size_t)115 * 32 + kt) * 8192 + 4096 + q * 8) = make_uint4(0, 0, 0, 0);
  }
  rms_rows<true>((const float*)p.in[I_X], S_, (const float*)p.in[I_NORMG], (u16*)(ws + OFF_H));
  for (int l = 0; l < L_; ++l)
    rms_rows<false>((const float*)p.in[I_MEM], 256, (const float*)p.in[I_MEMNG] + l * D_, (u16*)(ws + OFF_MEMN) + (size_t)l * 256 * D_);
  const int PER_L = 7392 + 1024 + 1024 + 72 + 64 + 512;
  for (int t = lbid(); t < L_ * PER_L; t += gridDim.x) {
    int l = t / PER_L, r = t % PER_L;
    if (r < 7392) {
      transpose_tile<true>((const float*)p.in[I_WIN] + (size_t)l * D_ * NIN, NIN, (u16*)(ws + OFF_WIN) + (size_t)l * NINP * D_, D_,
                     r / 231, r % 231, tile);
    } else if (r < 7392 + 1024) {
      r -= 7392;
      int bi = r >> 8;
      r &= 255;
      transpose_tile<false>((const float*)p.in[I_WBR] + (size_t)(l * 4 + bi) * 512 * 2048, 2048,
                     (u16*)(ws + OFF_WB) + (size_t)(l * 4 + bi) * 2048 * 512, 512, r >> 5, r & 31, tile);
    } else if (r < 7392 + 2048) {
      r -= 7392 + 1024;
      transpose_tile<false>((const float*)p.in[I_WOUT] + (size_t)l * 2048 * 2048, 2048, (u16*)(ws + OFF_WO) + (size_t)l * 2048 * 2048,
                     2048, r >> 5, r & 31, tile);
    } else if (r < 7392 + 2048 + 72) {
      r -= 7392 + 2048;
      transpose_tile<false>((const float*)p.in[I_WUQ] + (size_t)l * 384 * 768, 768, (u16*)(ws + OFF_WUQ) + (size_t)l * 768 * 384, 384,
                     r / 12, r % 12, tile);
    } else if (r < 7392 + 2048 + 72 + 64) {
      r -= 7392 + 2048 + 72;
      transpose_tile<false>((const float*)p.in[I_WUKV] + (size_t)l * 256 * 1024, 1024, (u16*)(ws + OFF_WUKV) + (size_t)l * 1024 * 256,
                     256, r >> 4, r & 15, tile);
    } else {
      r -= 7392 + 2048 + 72 + 64;
      transpose_tile<false>((const float*)p.in[I_WKV] + (size_t)l * 2048 * 1024, 1024, (u16*)(ws + OFF_WKV) + (size_t)l * 1024 * 2048,
                     2048, r >> 4, r & 15, tile);
    }
  }
}

__device__ __forceinline__ int tile_slots(int NT) { return gridDim.x == 512 ? 512 * ((NT + 7) >> 3) : 64 * NT; }
__device__ __forceinline__ bool tile_map(int t, int NT, int& mt, int& nt) {
  if (gridDim.x == 512) {
    int bid = t & 511, k = t >> 9, x = bid & 7, j = bid >> 3;
    mt = 8 * x + (j & 7);
    nt = 8 * k + (j >> 3);
  } else {
    mt = t & 63;
    nt = t >> 6;
  }
  return nt < NT;
}

__device__ __forceinline__ int tile_slots2(int NT) { return gridDim.x == 512 ? 512 * ((NT + 15) >> 4) : 32 * NT; }
__device__ __forceinline__ bool tile_map2(int t, int NT, int& mt, int& nt) {
  if (gridDim.x == 512) {
    int bid = t & 511, k = t >> 9, x = bid & 7, j = bid >> 3;
    mt = 4 * x + (j & 3);
    nt = 16 * k + (j >> 2);
  } else {
    mt = t & 31;
    nt = t >> 5;
  }
  return nt < NT;
}

__device__ __forceinline__ void phase_gemm_in(const Params p, int l, char* smem, int vb) {
  u16* As = (u16*)smem;
  char* ws = p.ws;
  {
    u16* Bs = As + 256 * 64;
    const int nslots = tile_slots2(112);
    for (int t = vb; t < nslots; t += gridDim.x) {
      int mt, nt;
      if (!tile_map2(t, 112, mt, nt)) continue;
      f32x4 acc[8][4];
#pragma unroll
      for (int i_ = 0; i_ < 8; ++i_)
#pragma unroll
        for (int j_ = 0; j_ < 4; ++j_) acc[i_][j_] = (f32x4){0.f, 0.f, 0.f, 0.f};
      int m0 = mt * 256, n0 = nt * 128;
      gemm_main_blk2((const u16*)(ws + OFF_H) + (size_t)(2 * mt) * 32 * 8192,
                     (const u16*)(ws + OFF_WIN) + (size_t)l * NINP * D_ + (size_t)nt * 32 * 8192, D_, As, Bs, acc);
      if (n0 < 1792) {
        float* dst = (float*)(ws + OFF_RWU);
        EPI_LOOP8({
          _Pragma("unroll") for (int r2 = 0; r2 < 4; ++r2) dst[(size_t)(m0 + mr + r2) * 1792 + n0 + nc] = acc[i][j][r2];
        })
      } else if (n0 >= O_DV && n0 < O_QL) {
        u16* dst = (u16*)(ws + OFF_VTD) + (size_t)((n0 - O_DV) / 128) * 128 * S_;
        EPI_LOOP8({
          uint2 o;
          o.x = pack2(acc[i][j][0], acc[i][j][1]);
          o.y = pack2(acc[i][j][2], acc[i][j][3]);
          *(uint2*)(dst + (size_t)nc * S_ + m0 + mr) = o;
        })
      } else {
        u16* dst = (u16*)(ws + OFF_P);
        EPI_LOOP8({
          _Pragma("unroll") for (int r2 = 0; r2 < 4; ++r2) dst[(size_t)(m0 + mr + r2) * NINP + n0 + nc] = f2bf(acc[i][j][r2]);
        })
      }
    }
  }
  {
    u16* Bs = As + 128 * 64;
    for (int t = vb; t < 256; t += gridDim.x) {
      f32x4 acc[4][4];
      ZERO_ACC(acc);
      int mt = t & 63, nt = 112 + (t >> 6);
      int m0 = mt * 128, n0 = nt * 128;
      gemm_main_blk((const u16*)(ws + OFF_H) + (size_t)mt * 32 * 8192,
                    (const u16*)(ws + OFF_WIN) + (size_t)l * NINP * D_ + (size_t)nt * 32 * 8192, D_, As, Bs, acc);
      u16* dst = (u16*)(ws + OFF_P);
      EPI_LOOP({
        _Pragma("unroll") for (int r2 = 0; r2 < 4; ++r2) dst[(size_t)(m0 + mr + r2) * NINP + n0 + nc] = f2bf(acc[i][j][r2]);
      })
    }
  }
  if (l == 0) {
    u16* Bs = As + 128 * 64;
    for (int tt = (vb + gridDim.x - 256) % gridDim.x; tt < 64; tt += gridDim.x) {
      f32x4 acc[4][4];
      ZERO_ACC(acc);
      int ll = tt >> 4, mt = (tt >> 3) & 1, nt = tt & 7;
      int m0 = mt * 128, n0 = nt * 128;
      gemm_main<false>((const u16*)(ws + OFF_MEMN) + ((size_t)ll * 256 + m0) * D_, D_, (const u16*)(ws + OFF_WKV) + ((size_t)ll * 1024 + n0) * D_,
                D_, D_, As, Bs, acc);
      if (nt < 4) {
        float* dst = (float*)(ws + OFF_KVMEM) + (size_t)ll * 256 * 512;
        EPI_LOOP({
          _Pragma("unroll") for (int r2 = 0; r2 < 4; ++r2) dst[(size_t)(m0 + mr + r2) * 512 + n0 + nc] = acc[i][j][r2];
        })
      } else {
        u16* dst = (u16*)(ws + OFF_VTMEM) + (size_t)(ll * 4 + (nt - 4)) * 128 * 256;
        EPI_LOOP({
          uint2 o;
          o.x = pack2(acc[i][j][0], acc[i][j][1]);
          o.y = pack2(acc[i][j][2], acc[i][j][3]);
          *(uint2*)(dst + (size_t)nc * 256 + m0 + mr) = o;
        })
      }
    }
  }
}

__device__ __forceinline__ void phase_gemm_mla(const Params p, int l, char* smem, int vb) {
  u16* As = (u16*)smem;
  u16* Bs = As + 128 * 64;
  char* ws = p.ws;
  const u16* P = (const u16*)(ws + OFF_P);
  const int nslots = tile_slots(14);
  for (int t = vb; t < nslots; t += gridDim.x) {
    f32x4 acc[4][4];
    ZERO_ACC(acc);
    int mt, nt;
    if (!tile_map(t, 14, mt, nt)) continue;
    int m0 = mt * 128;
    if (nt < 6) {
      int n0 = nt * 128;
      gemm_main<true>(P + (size_t)m0 * NINP + O_QL, NINP, (const u16*)(ws + OFF_WUQ) + ((size_t)l * 768 + n0) * 384, 384, 384, As, Bs, acc);
      u16* dst = (u16*)(ws + OFF_MQ);
      EPI_LOOP_T({
        uint2 o;
        o.x = pack2(acc[i][j][0], acc[i][j][1]);
        o.y = pack2(acc[i][j][2], acc[i][j][3]);
        *(uint2*)(dst + (size_t)(m0 + mr) * 768 + n0 + nc) = o;
      })
    } else {
      nt -= 6;
      int n0 = nt * 128, h = nt >> 1;
      if ((nt & 1) == 0) {
        gemm_main<true>(P + (size_t)m0 * NINP + O_KVL, NINP, (const u16*)(ws + OFF_WUKV) + ((size_t)l * 1024 + n0) * 256, 256, 256, As, Bs, acc);
        u16* dst = (u16*)(ws + OFF_MKV);
        EPI_LOOP_T({
          uint2 o;
          o.x = pack2(acc[i][j][0], acc[i][j][1]);
          o.y = pack2(acc[i][j][2], acc[i][j][3]);
          *(uint2*)(dst + (size_t)(m0 + mr) * 512 + h * 128 + nc) = o;
        })
      } else {
        gemm_main<false>(P + (size_t)m0 * NINP + O_KVL, NINP, (const u16*)(ws + OFF_WUKV) + ((size_t)l * 1024 + n0) * 256, 256, 256, As, Bs, acc);
        u16* dst = (u16*)(ws + OFF_VTM) + (size_t)h * 128 * S_;
        EPI_LOOP({
          uint2 o;
          o.x = pack2(acc[i][j][0], acc[i][j][1]);
          o.y = pack2(acc[i][j][2], acc[i][j][3]);
          *(uint2*)(dst + (size_t)nc * S_ + m0 + mr) = o;
        })
      }
    }
  }
}

__device__ __forceinline__ void phase_gemm_branch(const Params p, int l, char* smem, int vb) {
  u16* As = (u16*)smem;
  u16* Bs = As + 128 * 64;
  char* ws = p.ws;
  const u16* P = (const u16*)(ws + OFF_P);
  const int nslots = tile_slots(16);
  for (int t = vb; t < nslots; t += gridDim.x) {
    int mt, nt;
    if (!tile_map(t, 16, mt, nt)) continue;
    int m0 = mt * 128, n0 = nt * 128;
    f32x4 zacc[4][4];
    ZERO_ACC(zacc);
    for (int bi = 0; bi < 4; ++bi) {
      f32x4 acc[4][4];
      ZERO_ACC(acc);
      gemm_main1<true>((const u16*)(ws + OFF_YG) + ((size_t)bi * S_ + m0) * 512, 512,
                (const u16*)(ws + OFF_WB) + ((size_t)(l * 4 + bi) * 2048 + n0) * 512, 512, 512, As, Bs, acc);
      EPI_LOOP_T({
        const uint2 mg = *(const uint2*)(P + (size_t)(m0 + mr) * NINP + O_MG + bi * 2048 + n0 + nc);
        zacc[i][j][0] += sigmoidf_(lo2f(mg.x)) * acc[i][j][0];
        zacc[i][j][1] += sigmoidf_(hi2f(mg.x)) * acc[i][j][1];
        zacc[i][j][2] += sigmoidf_(lo2f(mg.y)) * acc[i][j][2];
        zacc[i][j][3] += sigmoidf_(hi2f(mg.y)) * acc[i][j][3];
      })
    }
    u16* dst = (u16*)(ws + OFF_Z);
    EPI_LOOP_T({
      uint2 o;
      o.x = pack2(zacc[i][j][0], zacc[i][j][1]);
      o.y = pack2(zacc[i][j][2], zacc[i][j][3]);
      *(uint2*)(dst + (size_t)(m0 + mr) * D_ + n0 + nc) = o;
    })
  }
}

__device__ __forceinline__ void phase_gemm_out(const Params p, int l, char* smem, int vb) {
  u16* As = (u16*)smem;
  u16* Bs = As + 128 * 64;
  char* ws = p.ws;
  const float* xin = (l == 0) ? (const float*)p.in[I_X] : (const float*)p.out;
  const int nslots = tile_slots(16);
  for (int t = vb; t < nslots; t += gridDim.x) {
    int mt, nt;
    if (!tile_map(t, 16, mt, nt)) continue;
    int m0 = mt * 128, n0 = nt * 128;
    f32x4 acc[4][4];
    ZERO_ACC(acc);
    gemm_main<true>((const u16*)(ws + OFF_Z) + (size_t)m0 * D_, D_, (const u16*)(ws + OFF_WO) + ((size_t)l * 2048 + n0) * D_, D_, D_, As, Bs,
              acc);
    EPI_LOOP_T({
      size_t idx = (size_t)(m0 + mr) * D_ + n0 + nc;
      float4 xv = *(const float4*)(xin + idx);
      *(float4*)(p.out + idx) = make_float4(xv.x + acc[i][j][0], xv.y + acc[i][j][1], xv.z + acc[i][j][2], xv.w + acc[i][j][3]);
    })
  }
}

__device__ __forceinline__ void seg_norm8(u16* ptr, bool active, int width, float inv_n, const float* g, float scale) {
  uint4 v = make_uint4(0, 0, 0, 0);
  if (active) v = *(const uint4*)ptr;
  float x[8] = {lo2f(v.x), hi2f(v.x), lo2f(v.y), hi2f(v.y), lo2f(v.z), hi2f(v.z), lo2f(v.w), hi2f(v.w)};
  float ss = 0.f;
#pragma unroll
  for (int i = 0; i < 8; ++i) ss += x[i] * x[i];
  for (int o = 1; o < width; o <<= 1) ss += __shfl_xor(ss, o);
  float rs = rsqrtf(ss * inv_n + 1e-6f) * scale;
  if (active) {
    float4 g0 = *(const float4*)g, g1 = *(const float4*)(g + 4);
    uint4 o;
    o.x = pack2(x[0] * rs * g0.x, x[1] * rs * g0.y);
    o.y = pack2(x[2] * rs * g0.z, x[3] * rs * g0.w);
    o.z = pack2(x[4] * rs * g1.x, x[5] * rs * g1.y);
    o.w = pack2(x[6] * rs * g1.z, x[7] * rs * g1.w);
    *(uint4*)ptr = o;
  }
}

template <bool RWONLY>
__device__ __forceinline__ void phase_prep(const Params p, int l, char* smem) {
  char* ws = p.ws;
  const int tid = ltid(), lane = tid & 63, w = tid >> 6;
  u16* P = (u16*)(ws + OFF_P);
  if (!RWONLY) {
    const float* dqg = (const float*)p.in[I_DQKG] + l * 128;
    const float* mqg = (const float*)p.in[I_MQKG] + l * 256;
    const float* qlg = (const float*)p.in[I_QLATG] + l * 384;
    const float* kvg = (const float*)p.in[I_KVLATG] + l * 256;
    for (int s = lbid() * 4 + w; s < S_; s += gridDim.x * 4) {
      u16* row = P + (size_t)s * NINP;
      seg_norm8(row + O_DQ + lane * 8, true, 8, 1.f / 64, dqg + (lane * 8) % 64, 0.125f * LOG2E);
      seg_norm8(row + O_DK + lane * 8, true, 8, 1.f / 64, dqg + 64 + (lane * 8) % 64, 1.f);
      seg_norm8(row + O_MQ + lane * 8, true, 16, 1.f / 128, mqg + (lane * 8) % 128, 0.08838834764831845f * LOG2E);
      seg_norm8(row + O_QL + (lane < 48 ? lane : 0) * 8, lane < 48, 64, 1.f / 384, qlg + (lane < 48 ? lane : 0) * 8, 1.f);
      seg_norm8(row + O_KVL + (lane < 32 ? lane : 0) * 8, lane < 32, 64, 1.f / 256, kvg + (lane < 32 ? lane : 0) * 8, 1.f);
    }
  }
  if (l == 0 && !RWONLY) {
    for (int sg = lbid() * 4 + w; sg < L_ * 256 * 4; sg += gridDim.x * 4) {
      int ll = sg >> 10, m = (sg >> 2) & 255, h = sg & 3;
      const float* src = (const float*)(ws + OFF_KVMEM) + ((size_t)ll * 256 + m) * 512 + h * 128;
      float a = src[lane], b = src[lane + 64];
      float ss = wave_sum(a * a + b * b);
      float rs = rsqrtf(ss * (1.f / 128) + 1e-6f);
      const float* g = (const float*)p.in[I_MQKG] + ll * 256 + 128;
      u16* dst = (u16*)(ws + OFF_KMEM) + ((size_t)(ll * 4 + h) * 256 + m) * 128;
      dst[lane] = f2bf(a * rs * g[lane]);
      dst[lane + 64] = f2bf(b * rs * g[lane + 64]);
    }
  }
  {
    float* ld = (float*)smem;
    const float* RWU = (const float*)(ws + OFF_RWU);
    const float* sh = (const float*)p.in[I_SHIFT] + (size_t)l * 3 * 1792;
    const float* wup = (const float*)p.in[I_WUP] + (size_t)l * 2 * 64 * 512;
    const float* aup = (const float*)p.in[I_AUP] + (size_t)l * 2 * 64 * 512;
    const float* w0 = (const float*)p.in[I_W0] + l * 1024;
    const float* a0 = (const float*)p.in[I_A0] + l * 1024;
    const float* kkp = (const float*)p.in[I_KK] + l * 512;
    const float* kap = (const float*)p.in[I_KA] + l * 512;
    const float* rkp = (const float*)p.in[I_RK] + l * 512;
    for (int tile = lbid(); tile < S_ / 8; tile += gridDim.x) {
      const int s0 = tile * 8;
      __syncthreads();
      {
        int c = 1536 + tid;
        float c0 = sh[c], c1 = sh[1792 + c], c2 = sh[2 * 1792 + c];
#pragma unroll
        for (int tk = 0; tk < 8; ++tk) {
          int s = s0 + tk;
          float um = s > 0 ? RWU[(size_t)(s - 1) * 1792 + c] : 0.f;
          float u0 = RWU[(size_t)s * 1792 + c];
          float up = s < S_ - 1 ? RWU[(size_t)(s + 1) * 1792 + c] : 0.f;
          float v = c0 * um + c1 * u0 + c2 * up;
          if (tid < 128) v = tanhf(v);
          ld[tk * 256 + tid] = v;
        }
      }
      __syncthreads();
      float acc[8][4][2];
#pragma unroll
      for (int a = 0; a < 8; ++a)
#pragma unroll
        for (int b = 0; b < 4; ++b) acc[a][b][0] = acc[a][b][1] = 0.f;
      for (int l4 = 0; l4 < 16; ++l4) {
        float wv[4][4][2];
#pragma unroll
        for (int ll = 0; ll < 4; ++ll) {
#pragma unroll
          for (int ch = 0; ch < 2; ++ch) {
            int c = tid + ch * 256;
            int li = l4 * 4 + ll;
            wv[0][ll][ch] = wup[(size_t)(0 * 64 + li) * 512 + c];
            wv[1][ll][ch] = wup[(size_t)(1 * 64 + li) * 512 + c];
            wv[2][ll][ch] = aup[(size_t)(0 * 64 + li) * 512 + c];
            wv[3][ll][ch] = aup[(size_t)(1 * 64 + li) * 512 + c];
          }
        }
#pragma unroll
        for (int tk = 0; tk < 8; ++tk) {
#pragma unroll
          for (int mat = 0; mat < 4; ++mat) {
            float4 d = *(const float4*)(ld + tk * 256 + mat * 64 + l4 * 4);
#pragma unroll
            for (int ch = 0; ch < 2; ++ch) {
              acc[tk][mat][ch] += d.x * wv[mat][0][ch] + d.y * wv[mat][1][ch] + d.z * wv[mat][2][ch] + d.w * wv[mat][3][ch];
            }
          }
        }
      }
#pragma unroll
      for (int ch = 0; ch < 2; ++ch) {
        const int c = tid + ch * 256;
        float shc[3][3];
#pragma unroll
        for (int q = 0; q < 3; ++q)
#pragma unroll
          for (int j = 0; j < 3; ++j) shc[q][j] = sh[j * 1792 + q * 512 + c];
        const float kkc = kkp[c], kac = kap[c], rkc = rkp[c];
        const float w0c0 = w0[c], w0c1 = w0[512 + c], a0c0 = a0[c], a0c1 = a0[512 + c];
        float um[3], u0[3];
#pragma unroll
        for (int q = 0; q < 3; ++q) {
          um[q] = s0 > 0 ? RWU[(size_t)(s0 - 1) * 1792 + q * 512 + c] : 0.f;
          u0[q] = RWU[(size_t)s0 * 1792 + q * 512 + c];
        }
#pragma unroll
        for (int tk = 0; tk < 8; ++tk) {
          const int s = s0 + tk;
          float rkv[3];
#pragma unroll
          for (int q = 0; q < 3; ++q) {
            float up = s < S_ - 1 ? RWU[(size_t)(s + 1) * 1792 + q * 512 + c] : 0.f;
            rkv[q] = shc[q][0] * um[q] + shc[q][1] * u0[q] + shc[q][2] * up;
            um[q] = u0[q];
            u0[q] = up;
          }
          float r = rkv[0], k = rkv[1], v = rkv[2];
          float kkr = k * kkc;
          float ss = wave_sum(kkr * kkr);
          float kk = kkr / fmaxf(sqrtf(ss), 1e-12f);
          float bsum = 0.f;
#pragma unroll
          for (int n = 0; n < 2; ++n) {
            float zw = (n ? w0c1 : w0c0) + acc[tk][n][ch];
            float za = (n ? a0c1 : a0c0) + acc[tk][2 + n][ch];
            float dec = __expf(-0.6065306597126334f * sigmoidf_(zw));
            float a = sigmoidf_(za);
            float kd = k * (1.f + (a - 1.f) * kac);
            float bb = kk * a;
            size_t o = ((size_t)n * S_ + s) * 512 + c;
            ((float*)(ws + OFF_SCW))[o] = dec;
            ((float*)(ws + OFF_SCKD))[o] = kd;
            ((float*)(ws + OFF_SCB))[o] = bb;
            bsum += r * kd * rkc;
          }
          size_t o1 = (size_t)s * 512 + c;
          ((float*)(ws + OFF_SCR))[o1] = r;
          ((float*)(ws + OFF_SCV))[o1] = v;
          ((float*)(ws + OFF_SCKK))[o1] = kk;
          float bon = wave_sum(bsum);
          if (lane == 0) ((float*)(ws + OFF_BONUS))[s * 8 + w + 4 * ch] = bon;
        }
      }
    }
  }
}

__device__ __forceinline__ void phase_mla_post(const Params p, int l, char* smem) {
  char* ws = p.ws;
  const int lane = ltid() & 63, w = ltid() >> 6;
  const float* ng = (const float*)p.in[I_NOPEG] + l * 256;
  const float* rg = (const float*)p.in[I_ROPEG] + l * 128;
  const int* pos = (const int*)p.in[I_POS];
  const float qscale = 0.07216878364870322f * LOG2E;
  const int fi = lane & 31;
  const float inv_freq = powf(10000.f, -(float)fi / 32.f);
  for (int s = lbid() * 4 + w; s < S_; s += gridDim.x * 4) {
    float ang = (float)pos[s] * inv_freq;
    float cs = cosf(ang), sn = sinf(ang);
    const u16* mq = (const u16*)(ws + OFF_MQ) + (size_t)s * 768;
    const u16* mk = (const u16*)(ws + OFF_MKV) + (size_t)s * 512;
    float kr1, kr2;
    {
      const u16* kr = (const u16*)(ws + OFF_P) + (size_t)s * NINP + O_KR;
      float t1 = lane < 32 ? bf2f(kr[fi]) : 0.f, t2 = lane < 32 ? bf2f(kr[32 + fi]) : 0.f;
      float ss = wave_sum(t1 * t1 + t2 * t2);
      float rs = rsqrtf(ss * (1.f / 64) + 1e-6f);
      t1 *= rs * rg[64 + fi];
      t2 *= rs * rg[64 + 32 + fi];
      kr1 = t1 * cs - t2 * sn;
      kr2 = t2 * cs + t1 * sn;
    }
#pragma unroll
    for (int h = 0; h < 4; ++h) {
      u16* qd = (u16*)(ws + OFF_QM) + ((size_t)h * S_ + s) * 192;
      u16* kd = (u16*)(ws + OFF_KM) + ((size_t)h * S_ + s) * 192;
      {
        const unsigned ab = *(const unsigned*)(mq + h * 192 + 2 * lane);
        float a = lo2f(ab), b = hi2f(ab);
        float ss = wave_sum(a * a + b * b);
        float rs = rsqrtf(ss * (1.f / 128) + 1e-6f) * qscale;
        const float2 gq = *(const float2*)(ng + 2 * lane);
        *(unsigned*)(qd + 2 * lane) = pack2(a * rs * gq.x, b * rs * gq.y);
      }
      {
        float t1 = lane < 32 ? bf2f(mq[h * 192 + 128 + fi]) : 0.f, t2 = lane < 32 ? bf2f(mq[h * 192 + 160 + fi]) : 0.f;
        float ss = wave_sum(t1 * t1 + t2 * t2);
        float rs = rsqrtf(ss * (1.f / 64) + 1e-6f);
        t1 *= rs * rg[fi];
        t2 *= rs * rg[32 + fi];
        if (lane < 32) {
          qd[128 + fi] = f2bf((t1 * cs - t2 * sn) * qscale);
          qd[160 + fi] = f2bf((t2 * cs + t1 * sn) * qscale);
        }
      }
      {
        const unsigned ab = *(const unsigned*)(mk + h * 128 + 2 * lane);
        float a = lo2f(ab), b = hi2f(ab);
        float ss = wave_sum(a * a + b * b);
        float rs = rsqrtf(ss * (1.f / 128) + 1e-6f);
        const float2 gk = *(const float2*)(ng + 128 + 2 * lane);
        *(unsigned*)(kd + 2 * lane) = pack2(a * rs * gk.x, b * rs * gk.y);
        if (lane < 32) {
          kd[128 + fi] = f2bf(kr1);
          kd[160 + fi] = f2bf(kr2);
        }
      }
    }
  }
}

template <int DQK, int NSUB>
__device__ __forceinline__ void attn_item(const u16* __restrict__ Q, int ldq, const u16* __restrict__ K, int ldk, const u16* __restrict__ Vt,
                          int ldv, int Skv, u16* __restrict__ O, int qb, bool hasBias, const float* __restrict__ relb, int head,
                          const int* __restrict__ pos, const int* __restrict__ kpmm, char* smem, const int* __restrict__ kposp,
                          float* __restrict__ ML) {
  constexpr int LDK = DQK;
  constexpr int SW = (DQK == 128) ? 15 : 7;
  constexpr int NKS = DQK / 32;
  constexpr int NKC = DQK / 32;
  u16* Ks = (u16*)smem;
  u16* Vs = (u16*)(smem + 25600);
  float* bt = (float*)(smem + 44032);
  int* kp = (int*)(smem + 45072);
  const int tid = ltid(), lane = tid & 63, w = tid >> 6, l15 = lane & 15, quad = lane >> 4;
  const int q0 = qb * (64 * NSUB) + w * (16 * NSUB);

  bf16x8 qf[NSUB][NKS];
#pragma unroll
  for (int sub = 0; sub < NSUB; ++sub)
#pragma unroll
    for (int ks = 0; ks < NKS; ++ks)
      qf[sub][ks] = *(const bf16x8*)(Q + (size_t)(q0 + sub * 16 + l15) * ldq + ks * 32 + quad * 8);

  int qp[2] = {0, 0};
  int qpmin = 0, qpmax = 0;
  if (hasBias) {
    qp[0] = pos[q0 + l15];
    qp[1] = pos[q0 + (NSUB - 1) * 16 + l15];
    qpmin = min(qp[0], qp[1]);
    qpmax = max(qp[0], qp[1]);
#pragma unroll
    for (int o = 8; o >= 1; o >>= 1) {
      qpmin = min(qpmin, __shfl_xor(qpmin, o));
      qpmax = max(qpmax, __shfl_xor(qpmax, o));
    }
  }
  __syncthreads();
  if (hasBias) {
    for (int i = tid; i < 257; i += 256) bt[i] = relb[t5_bucket(i - 128) * 4 + head] * LOG2E;
  }
  u32x4 kreg[NKC], vreg[4];
#pragma unroll
  for (int i = 0; i < NKC; ++i) {
    int c = tid + i * 256, r = c / (DQK / 8), kc = c % (DQK / 8);
    kreg[i] = *(const u32x4*)(K + (size_t)r * ldk + kc * 8);
  }
#pragma unroll
  for (int i = 0; i < 4; ++i) {
    int c = tid + i * 256, r = c >> 3, kc = c & 7;
    vreg[i] = *(const u32x4*)(Vt + (size_t)r * ldv + kc * 8);
  }
#pragma unroll
  for (int i = 0; i < NKC; ++i) {
    int c = tid + i * 256, r = c / (DQK / 8), kc = c % (DQK / 8);
    *(u32x4*)(Ks + r * LDK + ((kc ^ (r & SW)) * 8)) = kreg[i];
  }
#pragma unroll
  for (int i = 0; i < 4; ++i) {
    int c = tid + i * 256, r = c >> 3, kc = c & 7;
    *(u32x4*)(Vs + r * 72 + kc * 8) = vreg[i];
  }
  if (hasBias && tid < 64) kp[tid] = kposp[tid];
  __syncthreads();

  f32x4 oacc[8][NSUB];
#pragma unroll
  for (int et = 0; et < 8; ++et)
#pragma unroll
    for (int sub = 0; sub < NSUB; ++sub) oacc[et][sub] = (f32x4){0.f, 0.f, 0.f, 0.f};
  float mrow[2] = {-1e30f, -1e30f}, lrow[2] = {0.f, 0.f};

  const int ntiles = Skv / 64;
  constexpr bool KDMA = (DQK == 192);
  int koff[6];
#pragma unroll
  for (int i = 0; i < 6; ++i) {
    const int o = (w + 4 * i) * 1024 + lane * 16;
    const int r = o / (DQK * 2), pos = (o % (DQK * 2)) >> 4;
    koff[i] = r * ldk + ((pos ^ (r & SW)) * 8);
  }
  for (int t = 0; t < ntiles; ++t) {
    const bool more = (t + 1 < ntiles);
    const int k1 = (t + 1) * 64;
    constexpr bool EARLY = (DQK != 128);
    if (EARLY && more) {
      if (!KDMA) {
#pragma unroll
        for (int i = 0; i < NKC; ++i) {
          int c = tid + i * 256, r = c / (DQK / 8), kc = c % (DQK / 8);
          kreg[i] = *(const u32x4*)(K + (size_t)(k1 + r) * ldk + kc * 8);
        }
      }
#pragma unroll
      for (int i = 0; i < 4; ++i) {
        int c = tid + i * 256, r = c >> 3, kc = c & 7;
        vreg[i] = *(const u32x4*)(Vt + (size_t)r * ldv + k1 + kc * 8);
      }
    }
    f32x4 sacc[4][NSUB];
#pragma unroll
    for (int kt = 0; kt < 4; ++kt)
#pragma unroll
      for (int sub = 0; sub < NSUB; ++sub) sacc[kt][sub] = (f32x4){0.f, 0.f, 0.f, 0.f};
#pragma unroll
    for (int ks = 0; ks < NKS; ++ks) {
#pragma unroll
      for (int kt = 0; kt < 4; ++kt) {
        bf16x8 kf = *(const bf16x8*)(Ks + (kt * 16 + l15) * LDK + (((ks * 4 + quad) ^ (l15 & SW)) * 8));
#pragma unroll
        for (int sub = 0; sub < NSUB; ++sub)
          sacc[kt][sub] = __builtin_amdgcn_mfma_f32_16x16x32_bf16(kf, qf[sub][ks], sacc[kt][sub], 0, 0, 0);
      }
      __builtin_amdgcn_sched_barrier(0);
    }
    float cb = 0.f;
    if (hasBias) {
      int kmn = kpmm[t * 2], kmx = kpmm[t * 2 + 1];
      if (kmn - qpmax >= 128 || kmx - qpmin <= -128) {
        cb = (kmn - qpmax >= 128) ? bt[256] : bt[0];
      } else {
#pragma unroll
        for (int kt = 0; kt < 4; ++kt) {
#pragma unroll
          for (int j = 0; j < 4; ++j) {
            int kpos = kp[kt * 16 + quad * 4 + j];
#pragma unroll
            for (int sub = 0; sub < NSUB; ++sub) {
              int rel = kpos - qp[sub];
              rel = max(-128, min(128, rel));
              sacc[kt][sub][j] += bt[rel + 128];
            }
          }
        }
      }
    }
    LBAR();
    if (more) {
      if (!EARLY) {
#pragma unroll
        for (int i = 0; i < NKC; ++i) {
          int c = tid + i * 256, r = c / (DQK / 8), kc = c % (DQK / 8);
          kreg[i] = *(const u32x4*)(K + (size_t)(k1 + r) * ldk + kc * 8);
        }
#pragma unroll
        for (int i = 0; i < 4; ++i) {
          int c = tid + i * 256, r = c >> 3, kc = c & 7;
          vreg[i] = *(const u32x4*)(Vt + (size_t)r * ldv + k1 + kc * 8);
        }
      }
      if (hasBias && tid < 64) kp[tid] = kposp[k1 + tid];
      if (KDMA) {
#pragma unroll
        for (int i = 0; i < 6; ++i)
          __builtin_amdgcn_global_load_lds((const unsigned*)(K + (size_t)k1 * ldk + koff[i]),
                                           (unsigned*)((char*)Ks + (w + 4 * i) * 1024), 16, 0, 0);
      }
    }
    __builtin_amdgcn_sched_barrier(0);
    bf16x8 pf[NSUB][2];
#pragma unroll
    for (int sub = 0; sub < NSUB; ++sub) {
      float mx = -1e30f;
#pragma unroll
      for (int kt = 0; kt < 4; ++kt)
#pragma unroll
        for (int j = 0; j < 4; ++j) mx = fmaxf(mx, sacc[kt][sub][j]);
      mx = fmaxf(mx, __shfl_xor(mx, 16));
      mx = fmaxf(mx, __shfl_xor(mx, 32));
      float mnew = fmaxf(mrow[sub], mx + cb);
      float alpha = __builtin_amdgcn_exp2f(mrow[sub] - mnew);
      mrow[sub] = mnew;
      const float off = cb - mnew;
      float ps = 0.f;
      float pv[4][4];
#pragma unroll
      for (int kt = 0; kt < 4; ++kt)
#pragma unroll
        for (int j = 0; j < 4; ++j) {
          pv[kt][j] = __builtin_amdgcn_exp2f(sacc[kt][sub][j] + off);
          ps += pv[kt][j];
        }
      lrow[sub] = lrow[sub] * alpha + ps;
#pragma unroll
      for (int kb = 0; kb < 2; ++kb) {
        u32x4 pu = {pack2(pv[2 * kb][0], pv[2 * kb][1]), pack2(pv[2 * kb][2], pv[2 * kb][3]),
                    pack2(pv[2 * kb + 1][0], pv[2 * kb + 1][1]), pack2(pv[2 * kb + 1][2], pv[2 * kb + 1][3])};
        pf[sub][kb] = __builtin_bit_cast(bf16x8, pu);
      }
      if (__builtin_amdgcn_ballot_w64(alpha != 1.f) != 0) {
#pragma unroll
        for (int et = 0; et < 8; ++et) {
          oacc[et][sub][0] *= alpha; oacc[et][sub][1] *= alpha;
          oacc[et][sub][2] *= alpha; oacc[et][sub][3] *= alpha;
        }
      }
    }
#pragma unroll
    for (int et = 0; et < 8; ++et) {
#pragma unroll
      for (int kb = 0; kb < 2; ++kb) {
        const u16* vp = Vs + (et * 16 + l15) * 72 + kb * 32 + quad * 4;
        u32x2 a0 = *(const u32x2*)vp;
        u32x2 a1 = *(const u32x2*)(vp + 16);
        u32x4 cu = {a0.x, a0.y, a1.x, a1.y};
        bf16x8 vb = __builtin_bit_cast(bf16x8, cu);
#pragma unroll
        for (int sub = 0; sub < NSUB; ++sub)
          oacc[et][sub] = __builtin_amdgcn_mfma_f32_16x16x32_bf16(vb, pf[sub][kb], oacc[et][sub], 0, 0, 0);
      }
      if (et & 1) __builtin_amdgcn_sched_barrier(0);
    }
    if (more) {
      if (KDMA) {
        asm volatile("s_waitcnt vmcnt(0)" ::: "memory");
      } else {
#pragma unroll
        for (int i = 0; i < NKC; ++i) {
          int c = tid + i * 256, r = c / (DQK / 8), kc = c % (DQK / 8);
          *(u32x4*)(Ks + r * LDK + ((kc ^ (r & SW)) * 8)) = kreg[i];
        }
      }
    }
    LBAR();
    if (more) {
#pragma unroll
      for (int i = 0; i < 4; ++i) {
        int c = tid + i * 256, r = c >> 3, kc = c & 7;
        *(u32x4*)(Vs + r * 72 + kc * 8) = vreg[i];
      }
    }
  }
#pragma unroll
  for (int sub = 0; sub < NSUB; ++sub) {
    float lt = lrow[sub];
    lt += __shfl_xor(lt, 16);
    lt += __shfl_xor(lt, 32);
    float inv = 1.f / lt;
    if (ML) {
      inv = 1.f;
      if (quad == 0) *(float2*)(ML + (size_t)(q0 + sub * 16 + l15) * 2) = make_float2(mrow[sub], lt);
    }
    u16* orow = O + (size_t)(q0 + sub * 16 + l15) * 128;
#pragma unroll
    for (int et = 0; et < 8; ++et) {
      uint2 o;
      o.x = pack2(oacc[et][sub][0] * inv, oacc[et][sub][1] * inv);
      o.y = pack2(oacc[et][sub][2] * inv, oacc[et][sub][3] * inv);
      *(uint2*)(orow + et * 16 + quad * 4) = o;
    }
  }
}

#define QB2 (128 / ATT_NSUB)
#define SC_CH 16
#define SC_STEPF 336
typedef float f32x2 __attribute__((ext_vector_type(2)));
struct ScStep { f32x2 kk0, kk1, w0, w1, b0, b1, k0, k1, r0, r1; float v; };
__device__ __forceinline__ ScStep sc_ld(const float* sb, int jg4, int vi) {
  ScStep x;
  f32x4 t;
  t = *(const f32x4*)(sb + jg4);       x.kk0 = t.xy; x.kk1 = t.zw;
  t = *(const f32x4*)(sb + 64 + jg4);  x.w0 = t.xy;  x.w1 = t.zw;
  t = *(const f32x4*)(sb + 128 + jg4); x.b0 = t.xy;  x.b1 = t.zw;
  t = *(const f32x4*)(sb + 192 + jg4); x.k0 = t.xy;  x.k1 = t.zw;
  t = *(const f32x4*)(sb + 256 + jg4); x.r0 = t.xy;  x.r1 = t.zw;
  x.v = sb[320 + vi];
  return x;
}
__device__ __forceinline__ void scan_unit(const Params p, int u, char* smem) {
  char* ws = p.ws;
  const int tid = ltid(), lane = tid & 63, w = tid >> 6;
  const int chain = u >> 2, rg = u & 3, n = chain >> 3, h = chain & 7;
  const int jg = lane & 15, rw = lane >> 4;
  float* buf = (float*)smem;
  const float* a0 = (const float*)(ws + OFF_SCKK) + h * 64;
  const float* a1 = (const float*)(ws + OFF_SCW) + (size_t)n * S_ * 512 + h * 64;
  const float* a2 = (const float*)(ws + OFF_SCB) + (size_t)n * S_ * 512 + h * 64;
  const float* a3 = (const float*)(ws + OFF_SCKD) + (size_t)n * S_ * 512 + h * 64;
  const float* a4 = (const float*)(ws + OFF_SCR) + h * 64;
  const float* vsrc = (const float*)(ws + OFF_SCV) + h * 64 + rg * 16;
  float* ydst = (float*)(ws + OFF_YS) + (size_t)n * S_ * 512 + h * 64 + rg * 16 + w * 4 + rw;

  const float* pb[6];
  int pst[6], pf[6];
#pragma unroll
  for (int i = 0; i < 6; ++i) {
    int f = min(tid + i * 256, SC_CH * 84 - 1);
    int st = f / 84, q = f % 84;
    int a = q >> 4;
    const float* base = a == 0 ? a0 : a == 1 ? a1 : a == 2 ? a2 : a == 3 ? a3 : a == 4 ? a4 : vsrc;
    pb[i] = base + (a < 5 ? (q & 15) * 4 : (q - 80) * 4);
    pst[i] = st;
    pf[i] = f * 4;
  }
  const int sdir = n ? -1 : 1, sbase = n ? (S_ - 1) : 0;
  const int nch = S_ / SC_CH;
  unsigned po[6];
#pragma unroll
  for (int i = 0; i < 6; ++i)
    po[i] = (unsigned)((const char*)(pb[i] + (size_t)(sbase + sdir * pst[i]) * 512) - (const char*)ws);
  const unsigned yo = (unsigned)((const char*)(ydst + (size_t)(sbase + sdir * jg) * 512) - (const char*)ws);
  const int cstep = sdir * SC_CH * 512 * 4;
  f32x4 lregA[6], lregB[6];
#define SC_LOAD(R, CH)                                                            \
  {                                                                               \
    const unsigned d_ = (unsigned)(min((CH), nch - 1) * cstep);                   \
    _Pragma("unroll") for (int i = 0; i < 6; ++i)                                 \
      R[i] = *(const f32x4*)((const char*)ws + (unsigned)(po[i] + d_));           \
  }
#define SC_STORE(R, B)                                                \
  _Pragma("unroll") for (int i = 0; i < 6; ++i) *(f32x4*)(buf + (B) * SC_CH * SC_STEPF + pf[i]) = R[i];

  f32x2 sA = {0.f, 0.f}, sB = {0.f, 0.f};
  const int jg4 = jg * 4, vi = w * 4 + rw;
#define SC_COMPUTE(C, B)                                                              \
  {                                                                                   \
    const float* cb = buf + (B) * SC_CH * SC_STEPF;                                   \
    float ykeep = 0.f;                                                                \
    ScStep cur = sc_ld(cb, jg4, vi);                                                  \
    ScStep nx1 = sc_ld(cb + SC_STEPF, jg4, vi);                                       \
    _Pragma("unroll") for (int st = 0; st < SC_CH; ++st) {                            \
      ScStep nx2 = nx1;                                                               \
      if (st + 2 < SC_CH) nx2 = sc_ld(cb + (st + 2) * SC_STEPF, jg4, vi);             \
      f32x2 sa2 = sA * cur.kk0 + sB * cur.kk1;                                        \
      f32x2 vv = {cur.v, cur.v};                                                      \
      f32x2 uA = sA * cur.w0 + vv * cur.k0;                                           \
      f32x2 uB = sB * cur.w1 + vv * cur.k1;                                           \
      float sa = row16_sum(sa2.x + sa2.y);                                            \
      f32x2 nsa = {-sa, -sa};                                                         \
      sA = uA + nsa * cur.b0;                                                         \
      sB = uB + nsa * cur.b1;                                                         \
      f32x2 y2 = sA * cur.r0 + sB * cur.r1;                                           \
      float y = row16_sum(y2.x + y2.y);                                               \
      ykeep = (jg == st) ? y : ykeep;                                                 \
      cur = nx1;                                                                      \
      nx1 = nx2;                                                                      \
    }                                                                                 \
    *(float*)((char*)ws + (unsigned)(yo + (unsigned)((C) * cstep))) = ykeep;          \
  }

  __syncthreads();
  __builtin_amdgcn_s_setprio(3);
  SC_LOAD(lregA, 0);
  SC_STORE(lregA, 0);
  SC_LOAD(lregB, 1);
  __syncthreads();
  for (int c = 0; c < nch; c += 2) {
    SC_LOAD(lregA, c + 2);
    SC_COMPUTE(c, 0);
    SC_STORE(lregB, 1);
    LBAR();
    SC_LOAD(lregB, c + 3);
    SC_COMPUTE(c + 1, 1);
    SC_STORE(lregA, 0);
    LBAR();
  }
  __builtin_amdgcn_s_setprio(0);
}

template <int ATM>
__device__ __forceinline__ void phase_attn_scan(const Params p, int l, char* smem) {
  char* ws = p.ws;
  __shared__ int s_item;
  if (ATM & 8) for (int u = lbid(); u < 64; u += gridDim.x) scan_unit(p, u, smem);
  if ((ATM & 8) && (DUP_MASK & 2)) for (int u = lbid(); u < 64; u += gridDim.x) scan_unit(p, u, smem);
  int* cnt = (int*)(ws + OFF_CNT) + l * 4;
  const int* pos = (const int*)p.in[I_POS];
  const int* kpmm = (const int*)(ws + OFF_KPMM);
  const u16* P = (const u16*)(ws + OFF_P);
  u16* OB = (u16*)(ws + OFF_OB);
#define NEXT_ITEM(CI, LIMIT)                                   \
    __syncthreads();                                           \
    if (ltid() == 0) s_item = atomicAdd(cnt + (CI), 1);   \
    __syncthreads();                                           \
    const int it = s_item;                                     \
    if (it >= (LIMIT)) break;
  u16* OB2 = (u16*)(ws + OFF_OB2);
  float* MLb = (float*)(ws + OFF_ML);
  const int flip = (blockIdx.x >> 8) & 1;
  for (int pass = 0; pass < 2; ++pass) {
  const int which = pass ^ flip;
  if (which == 0) {
  if (ATM & 1) while (true) {
    NEXT_ITEM(0, 512)
    int hh = it >> 6, qb = it & 63, h = hh >> 1, half = hh & 1;
    const int kv0 = half * (S_ / 2);
    attn_item<192, 2>((const u16*)(ws + OFF_QM) + (size_t)h * S_ * 192, 192,
                      (const u16*)(ws + OFF_KM) + ((size_t)h * S_ + kv0) * 192, 192,
                      (const u16*)(ws + OFF_VTM) + (size_t)h * 128 * S_ + kv0, S_, S_ / 2,
                      (half ? OB2 : OB) + (size_t)(8 + h) * S_ * 128, qb, false, nullptr, 0, pos, kpmm, smem, pos,
                      MLb + ((size_t)half * 16 + 8 + h) * S_ * 2);
  }
  } else {
  if (ATM & 2) while (true) {
    NEXT_ITEM(1, 16 * QB2)
    int pp = it / QB2, qb = it % QB2, pr = pp >> 1, half = pp & 1, h = pr >> 1, hf = pr & 1;
    const int kv0 = half * (S_ / 2);
    attn_item<64, ATT_NSUB>(P + O_DQ + h * 128 + hf * 64, NINP, P + (size_t)kv0 * NINP + O_DK + h * 128 + hf * 64, NINP,
                            (const u16*)(ws + OFF_VTD) + (size_t)h * 128 * S_ + kv0, S_, S_ / 2,
                            (half ? OB2 : OB) + (size_t)pr * S_ * 128, qb, true, (const float*)p.in[I_RELB], h, pos,
                            kpmm + (kv0 / 64) * 2, smem, pos + kv0, MLb + ((size_t)half * 16 + pr) * S_ * 2);
  }
  }
  }
  if (ATM & 4) while (true) {
    NEXT_ITEM(2, 4 * QB2)
    int h = it / QB2, qb = it % QB2;
    attn_item<128, ATT_NSUB>(P + O_MQ + h * 128, NINP, (const u16*)(ws + OFF_KMEM) + (size_t)(l * 4 + h) * 256 * 128, 128,
                             (const u16*)(ws + OFF_VTMEM) + (size_t)(l * 4 + h) * 128 * 256, 256, 256,
                             OB + (size_t)(12 + h) * S_ * 128, qb, false, nullptr, 0, pos, kpmm, smem, pos, nullptr);
  }
}

__device__ __forceinline__ void phase_combine(const Params p, int l, char* smem) {
  char* ws = p.ws;
  const int lane = ltid() & 63, w = ltid() >> 6;
  const float lam_init = 0.8f - 0.6f * expf(-0.3f * (float)l);
  float lam;
  {
    const float* lq = (const float*)p.in[I_DLAM] + l * 256;
    float a = wave_sum(lq[lane] * lq[64 + lane]);
    float b = wave_sum(lq[128 + lane] * lq[192 + lane]);
    lam = expf(a) - expf(b) + lam_init;
  }
  const float* gng = (const float*)p.in[I_GNG] + l * 512;
  const float* gnb = (const float*)p.in[I_GNB] + l * 512;
  const float* subg = (const float*)p.in[I_DSUBG] + l * 128;
  const u16* P = (const u16*)(ws + OFF_P);
  const float* YS = (const float*)(ws + OFF_YS);
  const u16* OB = (const u16*)(ws + OFF_OB);
  const u16* OB2c = (const u16*)(ws + OFF_OB2);
  const float* MLp = (const float*)(ws + OFF_ML);
  u16* YG = (u16*)(ws + OFF_YG);
  for (int s = lbid() * 4 + w; s < S_; s += gridDim.x * 4) {
    const u16* grow = P + (size_t)s * NINP + O_G;
#pragma unroll
    for (int hp = 0; hp < 4; ++hp) {
      const int c = hp * 128 + 2 * lane, h = hp * 2 + (lane >> 5);
      const float2 ya = *(const float2*)(YS + (size_t)s * 512 + c);
      const float2 yb = *(const float2*)(YS + ((size_t)S_ + s) * 512 + c);
      float y0 = ya.x + yb.x, y1 = ya.y + yb.y;
      float sm = y0 + y1;
#pragma unroll
      for (int o = 16; o >= 1; o >>= 1) sm += __shfl_xor(sm, o);
      const float mu = sm * (1.f / 64);
      const float d0 = y0 - mu, d1 = y1 - mu;
      float vs = d0 * d0 + d1 * d1;
#pragma unroll
      for (int o = 16; o >= 1; o >>= 1) vs += __shfl_xor(vs, o);
      const float rstd = rsqrtf(vs * (1.f / 64) + 64e-5f);
      const float2 gg = *(const float2*)(gng + c), gb = *(const float2*)(gnb + c);
      const float bon = ((const float*)(ws + OFF_BONUS))[s * 8 + h];
      const float2 vv = *(const float2*)((const float*)(ws + OFF_SCV) + (size_t)s * 512 + c);
      float o0 = d0 * rstd * gg.x + gb.x + bon * vv.x;
      float o1 = d1 * rstd * gg.y + gb.y + bon * vv.y;
      const unsigned gt = *(const unsigned*)(grow + c);
      const float g0 = lo2f(gt), g1 = hi2f(gt);
      *(unsigned*)(YG + (size_t)s * 512 + c) = pack2(o0 * g0 * sigmoidf_(g0), o1 * g1 * sigmoidf_(g1));
    }
#define MERGE_LOAD(PR, A, B)                                                                   \
    {                                                                                          \
      const float2 ml0 = *(const float2*)(MLp + ((size_t)(PR) * S_ + s) * 2);                  \
      const float2 ml1 = *(const float2*)(MLp + ((size_t)(16 + (PR)) * S_ + s) * 2);           \
      const float mm = fmaxf(ml0.x, ml1.x);                                                    \
      const float w0 = __builtin_amdgcn_exp2f(ml0.x - mm), w1 = __builtin_amdgcn_exp2f(ml1.x - mm); \
      const float inv = 1.f / (w0 * ml0.y + w1 * ml1.y);                                       \
      const unsigned q0 = *(const unsigned*)(OB + ((size_t)(PR) * S_ + s) * 128 + 2 * lane);   \
      const unsigned q1 = *(const unsigned*)(OB2c + ((size_t)(PR) * S_ + s) * 128 + 2 * lane); \
      A = (w0 * lo2f(q0) + w1 * lo2f(q1)) * inv;                                               \
      B = (w0 * hi2f(q0) + w1 * hi2f(q1)) * inv;                                               \
    }
#pragma unroll
    for (int h = 0; h < 4; ++h) {
      float a1, b1, a2, b2;
      MERGE_LOAD(h * 2, a1, b1)
      MERGE_LOAD(h * 2 + 1, a2, b2)
      float a = a1 - lam * a2, b = b1 - lam * b2;
      float ss = wave_sum(a * a + b * b);
      float rs = rsqrtf(ss * (1.f / 128) + 1e-6f) * (1.f - lam_init);
      const unsigned gg = *(const unsigned*)(grow + 512 + h * 128 + 2 * lane);
      float g0 = lo2f(gg), g1 = hi2f(gg);
      const float2 sg = *(const float2*)(subg + 2 * lane);
      u16* dst = YG + ((size_t)S_ + s) * 512 + h * 128;
      *(unsigned*)(dst + 2 * lane) = pack2(a * rs * sg.x * g0 * sigmoidf_(g0), b * rs * sg.y * g1 * sigmoidf_(g1));
    }
#pragma unroll
    for (int br = 2; br < 4; ++br) {
#pragma unroll
      for (int h = 0; h < 4; ++h) {
        float oa, ob;
        if (br == 2) {
          MERGE_LOAD(8 + h, oa, ob)
        } else {
          const unsigned o = *(const unsigned*)(OB + ((size_t)(12 + h) * S_ + s) * 128 + 2 * lane);
          oa = lo2f(o);
          ob = hi2f(o);
        }
        const unsigned gg = *(const unsigned*)(grow + br * 512 + h * 128 + 2 * lane);
        float g0 = lo2f(gg), g1 = hi2f(gg);
        u16* dst = YG + ((size_t)br * S_ + s) * 512 + h * 128;
        *(unsigned*)(dst + 2 * lane) = pack2(oa * g0 * sigmoidf_(g0), ob * g1 * sigmoidf_(g1));
      }
    }
#undef MERGE_LOAD
  }
}

#define XB_TMO      128
#define XB_XCNT(j)  (256  + 64 * (j))
#define XB_XSUB(j)  (1280 + 64 * (j))
#define XB_XGEN(j)  (2304 + 64 * (j))
#define XB_TOP      3328
#define XB_TOPGEN   3392
#define XCD_BAR_WORDS 3456
#define XB_SPIN_CAP (1u << 22)
#define LAS __attribute__((address_space(3)))
__device__ __forceinline__ unsigned xb_ld(unsigned* p)              { return __hip_atomic_load(p, __ATOMIC_RELAXED, __HIP_MEMORY_SCOPE_AGENT); }
__device__ __forceinline__ unsigned xb_add(unsigned* p, unsigned v) { return __hip_atomic_fetch_add(p, v, __ATOMIC_RELAXED, __HIP_MEMORY_SCOPE_AGENT); }
__device__ __forceinline__ unsigned xb_xcc_id() { return (unsigned)__builtin_amdgcn_s_getreg((3 << 11) | 20) & 0xFu; }
#define XB_SPIN(cond, bar) do { unsigned _sp = 0; while (cond) { __builtin_amdgcn_s_sleep(1); \
    if ((++_sp & 255u) == 0u) { if (xb_ld(&(bar)[XB_TMO])) break; if (_sp > XB_SPIN_CAP) { atomicAdd(&(bar)[XB_TMO], 1u); break; } } } } while (0)
struct XcdBarrier { unsigned* bar; unsigned x; volatile LAS unsigned* st; };
__device__ __forceinline__ XcdBarrier xcd_barrier_post(unsigned* bar, volatile LAS unsigned* st) {
  XcdBarrier b; b.bar = bar; b.x = xb_xcc_id(); b.st = st;
  if (threadIdx.x == 0) (void)xb_add(&bar[XB_XCNT(b.x)], 1u);
  return b;
}
__device__ __forceinline__ void xcd_barrier_complete(unsigned* bar, unsigned x, unsigned& nloc, unsigned& nx) {
  const unsigned G = gridDim.x * gridDim.y * gridDim.z;
  unsigned sum, cnt, mine, sp = 0u;
  for (;;) {
    sum = 0u; cnt = 0u; mine = 0u;
#pragma unroll
    for (unsigned j = 0; j < 16; ++j) { const unsigned c = xb_ld(&bar[XB_XCNT(j)]); sum += c; cnt += (c > 0u) ? 1u : 0u; mine = (j == x) ? c : mine; }
    if (sum == G) break;
    __builtin_amdgcn_s_sleep(1);
    if ((++sp & 255u) == 0u) { if (xb_ld(&bar[XB_TMO])) break; if (sp > XB_SPIN_CAP) { atomicAdd(&bar[XB_TMO], 1u); break; } }
  }
  nloc = mine > 0u ? mine : 1u; nx = cnt > 0u ? cnt : 1u;
}
__device__ __forceinline__ void xcd_barrier(const XcdBarrier& b) {
  asm volatile("s_waitcnt vmcnt(0)" ::: "memory");
  __syncthreads();
  if (threadIdx.x == 0) {
    unsigned* bar = b.bar;
    __builtin_amdgcn_s_waitcnt(0);
    unsigned nloc = b.st[0], nx = b.st[1];
    if (nloc == 0u) { xcd_barrier_complete(bar, b.x, nloc, nx); b.st[0] = nloc; b.st[1] = nx; }
    const unsigned old = xb_add(&bar[XB_XSUB(b.x)], 1u);
    const unsigned gen = old / nloc;
    if (old + 1u == (gen + 1u) * nloc) {
      __builtin_amdgcn_fence(__ATOMIC_RELEASE, "agent");
      asm volatile("s_waitcnt vmcnt(0)" ::: "memory");
      const unsigned og = xb_add(&bar[XB_TOP], 1u);
      const unsigned tg = og / nx;
      if (og + 1u == (tg + 1u) * nx) xb_add(&bar[XB_TOPGEN], 1u);
      else XB_SPIN(xb_ld(&bar[XB_TOPGEN]) == tg, bar);
      __builtin_amdgcn_fence(__ATOMIC_ACQUIRE, "agent");
      xb_add(&bar[XB_XGEN(b.x)], 1u);
      asm volatile("s_waitcnt vmcnt(0)" ::: "memory");
    } else {
      XB_SPIN(xb_ld(&bar[XB_XGEN(b.x)]) == gen, bar);
      __builtin_amdgcn_fence(__ATOMIC_ACQUIRE, "agent");
      asm volatile("s_waitcnt vmcnt(0)" ::: "memory");
    }
  }
  __syncthreads();
}

#define N_PHASES (1 + 9 * L_)

__global__ void __launch_bounds__(256, 2) mega(Params p, int ph_lo, int ph_hi) {
  __shared__ __attribute__((aligned(16))) char smem[SMEM_BYTES];
  cg::grid_group grid = cg::this_grid();
  __shared__ uint4 xb_words;
  if (threadIdx.x == 0) xb_words = make_uint4(0u, 0u, 0u, 0u);
  __syncthreads();
  XcdBarrier xb = xcd_barrier_post((unsigned*)(p.ws + OFF_BAR), (volatile LAS unsigned*)&xb_words);
  __shared__ int s_vbid, s_cand;
  if (threadIdx.x == 0) {
    int my_j = (int)xb_add((unsigned*)(p.ws + OFF_BAR) + 8 * xb.x, 1u);
    s_cand = my_j * 8 + (int)xb.x;
    s_vbid = blockIdx.x;
  }
#define VB s_vbid
  for (int ph = ph_lo; ph < ph_hi; ++ph) {
    if (ph == 0) {
      if (PH_MASK & 1) phase_w(p, smem);
    } else {
      int l = (ph - 1) / 9, sp = (ph - 1) % 9;
      switch (sp) {
        case 0: if (PH_MASK & 2) phase_gemm_in(p, l, smem, VB);
          if (DUP_MASK & 1) { __syncthreads(); phase_gemm_in(p, l, smem, VB); }
          break;
        case 1: if (PH_MASK & 4) phase_prep<false>(p, l, smem);
          if (DUP_MASK & 256) { __syncthreads(); phase_prep<true>(p, l, smem); }
          break;
        case 2: if (PH_MASK & 8) phase_gemm_mla(p, l, smem, VB);
          if (DUP_MASK & 16) { __syncthreads(); phase_gemm_mla(p, l, smem, VB); }
          break;
        case 3: if (PH_MASK & 16) phase_mla_post(p, l, smem);
          if (DUP_MASK & 32) { __syncthreads(); phase_mla_post(p, l, smem); }
          break;
        case 4: if (PH_MASK & 32) phase_attn_scan<AT_MASK>(p, l, smem); break;
        case 5: if (PH_MASK & 64) phase_combine(p, l, smem);
          if (DUP_MASK & 64) { __syncthreads(); phase_combine(p, l, smem); }
          break;
        case 6: if (PH_MASK & 128) phase_gemm_branch(p, l, smem, VB);
          if (DUP_MASK & 4) { __syncthreads(); phase_gemm_branch(p, l, smem, VB); }
          break;
        case 7: if (PH_MASK & 256) phase_gemm_out(p, l, smem, VB); break;
        case 8:
          if (l + 1 < L_) rms_rows<true>((const float*)p.out, S_, (const float*)p.in[I_NORMG] + (l + 1) * D_, (u16*)(p.ws + OFF_H));
          if ((DUP_MASK & 128) && l + 1 < L_) rms_rows<true>((const float*)p.out, S_, (const float*)p.in[I_NORMG] + (l + 1) * D_, (u16*)(p.ws + OFF_H));
          break;
      }
    }
#undef VB
    if (ph + 1 < ph_hi) {
      if (ph == ph_lo) {
        if (ph_hi < 0) grid.sync();
        xcd_barrier(xb);
        if (threadIdx.x == 0 && gridDim.x == 512) {
          bool ok = true;
          for (int j = 0; j < 8; ++j) ok = ok && (xb_ld((unsigned*)(p.ws + OFF_BAR) + 8 * j) == 64u);
          if (ok && xb.x < 8u) s_vbid = s_cand;
        }
        __syncthreads();
      } else xcd_barrier(xb);
    }
  }
}

template <int SP, int ATM>
__global__ void __launch_bounds__(256, 2) k_phase(Params p, int l) {
  __shared__ __attribute__((aligned(16))) char smem[SMEM_BYTES];
  const int VB = blockIdx.x;
  if (SP == -1) phase_w(p, smem);
  if (SP == 0) phase_gemm_in(p, l, smem, VB);
  if (SP == 1) phase_prep<false>(p, l, smem);
  if (SP == 2) phase_gemm_mla(p, l, smem, VB);
  if (SP == 3) phase_mla_post(p, l, smem);
  if (SP == 4) phase_attn_scan<ATM>(p, l, smem);
  if (SP == 5) phase_combine(p, l, smem);
  if (SP == 6) phase_gemm_branch(p, l, smem, VB);
  if (SP == 7) phase_gemm_out(p, l, smem, VB);
  if (SP == 8) rms_rows<true>((const float*)p.out, S_, (const float*)p.in[I_NORMG] + (l + 1) * D_, (u16*)(p.ws + OFF_H));
}

extern "C" void kernel_launch(void* const* d_in, const int* in_sizes, int n_in, void* d_out, int out_size, void* d_ws,
                              size_t ws_size, hipStream_t stream) {
  static int grid_blocks = 0;
  if (!grid_blocks) {
    int dev = 0, cus = 0, per_cu = 0;
    hipGetDevice(&dev);
    hipDeviceGetAttribute(&cus, hipDeviceAttributeMultiprocessorCount, dev);
    hipOccupancyMaxActiveBlocksPerMultiprocessor(&per_cu, mega, 256, 0);
    if (per_cu > 2) per_cu = 2;
    if (per_cu < 1) per_cu = 1;
    grid_blocks = cus * per_cu;
  }
  Params p{};
  for (int i = 0; i < N_INPUTS; ++i) p.in[i] = d_in[i];
  p.out = (float*)d_out;
  p.ws = (char*)d_ws;
  if (ws_size < WS_TOTAL) fprintf(stderr, "workspace too small: %zu < %zu\n", ws_size, (size_t)WS_TOTAL);
#if MULTI_LAUNCH
  const int G = grid_blocks;
  hipLaunchKernelGGL((k_phase<-1, 0>), dim3(G), dim3(256), 0, stream, p, 0);
  for (int l = 0; l < L_; ++l) {
    hipLaunchKernelGGL((k_phase<0, 0>), dim3(G), dim3(256), 0, stream, p, l);
    hipLaunchKernelGGL((k_phase<1, 0>), dim3(G), dim3(256), 0, stream, p, l);
    hipLaunchKernelGGL((k_phase<2, 0>), dim3(G), dim3(256), 0, stream, p, l);
    hipLaunchKernelGGL((k_phase<3, 0>), dim3(G), dim3(256), 0, stream, p, l);
    hipLaunchKernelGGL((k_phase<4, 8>), dim3(64), dim3(256), 0, stream, p, l);
    hipLaunchKernelGGL((k_phase<4, 1>), dim3(G), dim3(256), 0, stream, p, l);
    hipLaunchKernelGGL((k_phase<4, 2>), dim3(G), dim3(256), 0, stream, p, l);
    hipLaunchKernelGGL((k_phase<4, 4>), dim3(G), dim3(256), 0, stream, p, l);
    hipLaunchKernelGGL((k_phase<5, 0>), dim3(G), dim3(256), 0, stream, p, l);
    hipLaunchKernelGGL((k_phase<6, 0>), dim3(G), dim3(256), 0, stream, p, l);
    hipLaunchKernelGGL((k_phase<7, 0>), dim3(G), dim3(256), 0, stream, p, l);
    if (l + 1 < L_) hipLaunchKernelGGL((k_phase<8, 0>), dim3(G), dim3(256), 0, stream, p, l);
  }
#else
  hipMemsetAsync((char*)d_ws + OFF_BAR, 0, 3456 * 4, stream);
  int lo = 0, hi = N_PHASES - 1;
  void* args[] = {&p, &lo, &hi};
  hipError_t e = hipLaunchCooperativeKernel((void*)mega, dim3(grid_blocks), dim3(256), args, 0, stream);
  if (e != hipSuccess) fprintf(stderr, "cooperative launch failed: %s (grid %d)\n", hipGetErrorString(e), grid_blocks);
#endif
}
```

```cpp
#include <hip/hip_runtime.h>
#include <hip/hip_cooperative_groups.h>
#include <cstdio>
namespace cg = cooperative_groups;

typedef unsigned short u16;
typedef __attribute__((ext_vector_type(8))) short bf16x8;
typedef __attribute__((ext_vector_type(4))) float f32x4;
typedef __attribute__((ext_vector_type(4))) unsigned int u32x4;
typedef __attribute__((ext_vector_type(2))) unsigned int u32x2;

#ifndef MULTI_LAUNCH
#define MULTI_LAUNCH 0
#endif
#ifndef DUP_MASK
#define DUP_MASK 0
#endif
#ifndef ATT_NSUB
#define ATT_NSUB 2
#endif
#ifndef AT_MASK
#define AT_MASK 15
#endif
#ifndef PH_MASK
#if MULTI_LAUNCH
#define PH_MASK 0
#else
#define PH_MASK 0xffff
#endif
#endif


#define LOG2E 1.4426950408889634f
#define S_ 8192
#define D_ 2048
#define NIN 14784
#define NINP 14848
#define L_ 4
#define O_DQ 1792
#define O_DK 2304
#define O_DV 2816
#define O_QL 3328
#define O_KVL 3712
#define O_KR 3968
#define O_MQ 4032
#define O_G 4544
#define O_MG 6592

enum { I_X = 0, I_MEM, I_POS, I_NORMG, I_WIN, I_SHIFT, I_W0, I_WUP, I_A0, I_AUP, I_KK, I_KA, I_RK, I_GNG, I_GNB,
       I_DQKG, I_DLAM, I_DSUBG, I_RELB, I_QLATG, I_KVLATG, I_WUQ, I_WUKV, I_NOPEG, I_ROPEG, I_MEMNG, I_WKV,
       I_MQKG, I_WBR, I_WOUT, N_INPUTS };

struct Params {
  const void* in[N_INPUTS];
  float* out;
  char* ws;
};

constexpr size_t al(size_t x) { return (x + 255) & ~(size_t)255; }
constexpr size_t OFF_WIN = 0;
constexpr size_t OFF_WB = OFF_WIN + al((size_t)L_ * NINP * D_ * 2);
constexpr size_t OFF_WO = OFF_WB + al((size_t)L_ * 4 * 2048 * 512 * 2);
constexpr size_t OFF_WUQ = OFF_WO + al((size_t)L_ * 2048 * 2048 * 2);
constexpr size_t OFF_WUKV = OFF_WUQ + al((size_t)L_ * 768 * 384 * 2);
constexpr size_t OFF_WKV = OFF_WUKV + al((size_t)L_ * 1024 * 256 * 2);
constexpr size_t OFF_MEMN = OFF_WKV + al((size_t)L_ * 1024 * 2048 * 2);
constexpr size_t OFF_KVMEM = OFF_MEMN + al((size_t)L_ * 256 * 2048 * 2);
constexpr size_t OFF_KMEM = OFF_KVMEM + al((size_t)L_ * 256 * 512 * 4);
constexpr size_t OFF_VTMEM = OFF_KMEM + al((size_t)L_ * 4 * 256 * 128 * 2);
constexpr size_t OFF_H = OFF_VTMEM + al((size_t)L_ * 4 * 128 * 256 * 2);
constexpr size_t OFF_P = OFF_H + al((size_t)S_ * D_ * 2);
constexpr size_t OFF_RWU = OFF_P + al((size_t)S_ * NINP * 2);
constexpr size_t OFF_SCR = OFF_RWU + al((size_t)S_ * 1792 * 4);
constexpr size_t OFF_SCV = OFF_SCR + al((size_t)S_ * 512 * 4);
constexpr size_t OFF_SCKK = OFF_SCV + al((size_t)S_ * 512 * 4);
constexpr size_t OFF_SCW = OFF_SCKK + al((size_t)S_ * 512 * 4);
constexpr size_t OFF_SCKD = OFF_SCW + al((size_t)2 * S_ * 512 * 4);
constexpr size_t OFF_SCB = OFF_SCKD + al((size_t)2 * S_ * 512 * 4);
constexpr size_t OFF_BONUS = OFF_SCB + al((size_t)2 * S_ * 512 * 4);
constexpr size_t OFF_YS = OFF_BONUS + al((size_t)S_ * 8 * 4);
constexpr size_t OFF_MQ = OFF_YS + al((size_t)2 * S_ * 512 * 4);
constexpr size_t OFF_MKV = OFF_MQ + al((size_t)S_ * 768 * 4);
constexpr size_t OFF_QM = OFF_MKV + al((size_t)S_ * 512 * 4);
constexpr size_t OFF_KM = OFF_QM + al((size_t)4 * S_ * 192 * 2);
constexpr size_t OFF_VTM = OFF_KM + al((size_t)4 * S_ * 192 * 2);
constexpr size_t OFF_VTD = OFF_VTM + al((size_t)4 * 128 * S_ * 2);
constexpr size_t OFF_OB = OFF_VTD + al((size_t)4 * 128 * S_ * 2);
constexpr size_t OFF_YG = OFF_OB + al((size_t)16 * S_ * 128 * 4);
constexpr size_t OFF_Z = OFF_YG + al((size_t)4 * S_ * 512 * 2);
constexpr size_t OFF_CNT = OFF_Z + al((size_t)S_ * D_ * 2);
constexpr size_t OFF_KPMM = OFF_CNT + 256;
constexpr size_t OFF_BAR = OFF_KPMM + 1024;
constexpr size_t OFF_OB2 = OFF_BAR + al(3456 * 4);
constexpr size_t OFF_ML = OFF_OB2 + al((size_t)16 * S_ * 128 * 4);
constexpr size_t WS_TOTAL = OFF_ML + (size_t)2 * 16 * S_ * 2 * 4;

#define SMEM_BYTES 49152

#define LBAR() asm volatile("s_waitcnt lgkmcnt(0)\n\ts_barrier" ::: "memory")
__device__ __forceinline__ int ltid() {
  int t = __builtin_amdgcn_workitem_id_x();
  asm volatile("" : "+v"(t));
  return t;
}
__device__ __forceinline__ int lbid() {
  int t = __builtin_amdgcn_workgroup_id_x();
  asm volatile("" : "+s"(t));
  return t;
}
typedef float f32x2_ __attribute__((ext_vector_type(2)));
typedef __bf16 bf16x2_ __attribute__((ext_vector_type(2)));
__device__ __forceinline__ unsigned pack2(float a, float b) {
  f32x2_ v = {a, b};
  return __builtin_bit_cast(unsigned, __builtin_convertvector(v, bf16x2_));
}
__device__ __forceinline__ u16 f2bf(float f) { return (u16)(pack2(f, 0.f) & 0xffffu); }
__device__ __forceinline__ float bf2f(u16 h) { return __uint_as_float(((unsigned)h) << 16); }
__device__ __forceinline__ float lo2f(unsigned u) { return __uint_as_float(u << 16); }
__device__ __forceinline__ float hi2f(unsigned u) { return __uint_as_float(u & 0xffff0000u); }
__device__ __forceinline__ float sigmoidf_(float x) { return 1.f / (1.f + __expf(-x)); }
__device__ __forceinline__ float wave_sum(float v) {
#pragma unroll
  for (int o = 32; o >= 1; o >>= 1) v += __shfl_xor(v, o);
  return v;
}
template <int CTRL>
__device__ __forceinline__ float dpp_add(float x) {
  return x + __int_as_float(__builtin_amdgcn_update_dpp(0, __float_as_int(x), CTRL, 0xf, 0xf, true));
}
__device__ __forceinline__ float row16_sum(float x) {
  x = dpp_add<0xB1>(x);
  x = dpp_add<0x4E>(x);
  x = dpp_add<0x141>(x);
  x = dpp_add<0x140>(x);
  return x;
}

template <bool SW>
__device__ __forceinline__ void gemm_main1(const u16* __restrict__ A, int lda, const u16* __restrict__ B, int ldb,
                                          int K, u16* As, u16* Bs, f32x4 (&acc)[4][4]) {
  const int tid = ltid(), lane = tid & 63, w = tid >> 6, l15 = lane & 15, quad = lane >> 4;
  const int wm = w >> 1, wn = w & 1;
  u32x4 ra[4], rb[4];
#pragma unroll
  for (int i = 0; i < 4; ++i) {
    int c = tid + i * 256, r = c >> 3, kc = c & 7;
    ra[i] = *(const u32x4*)(A + (size_t)r * lda + kc * 8);
    rb[i] = *(const u32x4*)(B + (size_t)r * ldb + kc * 8);
  }
  for (int k0 = 0; k0 < K; k0 += 64) {
    LBAR();
#pragma unroll
    for (int i = 0; i < 4; ++i) {
      int c = tid + i * 256, r = c >> 3, kc = c & 7;
      *(u32x4*)(As + r * 64 + ((kc ^ (r & 7)) * 8)) = ra[i];
      *(u32x4*)(Bs + r * 64 + ((kc ^ (r & 7)) * 8)) = rb[i];
    }
    LBAR();
    {
      const int kn = min(k0 + 64, K - 64);
#pragma unroll
      for (int i = 0; i < 4; ++i) {
        int c = tid + i * 256, r = c >> 3, kc = c & 7;
        ra[i] = *(const u32x4*)(A + (size_t)r * lda + kn + kc * 8);
        rb[i] = *(const u32x4*)(B + (size_t)r * ldb + kn + kc * 8);
      }
    }
#pragma unroll
    for (int ks = 0; ks < 2; ++ks) {
      bf16x8 af[4], bfr[4];
#pragma unroll
      for (int i = 0; i < 4; ++i) {
        af[i] = *(const bf16x8*)(As + (wm * 64 + i * 16 + l15) * 64 + (((ks * 4 + quad) ^ (l15 & 7)) * 8));
        bfr[i] = *(const bf16x8*)(Bs + (wn * 64 + i * 16 + l15) * 64 + (((ks * 4 + quad) ^ (l15 & 7)) * 8));
      }
#pragma unroll
      for (int i = 0; i < 4; ++i)
#pragma unroll
        for (int j = 0; j < 4; ++j) acc[i][j] = SW ? __builtin_amdgcn_mfma_f32_16x16x32_bf16(bfr[j], af[i], acc[i][j], 0, 0, 0)
                                                     : __builtin_amdgcn_mfma_f32_16x16x32_bf16(af[i], bfr[j], acc[i][j], 0, 0, 0);
    }
  }
}

template <bool SW>
__device__ __forceinline__ void gemm_main(const u16* __restrict__ A, int lda, const u16* __restrict__ B, int ldb,
                                          int K, u16* As, u16* Bs, f32x4 (&acc)[4][4]) {
  const int tid = ltid(), lane = tid & 63, w = tid >> 6, l15 = lane & 15, quad = lane >> 4;
  const int wm = w >> 1, wn = w & 1;
  u32x4 ra0[4], rb0[4], ra1[4], rb1[4];
  const u16* Ap = A + (size_t)(tid >> 3) * lda + (tid & 7) * 8;
  const u16* Bp = B + (size_t)(tid >> 3) * ldb + (tid & 7) * 8;
  const size_t sa = (size_t)32 * lda, sb = (size_t)32 * ldb;
#define G_LOAD(RA, RB, KK)                                            \
  {                                                                   \
    const int kk_ = min((KK), K - 64);                                \
    _Pragma("unroll") for (int i = 0; i < 4; ++i) {                   \
      RA[i] = *(const u32x4*)(Ap + i * sa + kk_);                     \
      RB[i] = *(const u32x4*)(Bp + i * sb + kk_);                     \
    }                                                                 \
  }
#define G_STAGE(RA, RB, KNEXT)                                                                   \
  {                                                                                              \
    LBAR();                                                                             \
    _Pragma("unroll") for (int i = 0; i < 4; ++i) {                                              \
      *(u32x4*)(As + ((tid >> 3) + i * 32) * 64 + (((tid & 7) ^ ((tid >> 3) & 7)) * 8)) = RA[i]; \
      *(u32x4*)(Bs + ((tid >> 3) + i * 32) * 64 + (((tid & 7) ^ ((tid >> 3) & 7)) * 8)) = RB[i]; \
    }                                                                                            \
    LBAR();                                                                             \
    G_LOAD(RA, RB, KNEXT)                                                                        \
    {                                                                                            \
      bf16x8 af[2][4], bfr[2][4];                                                                \
      _Pragma("unroll") for (int ks = 0; ks < 2; ++ks)                                           \
        _Pragma("unroll") for (int i = 0; i < 4; ++i) {                                          \
          af[ks][i] = *(const bf16x8*)(As + (wm * 64 + i * 16 + l15) * 64 + (((ks * 4 + quad) ^ (l15 & 7)) * 8));  \
          bfr[ks][i] = *(const bf16x8*)(Bs + (wn * 64 + i * 16 + l15) * 64 + (((ks * 4 + quad) ^ (l15 & 7)) * 8)); \
        }                                                                                        \
      __builtin_amdgcn_sched_barrier(0);                                                         \
      _Pragma("unroll") for (int ks = 0; ks < 2; ++ks)                                           \
        _Pragma("unroll") for (int i = 0; i < 4; ++i)                                            \
          _Pragma("unroll") for (int j = 0; j < 4; ++j)                                          \
            acc[i][j] = SW ? __builtin_amdgcn_mfma_f32_16x16x32_bf16(bfr[ks][j], af[ks][i], acc[i][j], 0, 0, 0) \
                           : __builtin_amdgcn_mfma_f32_16x16x32_bf16(af[ks][i], bfr[ks][j], acc[i][j], 0, 0, 0); \
    }                                                                                            \
  }
  G_LOAD(ra0, rb0, 0)
  G_LOAD(ra1, rb1, 64)
  for (int k0 = 0; k0 < K; k0 += 128) {
    G_STAGE(ra0, rb0, k0 + 128)
    G_STAGE(ra1, rb1, k0 + 192)
  }
#undef G_LOAD
#undef G_STAGE
}

__device__ __forceinline__ void gemm_main_blk(const u16* __restrict__ A, const u16* __restrict__ B,
                                          int K, u16* As, u16* Bs, f32x4 (&acc)[4][4]) {
  const int tid = ltid(), lane = tid & 63, w = tid >> 6, l15 = lane & 15, quad = lane >> 4;
  const int wm = w >> 1, wn = w & 1;
  u32x4 ra0[4], rb0[4], ra1[4], rb1[4];
  const u16* Ap = A + tid * 8;
  const u16* Bp = B + tid * 8;
#define G_LOAD(RA, RB, KK)                                            \
  {                                                                   \
    const int kk_ = min((KK), K - 64);                                \
    _Pragma("unroll") for (int i = 0; i < 4; ++i) {                   \
      RA[i] = *(const u32x4*)(Ap + (size_t)kk_ * 128 + i * 2048);    \
      RB[i] = *(const u32x4*)(Bp + (size_t)kk_ * 128 + i * 2048);    \
    }                                                                 \
  }
#define G_STAGE(RA, RB, KNEXT)                                                                   \
  {                                                                                              \
    LBAR();                                                                             \
    _Pragma("unroll") for (int i = 0; i < 4; ++i) {                                              \
      *(u32x4*)(As + i * 2048 + tid * 8) = RA[i];                                                \
      *(u32x4*)(Bs + i * 2048 + tid * 8) = RB[i];                                                \
    }                                                                                            \
    LBAR();                                                                             \
    G_LOAD(RA, RB, KNEXT)                                                                        \
    {                                                                                            \
      bf16x8 af[2][4], bfr[2][4];                                                                \
      _Pragma("unroll") for (int ks = 0; ks < 2; ++ks)                                           \
        _Pragma("unroll") for (int i = 0; i < 4; ++i) {                                          \
          af[ks][i] = *(const bf16x8*)(As + (wm * 64 + i * 16 + l15) * 64 + (((ks * 4 + quad) ^ (l15 & 7)) * 8));  \
          bfr[ks][i] = *(const bf16x8*)(Bs + (wn * 64 + i * 16 + l15) * 64 + (((ks * 4 + quad) ^ (l15 & 7)) * 8)); \
        }                                                                                        \
      __builtin_amdgcn_sched_barrier(0);                                                         \
      _Pragma("unroll") for (int ks = 0; ks < 2; ++ks)                                           \
        _Pragma("unroll") for (int i = 0; i < 4; ++i)                                            \
          _Pragma("unroll") for (int j = 0; j < 4; ++j)                                          \
            acc[i][j] = __builtin_amdgcn_mfma_f32_16x16x32_bf16(af[ks][i], bfr[ks][j], acc[i][j], 0, 0, 0); \
    }                                                                                            \
  }
  G_LOAD(ra0, rb0, 0)
  G_LOAD(ra1, rb1, 64)
  for (int k0 = 0; k0 < K; k0 += 128) {
    G_STAGE(ra0, rb0, k0 + 128)
    G_STAGE(ra1, rb1, k0 + 192)
  }
#undef G_LOAD
#undef G_STAGE
}

#define ZERO_ACC(acc)                                  \
  _Pragma("unroll") for (int i_ = 0; i_ < 4; ++i_)     \
  _Pragma("unroll") for (int j_ = 0; j_ < 4; ++j_) acc[i_][j_] = (f32x4){0.f, 0.f, 0.f, 0.f};

#define EPI_LOOP_T(BODY)                                                           \
  {                                                                                \
    const int lane_ = ltid() & 63, w_ = ltid() >> 6;                               \
    const int l15_ = lane_ & 15, quad_ = lane_ >> 4, wm_ = w_ >> 1, wn_ = w_ & 1;  \
    _Pragma("unroll") for (int i = 0; i < 4; ++i) {                                \
      _Pragma("unroll") for (int j = 0; j < 4; ++j) {                              \
        const int mr = wm_ * 64 + i * 16 + l15_;                                   \
        const int nc = wn_ * 64 + j * 16 + quad_ * 4;                              \
        BODY                                                                       \
      }                                                                            \
    }                                                                              \
  }

#define EPI_LOOP(BODY)                                                             \
  {                                                                                \
    const int lane_ = ltid() & 63, w_ = ltid() >> 6;                     \
    const int l15_ = lane_ & 15, quad_ = lane_ >> 4, wm_ = w_ >> 1, wn_ = w_ & 1;  \
    _Pragma("unroll") for (int i = 0; i < 4; ++i) {                                \
      _Pragma("unroll") for (int j = 0; j < 4; ++j) {                              \
        const int mr = wm_ * 64 + i * 16 + quad_ * 4;                              \
        const int nc = wn_ * 64 + j * 16 + l15_;                                   \
        BODY                                                                       \
      }                                                                            \
    }                                                                              \
  }

__device__ __forceinline__ void gemm_main_blk2(const u16* __restrict__ A, const u16* __restrict__ B, int K, u16* As, u16* Bs,
                                               f32x4 (&acc)[8][4]) {
  const int tid = ltid(), lane = tid & 63, w = tid >> 6, l15 = lane & 15, quad = lane >> 4;
  const int wm = w >> 1, wn = w & 1;
  u32x4 ra[8], rb[4];
  const u16* Ap = A + tid * 8;
  const u16* Bp = B + tid * 8;
  const size_t a2 = (size_t)(K >> 6) * 8192;
#define G2_LOAD(KK)                                                       \
  {                                                                       \
    const int kk_ = min((KK), K - 64);                                    \
    _Pragma("unroll") for (int i = 0; i < 4; ++i) {                       \
      ra[i] = *(const u32x4*)(Ap + (size_t)kk_ * 128 + i * 2048);         \
      ra[4 + i] = *(const u32x4*)(Ap + a2 + (size_t)kk_ * 128 + i * 2048); \
      rb[i] = *(const u32x4*)(Bp + (size_t)kk_ * 128 + i * 2048);         \
    }                                                                     \
  }
  G2_LOAD(0)
  for (int k0 = 0; k0 < K; k0 += 64) {
    LBAR();
#pragma unroll
    for (int i = 0; i < 8; ++i) *(u32x4*)(As + i * 2048 + tid * 8) = ra[i];
#pragma unroll
    for (int i = 0; i < 4; ++i) *(u32x4*)(Bs + i * 2048 + tid * 8) = rb[i];
    LBAR();
    G2_LOAD(k0 + 64)
#pragma unroll
    for (int ks = 0; ks < 2; ++ks) {
      bf16x8 af[8], bfr[4];
#pragma unroll
      for (int i = 0; i < 8; ++i)
        af[i] = *(const bf16x8*)(As + (wm * 128 + i * 16 + l15) * 64 + (((ks * 4 + quad) ^ (l15 & 7)) * 8));
#pragma unroll
      for (int j = 0; j < 4; ++j)
        bfr[j] = *(const bf16x8*)(Bs + (wn * 64 + j * 16 + l15) * 64 + (((ks * 4 + quad) ^ (l15 & 7)) * 8));
#pragma unroll
      for (int i = 0; i < 8; ++i)
#pragma unroll
        for (int j = 0; j < 4; ++j) acc[i][j] = __builtin_amdgcn_mfma_f32_16x16x32_bf16(af[i], bfr[j], acc[i][j], 0, 0, 0);
    }
  }
#undef G2_LOAD
}

#define EPI_LOOP8(BODY)                                                            \
  {                                                                                \
    const int lane_ = ltid() & 63, w_ = ltid() >> 6;                               \
    const int l15_ = lane_ & 15, quad_ = lane_ >> 4, wm_ = w_ >> 1, wn_ = w_ & 1;  \
    _Pragma("unroll") for (int i = 0; i < 8; ++i) {                                \
      _Pragma("unroll") for (int j = 0; j < 4; ++j) {                              \
        const int mr = wm_ * 128 + i * 16 + quad_ * 4;                             \
        const int nc = wn_ * 64 + j * 16 + l15_;                                   \
        BODY                                                                       \
      }                                                                            \
    }                                                                              \
  }

template <bool BLK>
__device__ __forceinline__ void transpose_tile(const float* __restrict__ src, int N, u16* __restrict__ dst, int K, int kt, int nt,
                               float* tile) {
  const int tid = ltid();
  __syncthreads();
  {
    int c = tid & 63, r0 = tid >> 6;
#pragma unroll
    for (int i = 0; i < 16; ++i) {
      int r = r0 + i * 4;
      tile[r * 65 + c] = src[(size_t)(kt * 64 + r) * N + nt * 64 + c];
    }
  }
  __syncthreads();
#pragma unroll
  for (int i = 0; i < 2; ++i) {
    int c = tid + i * 256, n = c >> 3, kc = c & 7;
    uint4 o;
    o.x = pack2(tile[(kc * 8 + 0) * 65 + n], tile[(kc * 8 + 1) * 65 + n]);
    o.y = pack2(tile[(kc * 8 + 2) * 65 + n], tile[(kc * 8 + 3) * 65 + n]);
    o.z = pack2(tile[(kc * 8 + 4) * 65 + n], tile[(kc * 8 + 5) * 65 + n]);
    o.w = pack2(tile[(kc * 8 + 6) * 65 + n], tile[(kc * 8 + 7) * 65 + n]);
    if (BLK) {
      const int ng = nt * 64 + n;
      *(uint4*)(dst + ((size_t)(ng >> 7) * (K >> 6) + kt) * 8192 + (ng & 127) * 64 + ((kc ^ (ng & 7)) * 8)) = o;
    } else {
      *(uint4*)(dst + (size_t)(nt * 64 + n) * K + kt * 64 + kc * 8) = o;
    }
  }
}

template <bool BLK>
__device__ __forceinline__ void rms_rows(const float* __restrict__ src, int nrows, const float* __restrict__ g, u16* __restrict__ dst) {
  const int lane = ltid() & 63, w = ltid() >> 6;
  for (int row = lbid() * 4 + w; row < nrows; row += gridDim.x * 4) {
    const float4* xr = (const float4*)(src + (size_t)row * D_);
    float4 v[8];
    float ss = 0.f;
#pragma unroll
    for (int i = 0; i < 8; ++i) {
      v[i] = xr[lane + i * 64];
      ss += v[i].x * v[i].x + v[i].y * v[i].y + v[i].z * v[i].z + v[i].w * v[i].w;
    }
    ss = wave_sum(ss);
    float rs = rsqrtf(ss * (1.f / D_) + 1e-6f);
#pragma unroll
    for (int i = 0; i < 8; ++i) {
      int col = (lane + i * 64) * 4;
      float4 gg = *(const float4*)(g + col);
      uint2 o;
      o.x = pack2(v[i].x * rs * gg.x, v[i].y * rs * gg.y);
      o.y = pack2(v[i].z * rs * gg.z, v[i].w * rs * gg.w);
      if (BLK) {
        *(uint2*)(dst + ((size_t)(row >> 7) * 32 + (col >> 6)) * 8192 + (row & 127) * 64 + ((((col & 63) >> 3) ^ (row & 7)) * 8) + (col & 7)) = o;
      } else {
        *(uint2*)(dst + (size_t)row * D_ + col) = o;
      }
    }
  }
}

__device__ __forceinline__ int t5_bucket(int rel) {
  int n = rel < 0 ? -rel : rel;
  int b;
  if (n < 8) b = n;
  else if (n < 12) b = 8;
  else if (n < 16) b = 9;
  else if (n < 23) b = 10;
  else if (n < 32) b = 11;
  else if (n < 46) b = 12;
  else if (n < 64) b = 13;
  else if (n < 91) b = 14;
  else b = 15;
  return (rel > 0 ? 16 : 0) + b;
}

__device__ __forceinline__ void phase_w(const Params p, char* smem) {
  const int tid = ltid();
  float* tile = (float*)smem;
  char* ws = p.ws;
  if (lbid() == 0 && tid < 64) ((int*)(ws + OFF_CNT))[tid] = 0;
  {
    const int lane = tid & 63, w = tid >> 6;
    const int* pos = (const int*)p.in[I_POS];
    for (int t = lbid() * 4 + w; t < 128; t += gridDim.x * 4) {
      int v = pos[t * 64 + lane], mn = v, mx = v;
#pragma unroll
      for (int o = 32; o >= 1; o >>= 1) {
        mn = min(mn, __shfl_xor(mn, o));
        mx = max(mx, __shfl_xor(mx, o));
      }
      if (lane == 0) {
        ((int*)(ws + OFF_KPMM))[t * 2] = mn;
        ((int*)(ws + OFF_KPMM))[t * 2 + 1] = mx;
      }
    }
  }
  for (int i = lbid() * 256 + tid; i < L_ * 32 * 512; i += gridDim.x * 256) {
    int l = i / (32 * 512), r = i % (32 * 512), kt = r >> 9, q = r & 511;
    *(uint4*)((u16*)(ws + OFF_WIN) + (size_t)l * NINP * D_ + ((size_t)115 * 32 + kt) * 8192 + 4096 + q * 8) = make_uint4(0, 0, 0, 0);
  }
  rms_rows<true>((const float*)p.in[I_X], S_, (const float*)p.in[I_NORMG], (u16*)(ws + OFF_H));
  for (int l = 0; l < L_; ++l)
    rms_rows<false>((const float*)p.in[I_MEM], 256, (const float*)p.in[I_MEMNG] + l * D_, (u16*)(ws + OFF_MEMN) + (size_t)l * 256 * D_);
  const int PER_L = 7392 + 1024 + 1024 + 72 + 64 + 512;
  for (int t = lbid(); t < L_ * PER_L; t += gridDim.x) {
    int l = t / PER_L, r = t % PER_L;
    if (r < 7392) {
      transpose_tile<true>((const float*)p.in[I_WIN] + (size_t)l * D_ * NIN, NIN, (u16*)(ws + OFF_WIN) + (size_t)l * NINP * D_, D_,
                     r / 231, r % 231, tile);
    } else if (r < 7392 + 1024) {
      r -= 7392;
      int bi = r >> 8;
      r &= 255;
      transpose_tile<false>((const float*)p.in[I_WBR] + (size_t)(l * 4 + bi) * 512 * 2048, 2048,
                     (u16*)(ws + OFF_WB) + (size_t)(l * 4 + bi) * 2048 * 512, 512, r >> 5, r & 31, tile);
    } else if (r < 7392 + 2048) {
      r -= 7392 + 1024;
      transpose_tile<false>((const float*)p.in[I_WOUT] + (size_t)l * 2048 * 2048, 2048, (u16*)(ws + OFF_WO) + (size_t)l * 2048 * 2048,
                     2048, r >> 5, r & 31, tile);
    } else if (r < 7392 + 2048 + 72) {
      r -= 7392 + 2048;
      transpose_tile<false>((const float*)p.in[I_WUQ] + (size_t)l * 384 * 768, 768, (u16*)(ws + OFF_WUQ) + (size_t)l * 768 * 384, 384,
                     r / 12, r % 12, tile);
    } else if (r < 7392 + 2048 + 72 + 64) {
      r -= 7392 + 2048 + 72;
      transpose_tile<false>((const float*)p.in[I_WUKV] + (size_t)l * 256 * 1024, 1024, (u16*)(ws + OFF_WUKV) + (size_t)l * 1024 * 256,
                     256, r >> 4, r & 15, tile);
    } else {
      r -= 7392 + 2048 + 72 + 64;
      transpose_tile<false>((const float*)p.in[I_WKV] + (size_t)l * 2048 * 1024, 1024, (u16*)(ws + OFF_WKV) + (size_t)l * 1024 * 2048,
                     2048, r >> 4, r & 15, tile);
    }
  }
}

__device__ __forceinline__ int tile_slots(int NT) { return gridDim.x == 512 ? 512 * ((NT + 7) >> 3) : 64 * NT; }
__device__ __forceinline__ bool tile_map(int t, int NT, int& mt, int& nt) {
  if (gridDim.x == 512) {
    int bid = t & 511, k = t >> 9, x = bid & 7, j = bid >> 3;
    mt = 8 * x + (j & 7);
    nt = 8 * k + (j >> 3);
  } else {
    mt = t & 63;
    nt = t >> 6;
  }
  return nt < NT;
}

__device__ __forceinline__ int tile_slots2(int NT) { return gridDim.x == 512 ? 512 * ((NT + 15) >> 4) : 32 * NT; }
__device__ __forceinline__ bool tile_map2(int t, int NT, int& mt, int& nt) {
  if (gridDim.x == 512) {
    int bid = t & 511, k = t >> 9, x = bid & 7, j = bid >> 3;
    mt = 4 * x + (j & 3);
    nt = 16 * k + (j >> 2);
  } else {
    mt = t & 31;
    nt = t >> 5;
  }
  return nt < NT;
}

__device__ __forceinline__ void phase_gemm_in(const Params p, int l, char* smem, int vb) {
  u16* As = (u16*)smem;
  char* ws = p.ws;
  {
    u16* Bs = As + 256 * 64;
    const int nslots = tile_slots2(112);
    for (int t = vb; t < nslots; t += gridDim.x) {
      int mt, nt;
      if (!tile_map2(t, 112, mt, nt)) continue;
      f32x4 acc[8][4];
#pragma unroll
      for (int i_ = 0; i_ < 8; ++i_)
#pragma unroll
        for (int j_ = 0; j_ < 4; ++j_) acc[i_][j_] = (f32x4){0.f, 0.f, 0.f, 0.f};
      int m0 = mt * 256, n0 = nt * 128;
      gemm_main_blk2((const u16*)(ws + OFF_H) + (size_t)(2 * mt) * 32 * 8192,
                     (const u16*)(ws + OFF_WIN) + (size_t)l * NINP * D_ + (size_t)nt * 32 * 8192, D_, As, Bs, acc);
      if (n0 < 1792) {
        float* dst = (float*)(ws + OFF_RWU);
        EPI_LOOP8({
          _Pragma("unroll") for (int r2 = 0; r2 < 4; ++r2) dst[(size_t)(m0 + mr + r2) * 1792 + n0 + nc] = acc[i][j][r2];
        })
      } else if (n0 >= O_DV && n0 < O_QL) {
        u16* dst = (u16*)(ws + OFF_VTD) + (size_t)((n0 - O_DV) / 128) * 128 * S_;
        EPI_LOOP8({
          uint2 o;
          o.x = pack2(acc[i][j][0], acc[i][j][1]);
          o.y = pack2(acc[i][j][2], acc[i][j][3]);
          *(uint2*)(dst + (size_t)nc * S_ + m0 + mr) = o;
        })
      } else {
        u16* dst = (u16*)(ws + OFF_P);
        EPI_LOOP8({
          _Pragma("unroll") for (int r2 = 0; r2 < 4; ++r2) dst[(size_t)(m0 + mr + r2) * NINP + n0 + nc] = f2bf(acc[i][j][r2]);
        })
      }
    }
  }
  {
    u16* Bs = As + 128 * 64;
    for (int t = vb; t < 256; t += gridDim.x) {
      f32x4 acc[4][4];
      ZERO_ACC(acc);
      int mt = t & 63, nt = 112 + (t >> 6);
      int m0 = mt * 128, n0 = nt * 128;
      gemm_main_blk((const u16*)(ws + OFF_H) + (size_t)mt * 32 * 8192,
                    (const u16*)(ws + OFF_WIN) + (size_t)l * NINP * D_ + (size_t)nt * 32 * 8192, D_, As, Bs, acc);
      u16* dst = (u16*)(ws + OFF_P);
      EPI_LOOP({
        _Pragma("unroll") for (int r2 = 0; r2 < 4; ++r2) dst[(size_t)(m0 + mr + r2) * NINP + n0 + nc] = f2bf(acc[i][j][r2]);
      })
    }
  }
  if (l == 0) {
    u16* Bs = As + 128 * 64;
    for (int tt = (vb + gridDim.x - 256) % gridDim.x; tt < 64; tt += gridDim.x) {
      f32x4 acc[4][4];
      ZERO_ACC(acc);
      int ll = tt >> 4, mt = (tt >> 3) & 1, nt = tt & 7;
      int m0 = mt * 128, n0 = nt * 128;
      gemm_main<false>((const u16*)(ws + OFF_MEMN) + ((size_t)ll * 256 + m0) * D_, D_, (const u16*)(ws + OFF_WKV) + ((size_t)ll * 1024 + n0) * D_,
                D_, D_, As, Bs, acc);
      if (nt < 4) {
        float* dst = (float*)(ws + OFF_KVMEM) + (size_t)ll * 256 * 512;
        EPI_LOOP({
          _Pragma("unroll") for (int r2 = 0; r2 < 4; ++r2) dst[(size_t)(m0 + mr + r2) * 512 + n0 + nc] = acc[i][j][r2];
        })
      } else {
        u16* dst = (u16*)(ws + OFF_VTMEM) + (size_t)(ll * 4 + (nt - 4)) * 128 * 256;
        EPI_LOOP({
          uint2 o;
          o.x = pack2(acc[i][j][0], acc[i][j][1]);
          o.y = pack2(acc[i][j][2], acc[i][j][3]);
          *(uint2*)(dst + (size_t)nc * 256 + m0 + mr) = o;
        })
      }
    }
  }
}

__device__ __forceinline__ void phase_gemm_mla(const Params p, int l, char* smem, int vb) {
  u16* As = (u16*)smem;
  u16* Bs = As + 128 * 64;
  char* ws = p.ws;
  const u16* P = (const u16*)(ws + OFF_P);
  const int nslots = tile_slots(14);
  for (int t = vb; t < nslots; t += gridDim.x) {
    f32x4 acc[4][4];
    ZERO_ACC(acc);
    int mt, nt;
    if (!tile_map(t, 14, mt, nt)) continue;
    int m0 = mt * 128;
    if (nt < 6) {
      int n0 = nt * 128;
      gemm_main<true>(P + (size_t)m0 * NINP + O_QL, NINP, (const u16*)(ws + OFF_WUQ) + ((size_t)l * 768 + n0) * 384, 384, 384, As, Bs, acc);
      u16* dst = (u16*)(ws + OFF_MQ);
      EPI_LOOP_T({
        uint2 o;
        o.x = pack2(acc[i][j][0], acc[i][j][1]);
        o.y = pack2(acc[i][j][2], acc[i][j][3]);
        *(uint2*)(dst + (size_t)(m0 + mr) * 768 + n0 + nc) = o;
      })
    } else {
      nt -= 6;
      int n0 = nt * 128, h = nt >> 1;
      if ((nt & 1) == 0) {
        gemm_main<true>(P + (size_t)m0 * NINP + O_KVL, NINP, (const u16*)(ws + OFF_WUKV) + ((size_t)l * 1024 + n0) * 256, 256, 256, As, Bs, acc);
        u16* dst = (u16*)(ws + OFF_MKV);
        EPI_LOOP_T({
          uint2 o;
          o.x = pack2(acc[i][j][0], acc[i][j][1]);
          o.y = pack2(acc[i][j][2], acc[i][j][3]);
          *(uint2*)(dst + (size_t)(m0 + mr) * 512 + h * 128 + nc) = o;
        })
      } else {
        gemm_main<false>(P + (size_t)m0 * NINP + O_KVL, NINP, (const u16*)(ws + OFF_WUKV) + ((size_t)l * 1024 + n0) * 256, 256, 256, As, Bs, acc);
        u16* dst = (u16*)(ws + OFF_VTM) + (size_t)h * 128 * S_;
        EPI_LOOP({
          uint2 o;
          o.x = pack2(acc[i][j][0], acc[i][j][1]);
          o.y = pack2(acc[i][j][2], acc[i][j][3]);
          *(uint2*)(dst + (size_t)nc * S_ + m0 + mr) = o;
        })
      }
    }
  }
}

__device__ __forceinline__ void phase_gemm_branch(const Params p, int l, char* smem, int vb) {
  u16* As = (u16*)smem;
  u16* Bs = As + 128 * 64;
  char* ws = p.ws;
  const u16* P = (const u16*)(ws + OFF_P);
  const int nslots = tile_slots(16);
  for (int t = vb; t < nslots; t += gridDim.x) {
    int mt, nt;
    if (!tile_map(t, 16, mt, nt)) continue;
    int m0 = mt * 128, n0 = nt * 128;
    f32x4 zacc[4][4];
    ZERO_ACC(zacc);
    for (int bi = 0; bi < 4; ++bi) {
      f32x4 acc[4][4];
      ZERO_ACC(acc);
      gemm_main1<true>((const u16*)(ws + OFF_YG) + ((size_t)bi * S_ + m0) * 512, 512,
                (const u16*)(ws + OFF_WB) + ((size_t)(l * 4 + bi) * 2048 + n0) * 512, 512, 512, As, Bs, acc);
      EPI_LOOP_T({
        const uint2 mg = *(const uint2*)(P + (size_t)(m0 + mr) * NINP + O_MG + bi * 2048 + n0 + nc);
        zacc[i][j][0] += sigmoidf_(lo2f(mg.x)) * acc[i][j][0];
        zacc[i][j][1] += sigmoidf_(hi2f(mg.x)) * acc[i][j][1];
        zacc[i][j][2] += sigmoidf_(lo2f(mg.y)) * acc[i][j][2];
        zacc[i][j][3] += sigmoidf_(hi2f(mg.y)) * acc[i][j][3];
      })
    }
    u16* dst = (u16*)(ws + OFF_Z);
    EPI_LOOP_T({
      uint2 o;
      o.x = pack2(zacc[i][j][0], zacc[i][j][1]);
      o.y = pack2(zacc[i][j][2], zacc[i][j][3]);
      *(uint2*)(dst + (size_t)(m0 + mr) * D_ + n0 + nc) = o;
    })
  }
}

__device__ __forceinline__ void phase_gemm_out(const Params p, int l, char* smem, int vb) {
  u16* As = (u16*)smem;
  u16* Bs = As + 128 * 64;
  char* ws = p.ws;
  const float* xin = (l == 0) ? (const float*)p.in[I_X] : (const float*)p.out;
  const int nslots = tile_slots(16);
  for (int t = vb; t < nslots; t += gridDim.x) {
    int mt, nt;
    if (!tile_map(t, 16, mt, nt)) continue;
    int m0 = mt * 128, n0 = nt * 128;
    f32x4 acc[4][4];
    ZERO_ACC(acc);
    gemm_main<true>((const u16*)(ws + OFF_Z) + (size_t)m0 * D_, D_, (const u16*)(ws + OFF_WO) + ((size_t)l * 2048 + n0) * D_, D_, D_, As, Bs,
              acc);
    EPI_LOOP_T({
      size_t idx = (size_t)(m0 + mr) * D_ + n0 + nc;
      float4 xv = *(const float4*)(xin + idx);
      *(float4*)(p.out + idx) = make_float4(xv.x + acc[i][j][0], xv.y + acc[i][j][1], xv.z + acc[i][j][2], xv.w + acc[i][j][3]);
    })
  }
}

__device__ __forceinline__ void seg_norm8(u16* ptr, bool active, int width, float inv_n, const float* g, float scale) {
  uint4 v = make_uint4(0, 0, 0, 0);
  if (active) v = *(const uint4*)ptr;
  float x[8] = {lo2f(v.x), hi2f(v.x), lo2f(v.y), hi2f(v.y), lo2f(v.z), hi2f(v.z), lo2f(v.w), hi2f(v.w)};
  float ss = 0.f;
#pragma unroll
  for (int i = 0; i < 8; ++i) ss += x[i] * x[i];
  for (int o = 1; o < width; o <<= 1) ss += __shfl_xor(ss, o);
  float rs = rsqrtf(ss * inv_n + 1e-6f) * scale;
  if (active) {
    float4 g0 = *(const float4*)g, g1 = *(const float4*)(g + 4);
    uint4 o;
    o.x = pack2(x[0] * rs * g0.x, x[1] * rs * g0.y);
    o.y = pack2(x[2] * rs * g0.z, x[3] * rs * g0.w);
    o.z = pack2(x[4] * rs * g1.x, x[5] * rs * g1.y);
    o.w = pack2(x[6] * rs * g1.z, x[7] * rs * g1.w);
    *(uint4*)ptr = o;
  }
}

template <bool RWONLY>
__device__ __forceinline__ void phase_prep(const Params p, int l, char* smem) {
  char* ws = p.ws;
  const int tid = ltid(), lane = tid & 63, w = tid >> 6;
  u16* P = (u16*)(ws + OFF_P);
  if (!RWONLY) {
    const float* dqg = (const float*)p.in[I_DQKG] + l * 128;
    const float* mqg = (const float*)p.in[I_MQKG] + l * 256;
    const float* qlg = (const float*)p.in[I_QLATG] + l * 384;
    const float* kvg = (const float*)p.in[I_KVLATG] + l * 256;
    for (int s = lbid() * 4 + w; s < S_; s += gridDim.x * 4) {
      u16* row = P + (size_t)s * NINP;
      seg_norm8(row + O_DQ + lane * 8, true, 8, 1.f / 64, dqg + (lane * 8) % 64, 0.125f * LOG2E);
      seg_norm8(row + O_DK + lane * 8, true, 8, 1.f / 64, dqg + 64 + (lane * 8) % 64, 1.f);
      seg_norm8(row + O_MQ + lane * 8, true, 16, 1.f / 128, mqg + (lane * 8) % 128, 0.08838834764831845f * LOG2E);
      seg_norm8(row + O_QL + (lane < 48 ? lane : 0) * 8, lane < 48, 64, 1.f / 384, qlg + (lane < 48 ? lane : 0) * 8, 1.f);
      seg_norm8(row + O_KVL + (lane < 32 ? lane : 0) * 8, lane < 32, 64, 1.f / 256, kvg + (lane < 32 ? lane : 0) * 8, 1.f);
    }
  }
  if (l == 0 && !RWONLY) {
    for (int sg = lbid() * 4 + w; sg < L_ * 256 * 4; sg += gridDim.x * 4) {
      int ll = sg >> 10, m = (sg >> 2) & 255, h = sg & 3;
      const float* src = (const float*)(ws + OFF_KVMEM) + ((size_t)ll * 256 + m) * 512 + h * 128;
      float a = src[lane], b = src[lane + 64];
      float ss = wave_sum(a * a + b * b);
      float rs = rsqrtf(ss * (1.f / 128) + 1e-6f);
      const float* g = (const float*)p.in[I_MQKG] + ll * 256 + 128;
      u16* dst = (u16*)(ws + OFF_KMEM) + ((size_t)(ll * 4 + h) * 256 + m) * 128;
      dst[lane] = f2bf(a * rs * g[lane]);
      dst[lane + 64] = f2bf(b * rs * g[lane + 64]);
    }
  }
  {
    float* ld = (float*)smem;
    const float* RWU = (const float*)(ws + OFF_RWU);
    const float* sh = (const float*)p.in[I_SHIFT] + (size_t)l * 3 * 1792;
    const float* wup = (const float*)p.in[I_WUP] + (size_t)l * 2 * 64 * 512;
    const float* aup = (const float*)p.in[I_AUP] + (size_t)l * 2 * 64 * 512;
    const float* w0 = (const float*)p.in[I_W0] + l * 1024;
    const float* a0 = (const float*)p.in[I_A0] + l * 1024;
    const float* kkp = (const float*)p.in[I_KK] + l * 512;
    const float* kap = (const float*)p.in[I_KA] + l * 512;
    const float* rkp = (const float*)p.in[I_RK] + l * 512;
    for (int tile = lbid(); tile < S_ / 8; tile += gridDim.x) {
      const int s0 = tile * 8;
      __syncthreads();
      {
        int c = 1536 + tid;
        float c0 = sh[c], c1 = sh[1792 + c], c2 = sh[2 * 1792 + c];
#pragma unroll
        for (int tk = 0; tk < 8; ++tk) {
          int s = s0 + tk;
          float um = s > 0 ? RWU[(size_t)(s - 1) * 1792 + c] : 0.f;
          float u0 = RWU[(size_t)s * 1792 + c];
          float up = s < S_ - 1 ? RWU[(size_t)(s + 1) * 1792 + c] : 0.f;
          float v = c0 * um + c1 * u0 + c2 * up;
          if (tid < 128) v = tanhf(v);
          ld[tk * 256 + tid] = v;
        }
      }
      __syncthreads();
      float acc[8][4][2];
#pragma unroll
      for (int a = 0; a < 8; ++a)
#pragma unroll
        for (int b = 0; b < 4; ++b) acc[a][b][0] = acc[a][b][1] = 0.f;
      for (int l4 = 0; l4 < 16; ++l4) {
        float wv[4][4][2];
#pragma unroll
        for (int ll = 0; ll < 4; ++ll) {
#pragma unroll
          for (int ch = 0; ch < 2; ++ch) {
            int c = tid + ch * 256;
            int li = l4 * 4 + ll;
            wv[0][ll][ch] = wup[(size_t)(0 * 64 + li) * 512 + c];
            wv[1][ll][ch] = wup[(size_t)(1 * 64 + li) * 512 + c];
            wv[2][ll][ch] = aup[(size_t)(0 * 64 + li) * 512 + c];
            wv[3][ll][ch] = aup[(size_t)(1 * 64 + li) * 512 + c];
          }
        }
#pragma unroll
        for (int tk = 0; tk < 8; ++tk) {
#pragma unroll
          for (int mat = 0; mat < 4; ++mat) {
            float4 d = *(const float4*)(ld + tk * 256 + mat * 64 + l4 * 4);
#pragma unroll
            for (int ch = 0; ch < 2; ++ch) {
              acc[tk][mat][ch] += d.x * wv[mat][0][ch] + d.y * wv[mat][1][ch] + d.z * wv[mat][2][ch] + d.w * wv[mat][3][ch];
            }
          }
        }
      }
#pragma unroll
      for (int ch = 0; ch < 2; ++ch) {
        const int c = tid + ch * 256;
        float shc[3][3];
#pragma unroll
        for (int q = 0; q < 3; ++q)
#pragma unroll
          for (int j = 0; j < 3; ++j) shc[q][j] = sh[j * 1792 + q * 512 + c];
        const float kkc = kkp[c], kac = kap[c], rkc = rkp[c];
        const float w0c0 = w0[c], w0c1 = w0[512 + c], a0c0 = a0[c], a0c1 = a0[512 + c];
        float um[3], u0[3];
#pragma unroll
        for (int q = 0; q < 3; ++q) {
          um[q] = s0 > 0 ? RWU[(size_t)(s0 - 1) * 1792 + q * 512 + c] : 0.f;
          u0[q] = RWU[(size_t)s0 * 1792 + q * 512 + c];
        }
#pragma unroll
        for (int tk = 0; tk < 8; ++tk) {
          const int s = s0 + tk;
          float rkv[3];
#pragma unroll
          for (int q = 0; q < 3; ++q) {
            float up = s < S_ - 1 ? RWU[(size_t)(s + 1) * 1792 + q * 512 + c] : 0.f;
            rkv[q] = shc[q][0] * um[q] + shc[q][1] * u0[q] + shc[q][2] * up;
            um[q] = u0[q];
            u0[q] = up;
          }
          float r = rkv[0], k = rkv[1], v = rkv[2];
          float kkr = k * kkc;
          float ss = wave_sum(kkr * kkr);
          float kk = kkr / fmaxf(sqrtf(ss), 1e-12f);
          float bsum = 0.f;
#pragma unroll
          for (int n = 0; n < 2; ++n) {
            float zw = (n ? w0c1 : w0c0) + acc[tk][n][ch];
            float za = (n ? a0c1 : a0c0) + acc[tk][2 + n][ch];
            float dec = __expf(-0.6065306597126334f * sigmoidf_(zw));
            float a = sigmoidf_(za);
            float kd = k * (1.f + (a - 1.f) * kac);
            float bb = kk * a;
            size_t o = ((size_t)n * S_ + s) * 512 + c;
            ((float*)(ws + OFF_SCW))[o] = dec;
            ((float*)(ws + OFF_SCKD))[o] = kd;
            ((float*)(ws + OFF_SCB))[o] = bb;
            bsum += r * kd * rkc;
          }
          size_t o1 = (size_t)s * 512 + c;
          ((float*)(ws + OFF_SCR))[o1] = r;
          ((float*)(ws + OFF_SCV))[o1] = v;
          ((float*)(ws + OFF_SCKK))[o1] = kk;
          float bon = wave_sum(bsum);
          if (lane == 0) ((float*)(ws + OFF_BONUS))[s * 8 + w + 4 * ch] = bon;
        }
      }
    }
  }
}

__device__ __forceinline__ void phase_mla_post(const Params p, int l, char* smem) {
  char* ws = p.ws;
  const int lane = ltid() & 63, w = ltid() >> 6;
  const float* ng = (const float*)p.in[I_NOPEG] + l * 256;
  const float* rg = (const float*)p.in[I_ROPEG] + l * 128;
  const int* pos = (const int*)p.in[I_POS];
  const float qscale = 0.07216878364870322f * LOG2E;
  const int fi = lane & 31;
  const float inv_freq = powf(10000.f, -(float)fi / 32.f);
  for (int s = lbid() * 4 + w; s < S_; s += gridDim.x * 4) {
    float ang = (float)pos[s] * inv_freq;
    float cs = cosf(ang), sn = sinf(ang);
    const u16* mq = (const u16*)(ws + OFF_MQ) + (size_t)s * 768;
    const u16* mk = (const u16*)(ws + OFF_MKV) + (size_t)s * 512;
    float kr1, kr2;
    {
      const u16* kr = (const u16*)(ws + OFF_P) + (size_t)s * NINP + O_KR;
      float t1 = lane < 32 ? bf2f(kr[fi]) : 0.f, t2 = lane < 32 ? bf2f(kr[32 + fi]) : 0.f;
      float ss = wave_sum(t1 * t1 + t2 * t2);
      float rs = rsqrtf(ss * (1.f / 64) + 1e-6f);
      t1 *= rs * rg[64 + fi];
      t2 *= rs * rg[64 + 32 + fi];
      kr1 = t1 * cs - t2 * sn;
      kr2 = t2 * cs + t1 * sn;
    }
#pragma unroll
    for (int h = 0; h < 4; ++h) {
      u16* qd = (u16*)(ws + OFF_QM) + ((size_t)h * S_ + s) * 192;
      u16* kd = (u16*)(ws + OFF_KM) + ((size_t)h * S_ + s) * 192;
      {
        const unsigned ab = *(const unsigned*)(mq + h * 192 + 2 * lane);
        float a = lo2f(ab), b = hi2f(ab);
        float ss = wave_sum(a * a + b * b);
        float rs = rsqrtf(ss * (1.f / 128) + 1e-6f) * qscale;
        const float2 gq = *(const float2*)(ng + 2 * lane);
        *(unsigned*)(qd + 2 * lane) = pack2(a * rs * gq.x, b * rs * gq.y);
      }
      {
        float t1 = lane < 32 ? bf2f(mq[h * 192 + 128 + fi]) : 0.f, t2 = lane < 32 ? bf2f(mq[h * 192 + 160 + fi]) : 0.f;
        float ss = wave_sum(t1 * t1 + t2 * t2);
        float rs = rsqrtf(ss * (1.f / 64) + 1e-6f);
        t1 *= rs * rg[fi];
        t2 *= rs * rg[32 + fi];
        if (lane < 32) {
          qd[128 + fi] = f2bf((t1 * cs - t2 * sn) * qscale);
          qd[160 + fi] = f2bf((t2 * cs + t1 * sn) * qscale);
        }
      }
      {
        const unsigned ab = *(const unsigned*)(mk + h * 128 + 2 * lane);
        float a = lo2f(ab), b = hi2f(ab);
        float ss = wave_sum(a * a + b * b);
        float rs = rsqrtf(ss * (1.f / 128) + 1e-6f);
        const float2 gk = *(const float2*)(ng + 128 + 2 * lane);
        *(unsigned*)(kd + 2 * lane) = pack2(a * rs * gk.x, b * rs * gk.y);
        if (lane < 32) {
          kd[128 + fi] = f2bf(kr1);
          kd[160 + fi] = f2bf(kr2);
        }
      }
    }
  }
}

template <int DQK, int NSUB>
__device__ __forceinline__ void attn_item(const u16* __restrict__ Q, int ldq, const u16* __restrict__ K, int ldk, const u16* __restrict__ Vt,
                          int ldv, int Skv, u16* __restrict__ O, int qb, bool hasBias, const float* __restrict__ relb, int head,
                          const int* __restrict__ pos, const int* __restrict__ kpmm, char* smem, const int* __restrict__ kposp,
                          float* __restrict__ ML) {
  constexpr int LDK = DQK;
  constexpr int SW = (DQK == 128) ? 15 : 7;
  constexpr int NKS = DQK / 32;
  constexpr int NKC = DQK / 32;
  u16* Ks = (u16*)smem;
  u16* Vs = (u16*)(smem + 25600);
  float* bt = (float*)(smem + 44032);
  int* kp = (int*)(smem + 45072);
  const int tid = ltid(), lane = tid & 63, w = tid >> 6, l15 = lane & 15, quad = lane >> 4;
  const int q0 = qb * (64 * NSUB) + w * (16 * NSUB);

  bf16x8 qf[NSUB][NKS];
#pragma unroll
  for (int sub = 0; sub < NSUB; ++sub)
#pragma unroll
    for (int ks = 0; ks < NKS; ++ks)
      qf[sub][ks] = *(const bf16x8*)(Q + (size_t)(q0 + sub * 16 + l15) * ldq + ks * 32 + quad * 8);

  int qp[2] = {0, 0};
  int qpmin = 0, qpmax = 0;
  if (hasBias) {
    qp[0] = pos[q0 + l15];
    qp[1] = pos[q0 + (NSUB - 1) * 16 + l15];
    qpmin = min(qp[0], qp[1]);
    qpmax = max(qp[0], qp[1]);
#pragma unroll
    for (int o = 8; o >= 1; o >>= 1) {
      qpmin = min(qpmin, __shfl_xor(qpmin, o));
      qpmax = max(qpmax, __shfl_xor(qpmax, o));
    }
  }
  __syncthreads();
  if (hasBias) {
    for (int i = tid; i < 257; i += 256) bt[i] = relb[t5_bucket(i - 128) * 4 + head] * LOG2E;
  }
  u32x4 kreg[NKC], vreg[4];
#pragma unroll
  for (int i = 0; i < NKC; ++i) {
    int c = tid + i * 256, r = c / (DQK / 8), kc = c % (DQK / 8);
    kreg[i] = *(const u32x4*)(K + (size_t)r * ldk + kc * 8);
  }
#pragma unroll
  for (int i = 0; i < 4; ++i) {
    int c = tid + i * 256, r = c >> 3, kc = c & 7;
    vreg[i] = *(const u32x4*)(Vt + (size_t)r * ldv + kc * 8);
  }
#pragma unroll
  for (int i = 0; i < NKC; ++i) {
    int c = tid + i * 256, r = c / (DQK / 8), kc = c % (DQK / 8);
    *(u32x4*)(Ks + r * LDK + ((kc ^ (r & SW)) * 8)) = kreg[i];
  }
#pragma unroll
  for (int i = 0; i < 4; ++i) {
    int c = tid + i * 256, r = c >> 3, kc = c & 7;
    *(u32x4*)(Vs + r * 72 + kc * 8) = vreg[i];
  }
  if (hasBias && tid < 64) kp[tid] = kposp[tid];
  __syncthreads();

  f32x4 oacc[8][NSUB];
#pragma unroll
  for (int et = 0; et < 8; ++et)
#pragma unroll
    for (int sub = 0; sub < NSUB; ++sub) oacc[et][sub] = (f32x4){0.f, 0.f, 0.f, 0.f};
  float mrow[2] = {-1e30f, -1e30f}, lrow[2] = {0.f, 0.f};

  const int ntiles = Skv / 64;
  constexpr bool KDMA = (DQK == 192);
  int koff[6];
#pragma unroll
  for (int i = 0; i < 6; ++i) {
    const int o = (w + 4 * i) * 1024 + lane * 16;
    const int r = o / (DQK * 2), pos = (o % (DQK * 2)) >> 4;
    koff[i] = r * ldk + ((pos ^ (r & SW)) * 8);
  }
  for (int t = 0; t < ntiles; ++t) {
    const bool more = (t + 1 < ntiles);
    const int k1 = (t + 1) * 64;
    constexpr bool EARLY = (DQK != 128);
    if (EARLY && more) {
      if (!KDMA) {
#pragma unroll
        for (int i = 0; i < NKC; ++i) {
          int c = tid + i * 256, r = c / (DQK / 8), kc = c % (DQK / 8);
          kreg[i] = *(const u32x4*)(K + (size_t)(k1 + r) * ldk + kc * 8);
        }
      }
#pragma unroll
      for (int i = 0; i < 4; ++i) {
        int c = tid + i * 256, r = c >> 3, kc = c & 7;
        vreg[i] = *(const u32x4*)(Vt + (size_t)r * ldv + k1 + kc * 8);
      }
    }
    f32x4 sacc[4][NSUB];
#pragma unroll
    for (int kt = 0; kt < 4; ++kt)
#pragma unroll
      for (int sub = 0; sub < NSUB; ++sub) sacc[kt][sub] = (f32x4){0.f, 0.f, 0.f, 0.f};
    __builtin_amdgcn_s_setprio(1);
#pragma unroll
    for (int ks = 0; ks < NKS; ++ks) {
#pragma unroll
      for (int kt = 0; kt < 4; ++kt) {
        bf16x8 kf = *(const bf16x8*)(Ks + (kt * 16 + l15) * LDK + (((ks * 4 + quad) ^ (l15 & SW)) * 8));
#pragma unroll
        for (int sub = 0; sub < NSUB; ++sub)
          sacc[kt][sub] = __builtin_amdgcn_mfma_f32_16x16x32_bf16(kf, qf[sub][ks], sacc[kt][sub], 0, 0, 0);
      }
      __builtin_amdgcn_sched_barrier(0);
    }
    __builtin_amdgcn_s_setprio(0);
    float cb = 0.f;
    if (hasBias) {
      int kmn = kpmm[t * 2], kmx = kpmm[t * 2 + 1];
      if (kmn - qpmax >= 128 || kmx - qpmin <= -128) {
        cb = (kmn - qpmax >= 128) ? bt[256] : bt[0];
      } else {
#pragma unroll
        for (int kt = 0; kt < 4; ++kt) {
#pragma unroll
          for (int j = 0; j < 4; ++j) {
            int kpos = kp[kt * 16 + quad * 4 + j];
#pragma unroll
            for (int sub = 0; sub < NSUB; ++sub) {
              int rel = kpos - qp[sub];
              rel = max(-128, min(128, rel));
              sacc[kt][sub][j] += bt[rel + 128];
            }
          }
        }
      }
    }
    LBAR();
    if (more) {
      if (!EARLY) {
#pragma unroll
        for (int i = 0; i < NKC; ++i) {
          int c = tid + i * 256, r = c / (DQK / 8), kc = c % (DQK / 8);
          kreg[i] = *(const u32x4*)(K + (size_t)(k1 + r) * ldk + kc * 8);
        }
#pragma unroll
        for (int i = 0; i < 4; ++i) {
          int c = tid + i * 256, r = c >> 3, kc = c & 7;
          vreg[i] = *(const u32x4*)(Vt + (size_t)r * ldv + k1 + kc * 8);
        }
      }
      if (hasBias && tid < 64) kp[tid] = kposp[k1 + tid];
      if (KDMA) {
#pragma unroll
        for (int i = 0; i < 6; ++i)
          __builtin_amdgcn_global_load_lds((const unsigned*)(K + (size_t)k1 * ldk + koff[i]),
                                           (unsigned*)((char*)Ks + (w + 4 * i) * 1024), 16, 0, 0);
      }
    }
    __builtin_amdgcn_sched_barrier(0);
    bf16x8 pf[NSUB][2];
#pragma unroll
    for (int sub = 0; sub < NSUB; ++sub) {
      float mx = -1e30f;
#pragma unroll
      for (int kt = 0; kt < 4; ++kt)
#pragma unroll
        for (int j = 0; j < 4; ++j) mx = fmaxf(mx, sacc[kt][sub][j]);
      mx = fmaxf(mx, __shfl_xor(mx, 16));
      mx = fmaxf(mx, __shfl_xor(mx, 32));
      float mnew = fmaxf(mrow[sub], mx + cb);
      float alpha = __builtin_amdgcn_exp2f(mrow[sub] - mnew);
      mrow[sub] = mnew;
      const float off = cb - mnew;
      float ps = 0.f;
      float pv[4][4];
#pragma unroll
      for (int kt = 0; kt < 4; ++kt)
#pragma unroll
        for (int j = 0; j < 4; ++j) {
          pv[kt][j] = __builtin_amdgcn_exp2f(sacc[kt][sub][j] + off);
          ps += pv[kt][j];
        }
      lrow[sub] = lrow[sub] * alpha + ps;
#pragma unroll
      for (int kb = 0; kb < 2; ++kb) {
        u32x4 pu = {pack2(pv[2 * kb][0], pv[2 * kb][1]), pack2(pv[2 * kb][2], pv[2 * kb][3]),
                    pack2(pv[2 * kb + 1][0], pv[2 * kb + 1][1]), pack2(pv[2 * kb + 1][2], pv[2 * kb + 1][3])};
        pf[sub][kb] = __builtin_bit_cast(bf16x8, pu);
      }
      if (__builtin_amdgcn_ballot_w64(alpha != 1.f) != 0) {
#pragma unroll
        for (int et = 0; et < 8; ++et) {
          oacc[et][sub][0] *= alpha; oacc[et][sub][1] *= alpha;
          oacc[et][sub][2] *= alpha; oacc[et][sub][3] *= alpha;
        }
      }
    }
    __builtin_amdgcn_s_setprio(1);
#pragma unroll
    for (int et = 0; et < 8; ++et) {
#pragma unroll
      for (int kb = 0; kb < 2; ++kb) {
        const u16* vp = Vs + (et * 16 + l15) * 72 + kb * 32 + quad * 4;
        u32x2 a0 = *(const u32x2*)vp;
        u32x2 a1 = *(const u32x2*)(vp + 16);
        u32x4 cu = {a0.x, a0.y, a1.x, a1.y};
        bf16x8 vb = __builtin_bit_cast(bf16x8, cu);
#pragma unroll
        for (int sub = 0; sub < NSUB; ++sub)
          oacc[et][sub] = __builtin_amdgcn_mfma_f32_16x16x32_bf16(vb, pf[sub][kb], oacc[et][sub], 0, 0, 0);
      }
      if (et & 1) __builtin_amdgcn_sched_barrier(0);
    }
    __builtin_amdgcn_s_setprio(0);
    if (more) {
      if (KDMA) {
        asm volatile("s_waitcnt vmcnt(0)" ::: "memory");
      } else {
#pragma unroll
        for (int i = 0; i < NKC; ++i) {
          int c = tid + i * 256, r = c / (DQK / 8), kc = c % (DQK / 8);
          *(u32x4*)(Ks + r * LDK + ((kc ^ (r & SW)) * 8)) = kreg[i];
        }
      }
    }
    LBAR();
    if (more) {
#pragma unroll
      for (int i = 0; i < 4; ++i) {
        int c = tid + i * 256, r = c >> 3, kc = c & 7;
        *(u32x4*)(Vs + r * 72 + kc * 8) = vreg[i];
      }
    }
  }
#pragma unroll
  for (int sub = 0; sub < NSUB; ++sub) {
    float lt = lrow[sub];
    lt += __shfl_xor(lt, 16);
    lt += __shfl_xor(lt, 32);
    float inv = 1.f / lt;
    if (ML) {
      inv = 1.f;
      if (quad == 0) *(float2*)(ML + (size_t)(q0 + sub * 16 + l15) * 2) = make_float2(mrow[sub], lt);
    }
    u16* orow = O + (size_t)(q0 + sub * 16 + l15) * 128;
#pragma unroll
    for (int et = 0; et < 8; ++et) {
      uint2 o;
      o.x = pack2(oacc[et][sub][0] * inv, oacc[et][sub][1] * inv);
      o.y = pack2(oacc[et][sub][2] * inv, oacc[et][sub][3] * inv);
      *(uint2*)(orow + et * 16 + quad * 4) = o;
    }
  }
}

#define QB2 (128 / ATT_NSUB)
#define SC_CH 16
#define SC_STEPF 336
typedef float f32x2 __attribute__((ext_vector_type(2)));
struct ScStep { f32x2 kk0, kk1, w0, w1, b0, b1, k0, k1, r0, r1; float v; };
__device__ __forceinline__ ScStep sc_ld(const float* sb, int jg4, int vi) {
  ScStep x;
  f32x4 t;
  t = *(const f32x4*)(sb + jg4);       x.kk0 = t.xy; x.kk1 = t.zw;
  t = *(const f32x4*)(sb + 64 + jg4);  x.w0 = t.xy;  x.w1 = t.zw;
  t = *(const f32x4*)(sb + 128 + jg4); x.b0 = t.xy;  x.b1 = t.zw;
  t = *(const f32x4*)(sb + 192 + jg4); x.k0 = t.xy;  x.k1 = t.zw;
  t = *(const f32x4*)(sb + 256 + jg4); x.r0 = t.xy;  x.r1 = t.zw;
  x.v = sb[320 + vi];
  return x;
}
__device__ __forceinline__ void scan_unit(const Params p, int u, char* smem) {
  char* ws = p.ws;
  const int tid = ltid(), lane = tid & 63, w = tid >> 6;
  const int chain = u >> 2, rg = u & 3, n = chain >> 3, h = chain & 7;
  const int jg = lane & 15, rw = lane >> 4;
  float* buf = (float*)smem;
  const float* a0 = (const float*)(ws + OFF_SCKK) + h * 64;
  const float* a1 = (const float*)(ws + OFF_SCW) + (size_t)n * S_ * 512 + h * 64;
  const float* a2 = (const float*)(ws + OFF_SCB) + (size_t)n * S_ * 512 + h * 64;
  const float* a3 = (const float*)(ws + OFF_SCKD) + (size_t)n * S_ * 512 + h * 64;
  const float* a4 = (const float*)(ws + OFF_SCR) + h * 64;
  const float* vsrc = (const float*)(ws + OFF_SCV) + h * 64 + rg * 16;
  float* ydst = (float*)(ws + OFF_YS) + (size_t)n * S_ * 512 + h * 64 + rg * 16 + w * 4 + rw;

  const float* pb[6];
  int pst[6], pf[6];
#pragma unroll
  for (int i = 0; i < 6; ++i) {
    int f = min(tid + i * 256, SC_CH * 84 - 1);
    int st = f / 84, q = f % 84;
    int a = q >> 4;
    const float* base = a == 0 ? a0 : a == 1 ? a1 : a == 2 ? a2 : a == 3 ? a3 : a == 4 ? a4 : vsrc;
    pb[i] = base + (a < 5 ? (q & 15) * 4 : (q - 80) * 4);
    pst[i] = st;
    pf[i] = f * 4;
  }
  const int sdir = n ? -1 : 1, sbase = n ? (S_ - 1) : 0;
  const int nch = S_ / SC_CH;
  unsigned po[6];
#pragma unroll
  for (int i = 0; i < 6; ++i)
    po[i] = (unsigned)((const char*)(pb[i] + (size_t)(sbase + sdir * pst[i]) * 512) - (const char*)ws);
  const unsigned yo = (unsigned)((const char*)(ydst + (size_t)(sbase + sdir * jg) * 512) - (const char*)ws);
  const int cstep = sdir * SC_CH * 512 * 4;
  f32x4 lregA[6], lregB[6];
#define SC_LOAD(R, CH)                                                            \
  {                                                                               \
    const unsigned d_ = (unsigned)(min((CH), nch - 1) * cstep);                   \
    _Pragma("unroll") for (int i = 0; i < 6; ++i)                                 \
      R[i] = *(const f32x4*)((const char*)ws + (unsigned)(po[i] + d_));           \
  }
#define SC_STORE(R, B)                                                \
  _Pragma("unroll") for (int i = 0; i < 6; ++i) *(f32x4*)(buf + (B) * SC_CH * SC_STEPF + pf[i]) = R[i];

  f32x2 sA = {0.f, 0.f}, sB = {0.f, 0.f};
  const int jg4 = jg * 4, vi = w * 4 + rw;
#define SC_COMPUTE(C, B)                                                              \
  {                                                                                   \
    const float* cb = buf + (B) * SC_CH * SC_STEPF;                                   \
    float ykeep = 0.f;                                                                \
    ScStep cur = sc_ld(cb, jg4, vi);                                                  \
    ScStep nx1 = sc_ld(cb + SC_STEPF, jg4, vi);                                       \
    _Pragma("unroll") for (int st = 0; st < SC_CH; ++st) {                            \
      ScStep nx2 = nx1;                                                               \
      if (st + 2 < SC_CH) nx2 = sc_ld(cb + (st + 2) * SC_STEPF, jg4, vi);             \
      f32x2 sa2 = sA * cur.kk0 + sB * cur.kk1;                                        \
      f32x2 vv = {cur.v, cur.v};                                                      \
      f32x2 uA = sA * cur.w0 + vv * cur.k0;                                           \
      f32x2 uB = sB * cur.w1 + vv * cur.k1;                                           \
      float sa = row16_sum(sa2.x + sa2.y);                                            \
      f32x2 nsa = {-sa, -sa};                                                         \
      sA = uA + nsa * cur.b0;                                                         \
      sB = uB + nsa * cur.b1;                                                         \
      f32x2 y2 = sA * cur.r0 + sB * cur.r1;                                           \
      float y = row16_sum(y2.x + y2.y);                                               \
      ykeep = (jg == st) ? y : ykeep;                                                 \
      cur = nx1;                                                                      \
      nx1 = nx2;                                                                      \
    }                                                                                 \
    *(float*)((char*)ws + (unsigned)(yo + (unsigned)((C) * cstep))) = ykeep;          \
  }

  __syncthreads();
  __builtin_amdgcn_s_setprio(3);
  SC_LOAD(lregA, 0);
  SC_STORE(lregA, 0);
  SC_LOAD(lregB, 1);
  __syncthreads();
  for (int c = 0; c < nch; c += 2) {
    SC_LOAD(lregA, c + 2);
    SC_COMPUTE(c, 0);
    SC_STORE(lregB, 1);
    LBAR();
    SC_LOAD(lregB, c + 3);
    SC_COMPUTE(c + 1, 1);
    SC_STORE(lregA, 0);
    LBAR();
  }
  __builtin_amdgcn_s_setprio(0);
}

template <int ATM>
__device__ __forceinline__ void phase_attn_scan(const Params p, int l, char* smem) {
  char* ws = p.ws;
  __shared__ int s_item;
  if (ATM & 8) for (int u = lbid(); u < 64; u += gridDim.x) scan_unit(p, u, smem);
  if ((ATM & 8) && (DUP_MASK & 2)) for (int u = lbid(); u < 64; u += gridDim.x) scan_unit(p, u, smem);
  int* cnt = (int*)(ws + OFF_CNT) + l * 4;
  const int* pos = (const int*)p.in[I_POS];
  const int* kpmm = (const int*)(ws + OFF_KPMM);
  const u16* P = (const u16*)(ws + OFF_P);
  u16* OB = (u16*)(ws + OFF_OB);
#define NEXT_ITEM(CI, LIMIT)                                   \
    __syncthreads();                                           \
    if (ltid() == 0) s_item = atomicAdd(cnt + (CI), 1);   \
    __syncthreads();                                           \
    const int it = s_item;                                     \
    if (it >= (LIMIT)) break;
  u16* OB2 = (u16*)(ws + OFF_OB2);
  float* MLb = (float*)(ws + OFF_ML);
  const int flip = (blockIdx.x >> 8) & 1;
  for (int pass = 0; pass < 2; ++pass) {
  const int which = pass ^ flip;
  if (which == 0) {
  if (ATM & 1) while (true) {
    NEXT_ITEM(0, 512)
    int hh = it >> 6, qb = it & 63, h = hh >> 1, half = hh & 1;
    const int kv0 = half * (S_ / 2);
    attn_item<192, 2>((const u16*)(ws + OFF_QM) + (size_t)h * S_ * 192, 192,
                      (const u16*)(ws + OFF_KM) + ((size_t)h * S_ + kv0) * 192, 192,
                      (const u16*)(ws + OFF_VTM) + (size_t)h * 128 * S_ + kv0, S_, S_ / 2,
                      (half ? OB2 : OB) + (size_t)(8 + h) * S_ * 128, qb, false, nullptr, 0, pos, kpmm, smem, pos,
                      MLb + ((size_t)half * 16 + 8 + h) * S_ * 2);
  }
  } else {
  if (ATM & 2) while (true) {
    NEXT_ITEM(1, 16 * QB2)
    int pp = it / QB2, qb = it % QB2, pr = pp >> 1, half = pp & 1, h = pr >> 1, hf = pr & 1;
    const int kv0 = half * (S_ / 2);
    attn_item<64, ATT_NSUB>(P + O_DQ + h * 128 + hf * 64, NINP, P + (size_t)kv0 * NINP + O_DK + h * 128 + hf * 64, NINP,
                            (const u16*)(ws + OFF_VTD) + (size_t)h * 128 * S_ + kv0, S_, S_ / 2,
                            (half ? OB2 : OB) + (size_t)pr * S_ * 128, qb, true, (const float*)p.in[I_RELB], h, pos,
                            kpmm + (kv0 / 64) * 2, smem, pos + kv0, MLb + ((size_t)half * 16 + pr) * S_ * 2);
  }
  }
  }
  if (ATM & 4) while (true) {
    NEXT_ITEM(2, 4 * QB2)
    int h = it / QB2, qb = it % QB2;
    attn_item<128, ATT_NSUB>(P + O_MQ + h * 128, NINP, (const u16*)(ws + OFF_KMEM) + (size_t)(l * 4 + h) * 256 * 128, 128,
                             (const u16*)(ws + OFF_VTMEM) + (size_t)(l * 4 + h) * 128 * 256, 256, 256,
                             OB + (size_t)(12 + h) * S_ * 128, qb, false, nullptr, 0, pos, kpmm, smem, pos, nullptr);
  }
}

__device__ __forceinline__ void phase_combine(const Params p, int l, char* smem) {
  char* ws = p.ws;
  const int lane = ltid() & 63, w = ltid() >> 6;
  const float lam_init = 0.8f - 0.6f * expf(-0.3f * (float)l);
  float lam;
  {
    const float* lq = (const float*)p.in[I_DLAM] + l * 256;
    float a = wave_sum(lq[lane] * lq[64 + lane]);
    float b = wave_sum(lq[128 + lane] * lq[192 + lane]);
    lam = expf(a) - expf(b) + lam_init;
  }
  const float* gng = (const float*)p.in[I_GNG] + l * 512;
  const float* gnb = (const float*)p.in[I_GNB] + l * 512;
  const float* subg = (const float*)p.in[I_DSUBG] + l * 128;
  const u16* P = (const u16*)(ws + OFF_P);
  const float* YS = (const float*)(ws + OFF_YS);
  const u16* OB = (const u16*)(ws + OFF_OB);
  const u16* OB2c = (const u16*)(ws + OFF_OB2);
  const float* MLp = (const float*)(ws + OFF_ML);
  u16* YG = (u16*)(ws + OFF_YG);
  for (int s = lbid() * 4 + w; s < S_; s += gridDim.x * 4) {
    const u16* grow = P + (size_t)s * NINP + O_G;
#pragma unroll
    for (int hp = 0; hp < 4; ++hp) {
      const int c = hp * 128 + 2 * lane, h = hp * 2 + (lane >> 5);
      const float2 ya = *(const float2*)(YS + (size_t)s * 512 + c);
      const float2 yb = *(const float2*)(YS + ((size_t)S_ + s) * 512 + c);
      float y0 = ya.x + yb.x, y1 = ya.y + yb.y;
      float sm = y0 + y1;
#pragma unroll
      for (int o = 16; o >= 1; o >>= 1) sm += __shfl_xor(sm, o);
      const float mu = sm * (1.f / 64);
      const float d0 = y0 - mu, d1 = y1 - mu;
      float vs = d0 * d0 + d1 * d1;
#pragma unroll
      for (int o = 16; o >= 1; o >>= 1) vs += __shfl_xor(vs, o);
      const float rstd = rsqrtf(vs * (1.f / 64) + 64e-5f);
      const float2 gg = *(const float2*)(gng + c), gb = *(const float2*)(gnb + c);
      const float bon = ((const float*)(ws + OFF_BONUS))[s * 8 + h];
      const float2 vv = *(const float2*)((const float*)(ws + OFF_SCV) + (size_t)s * 512 + c);
      float o0 = d0 * rstd * gg.x + gb.x + bon * vv.x;
      float o1 = d1 * rstd * gg.y + gb.y + bon * vv.y;
      const unsigned gt = *(const unsigned*)(grow + c);
      const float g0 = lo2f(gt), g1 = hi2f(gt);
      *(unsigned*)(YG + (size_t)s * 512 + c) = pack2(o0 * g0 * sigmoidf_(g0), o1 * g1 * sigmoidf_(g1));
    }
#define MERGE_LOAD(PR, A, B)                                                                   \
    {                                                                                          \
      const float2 ml0 = *(const float2*)(MLp + ((size_t)(PR) * S_ + s) * 2);                  \
      const float2 ml1 = *(const float2*)(MLp + ((size_t)(16 + (PR)) * S_ + s) * 2);           \
      const float mm = fmaxf(ml0.x, ml1.x);                                                    \
      const float w0 = __builtin_amdgcn_exp2f(ml0.x - mm), w1 = __builtin_amdgcn_exp2f(ml1.x - mm); \
      const float inv = 1.f / (w0 * ml0.y + w1 * ml1.y);                                       \
      const unsigned q0 = *(const unsigned*)(OB + ((size_t)(PR) * S_ + s) * 128 + 2 * lane);   \
      const unsigned q1 = *(const unsigned*)(OB2c + ((size_t)(PR) * S_ + s) * 128 + 2 * lane); \
      A = (w0 * lo2f(q0) + w1 * lo2f(q1)) * inv;                                               \
      B = (w0 * hi2f(q0) + w1 * hi2f(q1)) * inv;                                               \
    }
#pragma unroll
    for (int h = 0; h < 4; ++h) {
      float a1, b1, a2, b2;
      MERGE_LOAD(h * 2, a1, b1)
      MERGE_LOAD(h * 2 + 1, a2, b2)
      float a = a1 - lam * a2, b = b1 - lam * b2;
      float ss = wave_sum(a * a + b * b);
      float rs = rsqrtf(ss * (1.f / 128) + 1e-6f) * (1.f - lam_init);
      const unsigned gg = *(const unsigned*)(grow + 512 + h * 128 + 2 * lane);
      float g0 = lo2f(gg), g1 = hi2f(gg);
      const float2 sg = *(const float2*)(subg + 2 * lane);
      u16* dst = YG + ((size_t)S_ + s) * 512 + h * 128;
      *(unsigned*)(dst + 2 * lane) = pack2(a * rs * sg.x * g0 * sigmoidf_(g0), b * rs * sg.y * g1 * sigmoidf_(g1));
    }
#pragma unroll
    for (int br = 2; br < 4; ++br) {
#pragma unroll
      for (int h = 0; h < 4; ++h) {
        float oa, ob;
        if (br == 2) {
          MERGE_LOAD(8 + h, oa, ob)
        } else {
          const unsigned o = *(const unsigned*)(OB + ((size_t)(12 + h) * S_ + s) * 128 + 2 * lane);
          oa = lo2f(o);
          ob = hi2f(o);
        }
        const unsigned gg = *(const unsigned*)(grow + br * 512 + h * 128 + 2 * lane);
        float g0 = lo2f(gg), g1 = hi2f(gg);
        u16* dst = YG + ((size_t)br * S_ + s) * 512 + h * 128;
        *(unsigned*)(dst + 2 * lane) = pack2(oa * g0 * sigmoidf_(g0), ob * g1 * sigmoidf_(g1));
      }
    }
#undef MERGE_LOAD
  }
}

#define XB_TMO      128
#define XB_XCNT(j)  (256  + 64 * (j))
#define XB_XSUB(j)  (1280 + 64 * (j))
#define XB_XGEN(j)  (2304 + 64 * (j))
#define XB_TOP      3328
#define XB_TOPGEN   3392
#define XCD_BAR_WORDS 3456
#define XB_SPIN_CAP (1u << 22)
#define LAS __attribute__((address_space(3)))
__device__ __forceinline__ unsigned xb_ld(unsigned* p)              { return __hip_atomic_load(p, __ATOMIC_RELAXED, __HIP_MEMORY_SCOPE_AGENT); }
__device__ __forceinline__ unsigned xb_add(unsigned* p, unsigned v) { return __hip_atomic_fetch_add(p, v, __ATOMIC_RELAXED, __HIP_MEMORY_SCOPE_AGENT); }
__device__ __forceinline__ unsigned xb_xcc_id() { return (unsigned)__builtin_amdgcn_s_getreg((3 << 11) | 20) & 0xFu; }
#define XB_SPIN(cond, bar) do { unsigned _sp = 0; while (cond) { __builtin_amdgcn_s_sleep(1); \
    if ((++_sp & 255u) == 0u) { if (xb_ld(&(bar)[XB_TMO])) break; if (_sp > XB_SPIN_CAP) { atomicAdd(&(bar)[XB_TMO], 1u); break; } } } } while (0)
struct XcdBarrier { unsigned* bar; unsigned x; volatile LAS unsigned* st; };
__device__ __forceinline__ XcdBarrier xcd_barrier_post(unsigned* bar, volatile LAS unsigned* st) {
  XcdBarrier b; b.bar = bar; b.x = xb_xcc_id(); b.st = st;
  if (threadIdx.x == 0) (void)xb_add(&bar[XB_XCNT(b.x)], 1u);
  return b;
}
__device__ __forceinline__ void xcd_barrier_complete(unsigned* bar, unsigned x, unsigned& nloc, unsigned& nx) {
  const unsigned G = gridDim.x * gridDim.y * gridDim.z;
  unsigned sum, cnt, mine, sp = 0u;
  for (;;) {
    sum = 0u; cnt = 0u; mine = 0u;
#pragma unroll
    for (unsigned j = 0; j < 16; ++j) { const unsigned c = xb_ld(&bar[XB_XCNT(j)]); sum += c; cnt += (c > 0u) ? 1u : 0u; mine = (j == x) ? c : mine; }
    if (sum == G) break;
    __builtin_amdgcn_s_sleep(1);
    if ((++sp & 255u) == 0u) { if (xb_ld(&bar[XB_TMO])) break; if (sp > XB_SPIN_CAP) { atomicAdd(&bar[XB_TMO], 1u); break; } }
  }
  nloc = mine > 0u ? mine : 1u; nx = cnt > 0u ? cnt : 1u;
}
__device__ __forceinline__ void xcd_barrier(const XcdBarrier& b) {
  asm volatile("s_waitcnt vmcnt(0)" ::: "memory");
  __syncthreads();
  if (threadIdx.x == 0) {
    unsigned* bar = b.bar;
    __builtin_amdgcn_s_waitcnt(0);
    unsigned nloc = b.st[0], nx = b.st[1];
    if (nloc == 0u) { xcd_barrier_complete(bar, b.x, nloc, nx); b.st[0] = nloc; b.st[1] = nx; }
    const unsigned old = xb_add(&bar[XB_XSUB(b.x)], 1u);
    const unsigned gen = old / nloc;
    if (old + 1u == (gen + 1u) * nloc) {
      __builtin_amdgcn_fence(__ATOMIC_RELEASE, "agent");
      asm volatile("s_waitcnt vmcnt(0)" ::: "memory");
      const unsigned og = xb_add(&bar[XB_TOP], 1u);
      const unsigned tg = og / nx;
      if (og + 1u == (tg + 1u) * nx) xb_add(&bar[XB_TOPGEN], 1u);
      else XB_SPIN(xb_ld(&bar[XB_TOPGEN]) == tg, bar);
      __builtin_amdgcn_fence(__ATOMIC_ACQUIRE, "agent");
      xb_add(&bar[XB_XGEN(b.x)], 1u);
      asm volatile("s_waitcnt vmcnt(0)" ::: "memory");
    } else {
      XB_SPIN(xb_ld(&bar[XB_XGEN(b.x)]) == gen, bar);
      __builtin_amdgcn_fence(__ATOMIC_ACQUIRE, "agent");
      asm volatile("s_waitcnt vmcnt(0)" ::: "memory");
    }
  }
  __syncthreads();
}

#define N_PHASES (1 + 9 * L_)

__global__ void __launch_bounds__(256, 2) mega(Params p, int ph_lo, int ph_hi) {
  __shared__ __attribute__((aligned(16))) char smem[SMEM_BYTES];
  cg::grid_group grid = cg::this_grid();
  __shared__ uint4 xb_words;
  if (threadIdx.x == 0) xb_words = make_uint4(0u, 0u, 0u, 0u);
  __syncthreads();
  XcdBarrier xb = xcd_barrier_post((unsigned*)(p.ws + OFF_BAR), (volatile LAS unsigned*)&xb_words);
  __shared__ int s_vbid, s_cand;
  if (threadIdx.x == 0) {
    int my_j = (int)xb_add((unsigned*)(p.ws + OFF_BAR) + 8 * xb.x, 1u);
    s_cand = my_j * 8 + (int)xb.x;
    s_vbid = blockIdx.x;
  }
#define VB s_vbid
  for (int ph = ph_lo; ph < ph_hi; ++ph) {
    if (ph == 0) {
      if (PH_MASK & 1) phase_w(p, smem);
    } else {
      int l = (ph - 1) / 9, sp = (ph - 1) % 9;
      switch (sp) {
        case 0: if (PH_MASK & 2) phase_gemm_in(p, l, smem, VB);
          if (DUP_MASK & 1) { __syncthreads(); phase_gemm_in(p, l, smem, VB); }
          break;
        case 1: if (PH_MASK & 4) phase_prep<false>(p, l, smem);
          if (DUP_MASK & 256) { __syncthreads(); phase_prep<true>(p, l, smem); }
          break;
        case 2: if (PH_MASK & 8) phase_gemm_mla(p, l, smem, VB);
          if (DUP_MASK & 16) { __syncthreads(); phase_gemm_mla(p, l, smem, VB); }
          break;
        case 3: if (PH_MASK & 16) phase_mla_post(p, l, smem);
          if (DUP_MASK & 32) { __syncthreads(); phase_mla_post(p, l, smem); }
          break;
        case 4: if (PH_MASK & 32) phase_attn_scan<AT_MASK>(p, l, smem); break;
        case 5: if (PH_MASK & 64) phase_combine(p, l, smem);
          if (DUP_MASK & 64) { __syncthreads(); phase_combine(p, l, smem); }
          break;
        case 6: if (PH_MASK & 128) phase_gemm_branch(p, l, smem, VB);
          if (DUP_MASK & 4) { __syncthreads(); phase_gemm_branch(p, l, smem, VB); }
          break;
        case 7: if (PH_MASK & 256) phase_gemm_out(p, l, smem, VB); break;
        case 8:
          if (l + 1 < L_) rms_rows<true>((const float*)p.out, S_, (const float*)p.in[I_NORMG] + (l + 1) * D_, (u16*)(p.ws + OFF_H));
          if ((DUP_MASK & 128) && l + 1 < L_) rms_rows<true>((const float*)p.out, S_, (const float*)p.in[I_NORMG] + (l + 1) * D_, (u16*)(p.ws + OFF_H));
          break;
      }
    }
#undef VB
    if (ph + 1 < ph_hi) {
      if (ph == ph_lo) {
        if (ph_hi < 0) grid.sync();
        xcd_barrier(xb);
        if (threadIdx.x == 0 && gridDim.x == 512) {
          bool ok = true;
          for (int j = 0; j < 8; ++j) ok = ok && (xb_ld((unsigned*)(p.ws + OFF_BAR) + 8 * j) == 64u);
          if (ok && xb.x < 8u) s_vbid = s_cand;
        }
        __syncthreads();
      } else xcd_barrier(xb);
    }
  }
}

template <int SP, int ATM>
__global__ void __launch_bounds__(256, 2) k_phase(Params p, int l) {
  __shared__ __attribute__((aligned(16))) char smem[SMEM_BYTES];
  const int VB = blockIdx.x;
  if (SP == -1) phase_w(p, smem);
  if (SP == 0) phase_gemm_in(p, l, smem, VB);
  if (SP == 1) phase_prep<false>(p, l, smem);
  if (SP == 2) phase_gemm_mla(p, l, smem, VB);
  if (SP == 3) phase_mla_post(p, l, smem);
  if (SP == 4) phase_attn_scan<ATM>(p, l, smem);
  if (SP == 5) phase_combine(p, l, smem);
  if (SP == 6) phase_gemm_branch(p, l, smem, VB);
  if (SP == 7) phase_gemm_out(p, l, smem, VB);
  if (SP == 8) rms_rows<true>((const float*)p.out, S_, (const float*)p.in[I_NORMG] + (l + 1) * D_, (u16*)(p.ws + OFF_H));
}

extern "C" void kernel_launch(void* const* d_in, const int* in_sizes, int n_in, void* d_out, int out_size, void* d_ws,
                              size_t ws_size, hipStream_t stream) {
  static int grid_blocks = 0;
  if (!grid_blocks) {
    int dev = 0, cus = 0, per_cu = 0;
    hipGetDevice(&dev);
    hipDeviceGetAttribute(&cus, hipDeviceAttributeMultiprocessorCount, dev);
    hipOccupancyMaxActiveBlocksPerMultiprocessor(&per_cu, mega, 256, 0);
    if (per_cu > 2) per_cu = 2;
    if (per_cu < 1) per_cu = 1;
    grid_blocks = cus * per_cu;
  }
  Params p{};
  for (int i = 0; i < N_INPUTS; ++i) p.in[i] = d_in[i];
  p.out = (float*)d_out;
  p.ws = (char*)d_ws;
  if (ws_size < WS_TOTAL) fprintf(stderr, "workspace too small: %zu < %zu\n", ws_size, (size_t)WS_TOTAL);
#if MULTI_LAUNCH
  const int G = grid_blocks;
  hipLaunchKernelGGL((k_phase<-1, 0>), dim3(G), dim3(256), 0, stream, p, 0);
  for (int l = 0; l < L_; ++l) {
    hipLaunchKernelGGL((k_phase<0, 0>), dim3(G), dim3(256), 0, stream, p, l);
    hipLaunchKernelGGL((k_phase<1, 0>), dim3(G), dim3(256), 0, stream, p, l);
    hipLaunchKernelGGL((k_phase<2, 0>), dim3(G), dim3(256), 0, stream, p, l);
    hipLaunchKernelGGL((k_phase<3, 0>), dim3(G), dim3(256), 0, stream, p, l);
    hipLaunchKernelGGL((k_phase<4, 8>), dim3(64), dim3(256), 0, stream, p, l);
    hipLaunchKernelGGL((k_phase<4, 1>), dim3(G), dim3(256), 0, stream, p, l);
    hipLaunchKernelGGL((k_phase<4, 2>), dim3(G), dim3(256), 0, stream, p, l);
    hipLaunchKernelGGL((k_phase<4, 4>), dim3(G), dim3(256), 0, stream, p, l);
    hipLaunchKernelGGL((k_phase<5, 0>), dim3(G), dim3(256), 0, stream, p, l);
    hipLaunchKernelGGL((k_phase<6, 0>), dim3(G), dim3(256), 0, stream, p, l);
    hipLaunchKernelGGL((k_phase<7, 0>), dim3(G), dim3(256), 0, stream, p, l);
    if (l + 1 < L_) hipLaunchKernelGGL((k_phase<8, 0>), dim3(G), dim3(256), 0, stream, p, l);
  }
#else
  hipMemsetAsync((char*)d_ws + OFF_BAR, 0, 3456 * 4, stream);
  int lo = 0, hi = N_PHASES - 1;
  void* args[] = {&p, &lo, &hi};
  hipError_t e = hipLaunchCooperativeKernel((void*)mega, dim3(grid_blocks), dim3(256), args, 0, stream);
  if (e != hipSuccess) fprintf(stderr, "cooperative launch failed: %s (grid %d)\n", hipGetErrorString(e), grid_blocks);
#endif
}
```

```cpp
#include <hip/hip_runtime.h>
#include <hip/hip_cooperative_groups.h>
#include <cstdio>
namespace cg = cooperative_groups;

typedef unsigned short u16;
typedef __attribute__((ext_vector_type(8))) short bf16x8;
typedef __attribute__((ext_vector_type(4))) float f32x4;
typedef __attribute__((ext_vector_type(4))) unsigned int u32x4;
typedef __attribute__((ext_vector_type(2))) unsigned int u32x2;

#ifndef MULTI_LAUNCH
#define MULTI_LAUNCH 0
#endif
#ifndef DUP_MASK
#define DUP_MASK 0
#endif
#ifndef ATT_NSUB
#define ATT_NSUB 2
#endif
#ifndef AT_MASK
#define AT_MASK 15
#endif
#ifndef PH_MASK
#if MULTI_LAUNCH
#define PH_MASK 0
#else
#define PH_MASK 0xffff
#endif
#endif


#define LOG2E 1.4426950408889634f
#define S_ 8192
#define D_ 2048
#define NIN 14784
#define NINP 14848
#define L_ 4
#define O_DQ 1792
#define O_DK 2304
#define O_DV 2816
#define O_QL 3328
#define O_KVL 3712
#define O_KR 3968
#define O_MQ 4032
#define O_G 4544
#define O_MG 6592

enum { I_X = 0, I_MEM, I_POS, I_NORMG, I_WIN, I_SHIFT, I_W0, I_WUP, I_A0, I_AUP, I_KK, I_KA, I_RK, I_GNG, I_GNB,
       I_DQKG, I_DLAM, I_DSUBG, I_RELB, I_QLATG, I_KVLATG, I_WUQ, I_WUKV, I_NOPEG, I_ROPEG, I_MEMNG, I_WKV,
       I_MQKG, I_WBR, I_WOUT, N_INPUTS };

struct Params {
  const void* in[N_INPUTS];
  float* out;
  char* ws;
};

constexpr size_t al(size_t x) { return (x + 255) & ~(size_t)255; }
constexpr size_t OFF_WIN = 0;
constexpr size_t OFF_WB = OFF_WIN + al((size_t)L_ * NINP * D_ * 2);
constexpr size_t OFF_WO = OFF_WB + al((size_t)L_ * 4 * 2048 * 512 * 2);
constexpr size_t OFF_WUQ = OFF_WO + al((size_t)L_ * 2048 * 2048 * 2);
constexpr size_t OFF_WUKV = OFF_WUQ + al((size_t)L_ * 768 * 384 * 2);
constexpr size_t OFF_WKV = OFF_WUKV + al((size_t)L_ * 1024 * 256 * 2);
constexpr size_t OFF_MEMN = OFF_WKV + al((size_t)L_ * 1024 * 2048 * 2);
constexpr size_t OFF_KVMEM = OFF_MEMN + al((size_t)L_ * 256 * 2048 * 2);
constexpr size_t OFF_KMEM = OFF_KVMEM + al((size_t)L_ * 256 * 512 * 4);
constexpr size_t OFF_VTMEM = OFF_KMEM + al((size_t)L_ * 4 * 256 * 128 * 2);
constexpr size_t OFF_H = OFF_VTMEM + al((size_t)L_ * 4 * 128 * 256 * 2);
constexpr size_t OFF_P = OFF_H + al((size_t)S_ * D_ * 2);
constexpr size_t OFF_RWU = OFF_P + al((size_t)S_ * NINP * 2);
constexpr size_t OFF_SCR = OFF_RWU + al((size_t)S_ * 1792 * 4);
constexpr size_t OFF_SCV = OFF_SCR + al((size_t)S_ * 512 * 4);
constexpr size_t OFF_SCKK = OFF_SCV + al((size_t)S_ * 512 * 4);
constexpr size_t OFF_SCW = OFF_SCKK + al((size_t)S_ * 512 * 4);
constexpr size_t OFF_SCKD = OFF_SCW + al((size_t)2 * S_ * 512 * 4);
constexpr size_t OFF_SCB = OFF_SCKD + al((size_t)2 * S_ * 512 * 4);
constexpr size_t OFF_BONUS = OFF_SCB + al((size_t)2 * S_ * 512 * 4);
constexpr size_t OFF_YS = OFF_BONUS + al((size_t)S_ * 8 * 4);
constexpr size_t OFF_MQ = OFF_YS + al((size_t)2 * S_ * 512 * 4);
constexpr size_t OFF_MKV = OFF_MQ + al((size_t)S_ * 768 * 4);
constexpr size_t OFF_QM = OFF_MKV + al((size_t)S_ * 512 * 4);
constexpr size_t OFF_KM = OFF_QM + al((size_t)4 * S_ * 192 * 2);
constexpr size_t OFF_VTM = OFF_KM + al((size_t)4 * S_ * 192 * 2);
constexpr size_t OFF_VTD = OFF_VTM + al((size_t)4 * 128 * S_ * 2);
constexpr size_t OFF_OB = OFF_VTD + al((size_t)4 * 128 * S_ * 2);
constexpr size_t OFF_YG = OFF_OB + al((size_t)16 * S_ * 128 * 4);
constexpr size_t OFF_Z = OFF_YG + al((size_t)4 * S_ * 512 * 2);
constexpr size_t OFF_CNT = OFF_Z + al((size_t)S_ * D_ * 2);
constexpr size_t OFF_KPMM = OFF_CNT + 256;
constexpr size_t OFF_BAR = OFF_KPMM + 1024;
constexpr size_t OFF_OB2 = OFF_BAR + al(3456 * 4);
constexpr size_t OFF_ML = OFF_OB2 + al((size_t)16 * S_ * 128 * 4);
constexpr size_t WS_TOTAL = OFF_ML + (size_t)2 * 16 * S_ * 2 * 4;

#define SMEM_BYTES 49152

#define LBAR() asm volatile("s_waitcnt lgkmcnt(0)\n\ts_barrier" ::: "memory")
__device__ __forceinline__ int ltid() {
  int t = __builtin_amdgcn_workitem_id_x();
  asm volatile("" : "+v"(t));
  return t;
}
__device__ __forceinline__ int lbid() {
  int t = __builtin_amdgcn_workgroup_id_x();
  asm volatile("" : "+s"(t));
  return t;
}
typedef float f32x2_ __attribute__((ext_vector_type(2)));
typedef __bf16 bf16x2_ __attribute__((ext_vector_type(2)));
__device__ __forceinline__ unsigned pack2(float a, float b) {
  f32x2_ v = {a, b};
  return __builtin_bit_cast(unsigned, __builtin_convertvector(v, bf16x2_));
}
__device__ __forceinline__ u16 f2bf(float f) { return (u16)(pack2(f, 0.f) & 0xffffu); }
__device__ __forceinline__ float bf2f(u16 h) { return __uint_as_float(((unsigned)h) << 16); }
__device__ __forceinline__ float lo2f(unsigned u) { return __uint_as_float(u << 16); }
__device__ __forceinline__ float hi2f(unsigned u) { return __uint_as_float(u & 0xffff0000u); }
__device__ __forceinline__ float sigmoidf_(float x) { return 1.f / (1.f + __expf(-x)); }
__device__ __forceinline__ float wave_sum(float v) {
#pragma unroll
  for (int o = 32; o >= 1; o >>= 1) v += __shfl_xor(v, o);
  return v;
}
template <int CTRL>
__device__ __forceinline__ float dpp_add(float x) {
  return x + __int_as_float(__builtin_amdgcn_update_dpp(0, __float_as_int(x), CTRL, 0xf, 0xf, true));
}
__device__ __forceinline__ float row16_sum(float x) {
  x = dpp_add<0xB1>(x);
  x = dpp_add<0x4E>(x);
  x = dpp_add<0x141>(x);
  x = dpp_add<0x140>(x);
  return x;
}

template <bool SW>
__device__ __forceinline__ void gemm_main1(const u16* __restrict__ A, int lda, const u16* __restrict__ B, int ldb,
                                          int K, u16* As, u16* Bs, f32x4 (&acc)[4][4]) {
  const int tid = ltid(), lane = tid & 63, w = tid >> 6, l15 = lane & 15, quad = lane >> 4;
  const int wm = w >> 1, wn = w & 1;
  u32x4 ra[4], rb[4];
#pragma unroll
  for (int i = 0; i < 4; ++i) {
    int c = tid + i * 256, r = c >> 3, kc = c & 7;
    ra[i] = *(const u32x4*)(A + (size_t)r * lda + kc * 8);
    rb[i] = *(const u32x4*)(B + (size_t)r * ldb + kc * 8);
  }
  for (int k0 = 0; k0 < K; k0 += 64) {
    LBAR();
#pragma unroll
    for (int i = 0; i < 4; ++i) {
      int c = tid + i * 256, r = c >> 3, kc = c & 7;
      *(u32x4*)(As + r * 64 + ((kc ^ (r & 7)) * 8)) = ra[i];
      *(u32x4*)(Bs + r * 64 + ((kc ^ (r & 7)) * 8)) = rb[i];
    }
    LBAR();
    {
      const int kn = min(k0 + 64, K - 64);
#pragma unroll
      for (int i = 0; i < 4; ++i) {
        int c = tid + i * 256, r = c >> 3, kc = c & 7;
        ra[i] = *(const u32x4*)(A + (size_t)r * lda + kn + kc * 8);
        rb[i] = *(const u32x4*)(B + (size_t)r * ldb + kn + kc * 8);
      }
    }
#pragma unroll
    for (int ks = 0; ks < 2; ++ks) {
      bf16x8 af[4], bfr[4];
#pragma unroll
      for (int i = 0; i < 4; ++i) {
        af[i] = *(const bf16x8*)(As + (wm * 64 + i * 16 + l15) * 64 + (((ks * 4 + quad) ^ (l15 & 7)) * 8));
        bfr[i] = *(const bf16x8*)(Bs + (wn * 64 + i * 16 + l15) * 64 + (((ks * 4 + quad) ^ (l15 & 7)) * 8));
      }
#pragma unroll
      for (int i = 0; i < 4; ++i)
#pragma unroll
        for (int j = 0; j < 4; ++j) acc[i][j] = SW ? __builtin_amdgcn_mfma_f32_16x16x32_bf16(bfr[j], af[i], acc[i][j], 0, 0, 0)
                                                     : __builtin_amdgcn_mfma_f32_16x16x32_bf16(af[i], bfr[j], acc[i][j], 0, 0, 0);
    }
  }
}

template <bool SW>
__device__ __forceinline__ void gemm_main(const u16* __restrict__ A, int lda, const u16* __restrict__ B, int ldb,
                                          int K, u16* As, u16* Bs, f32x4 (&acc)[4][4]) {
  const int tid = ltid(), lane = tid & 63, w = tid >> 6, l15 = lane & 15, quad = lane >> 4;
  const int wm = w >> 1, wn = w & 1;
  u32x4 ra0[4], rb0[4], ra1[4], rb1[4];
  const u16* Ap = A + (size_t)(tid >> 3) * lda + (tid & 7) * 8;
  const u16* Bp = B + (size_t)(tid >> 3) * ldb + (tid & 7) * 8;
  const size_t sa = (size_t)32 * lda, sb = (size_t)32 * ldb;
#define G_LOAD(RA, RB, KK)                                            \
  {                                                                   \
    const int kk_ = min((KK), K - 64);                                \
    _Pragma("unroll") for (int i = 0; i < 4; ++i) {                   \
      RA[i] = *(const u32x4*)(Ap + i * sa + kk_);                     \
      RB[i] = *(const u32x4*)(Bp + i * sb + kk_);                     \
    }                                                                 \
  }
#define G_STAGE(RA, RB, KNEXT)                                                                   \
  {                                                                                              \
    LBAR();                                                                             \
    _Pragma("unroll") for (int i = 0; i < 4; ++i) {                                              \
      *(u32x4*)(As + ((tid >> 3) + i * 32) * 64 + (((tid & 7) ^ ((tid >> 3) & 7)) * 8)) = RA[i]; \
      *(u32x4*)(Bs + ((tid >> 3) + i * 32) * 64 + (((tid & 7) ^ ((tid >> 3) & 7)) * 8)) = RB[i]; \
    }                                                                                            \
    LBAR();                                                                             \
    G_LOAD(RA, RB, KNEXT)                                                                        \
    {                                                                                            \
      bf16x8 af[2][4], bfr[2][4];                                                                \
      _Pragma("unroll") for (int ks = 0; ks < 2; ++ks)                                           \
        _Pragma("unroll") for (int i = 0; i < 4; ++i) {                                          \
          af[ks][i] = *(const bf16x8*)(As + (wm * 64 + i * 16 + l15) * 64 + (((ks * 4 + quad) ^ (l15 & 7)) * 8));  \
          bfr[ks][i] = *(const bf16x8*)(Bs + (wn * 64 + i * 16 + l15) * 64 + (((ks * 4 + quad) ^ (l15 & 7)) * 8)); \
        }                                                                                        \
      __builtin_amdgcn_sched_barrier(0);                                                         \
      _Pragma("unroll") for (int ks = 0; ks < 2; ++ks)                                           \
        _Pragma("unroll") for (int i = 0; i < 4; ++i)                                            \
          _Pragma("unroll") for (int j = 0; j < 4; ++j)                                          \
            acc[i][j] = SW ? __builtin_amdgcn_mfma_f32_16x16x32_bf16(bfr[ks][j], af[ks][i], acc[i][j], 0, 0, 0) \
                           : __builtin_amdgcn_mfma_f32_16x16x32_bf16(af[ks][i], bfr[ks][j], acc[i][j], 0, 0, 0); \
    }                                                                                            \
  }
  G_LOAD(ra0, rb0, 0)
  G_LOAD(ra1, rb1, 64)
  for (int k0 = 0; k0 < K; k0 += 128) {
    G_STAGE(ra0, rb0, k0 + 128)
    G_STAGE(ra1, rb1, k0 + 192)
  }
#undef G_LOAD
#undef G_STAGE
}

__device__ __forceinline__ void gemm_main_blk(const u16* __restrict__ A, const u16* __restrict__ B,
                                          int K, u16* As, u16* Bs, f32x4 (&acc)[4][4]) {
  const int tid = ltid(), lane = tid & 63, w = tid >> 6, l15 = lane & 15, quad = lane >> 4;
  const int wm = w >> 1, wn = w & 1;
  u32x4 ra0[4], rb0[4], ra1[4], rb1[4];
  const u16* Ap = A + tid * 8;
  const u16* Bp = B + tid * 8;
#define G_LOAD(RA, RB, KK)                                            \
  {                                                                   \
    const int kk_ = min((KK), K - 64);                                \
    _Pragma("unroll") for (int i = 0; i < 4; ++i) {                   \
      RA[i] = *(const u32x4*)(Ap + (size_t)kk_ * 128 + i * 2048);    \
      RB[i] = *(const u32x4*)(Bp + (size_t)kk_ * 128 + i * 2048);    \
    }                                                                 \
  }
#define G_STAGE(RA, RB, KNEXT)                                                                   \
  {                                                                                              \
    LBAR();                                                                             \
    _Pragma("unroll") for (int i = 0; i < 4; ++i) {                                              \
      *(u32x4*)(As + i * 2048 + tid * 8) = RA[i];                                                \
      *(u32x4*)(Bs + i * 2048 + tid * 8) = RB[i];                                                \
    }                                                                                            \
    LBAR();                                                                             \
    G_LOAD(RA, RB, KNEXT)                                                                        \
    {                                                                                            \
      bf16x8 af[2][4], bfr[2][4];                                                                \
      _Pragma("unroll") for (int ks = 0; ks < 2; ++ks)                                           \
        _Pragma("unroll") for (int i = 0; i < 4; ++i) {                                          \
          af[ks][i] = *(const bf16x8*)(As + (wm * 64 + i * 16 + l15) * 64 + (((ks * 4 + quad) ^ (l15 & 7)) * 8));  \
          bfr[ks][i] = *(const bf16x8*)(Bs + (wn * 64 + i * 16 + l15) * 64 + (((ks * 4 + quad) ^ (l15 & 7)) * 8)); \
        }                                                                                        \
      __builtin_amdgcn_sched_barrier(0);                                                         \
      _Pragma("unroll") for (int ks = 0; ks < 2; ++ks)                                           \
        _Pragma("unroll") for (int i = 0; i < 4; ++i)                                            \
          _Pragma("unroll") for (int j = 0; j < 4; ++j)                                          \
            acc[i][j] = __builtin_amdgcn_mfma_f32_16x16x32_bf16(af[ks][i], bfr[ks][j], acc[i][j], 0, 0, 0); \
    }                                                                                            \
  }
  G_LOAD(ra0, rb0, 0)
  G_LOAD(ra1, rb1, 64)
  for (int k0 = 0; k0 < K; k0 += 128) {
    G_STAGE(ra0, rb0, k0 + 128)
    G_STAGE(ra1, rb1, k0 + 192)
  }
#undef G_LOAD
#undef G_STAGE
}

#define ZERO_ACC(acc)                                  \
  _Pragma("unroll") for (int i_ = 0; i_ < 4; ++i_)     \
  _Pragma("unroll") for (int j_ = 0; j_ < 4; ++j_) acc[i_][j_] = (f32x4){0.f, 0.f, 0.f, 0.f};

#define EPI_LOOP_T(BODY)                                                           \
  {                                                                                \
    const int lane_ = ltid() & 63, w_ = ltid() >> 6;                               \
    const int l15_ = lane_ & 15, quad_ = lane_ >> 4, wm_ = w_ >> 1, wn_ = w_ & 1;  \
    _Pragma("unroll") for (int i = 0; i < 4; ++i) {                                \
      _Pragma("unroll") for (int j = 0; j < 4; ++j) {                              \
        const int mr = wm_ * 64 + i * 16 + l15_;                                   \
        const int nc = wn_ * 64 + j * 16 + quad_ * 4;                              \
        BODY                                                                       \
      }                                                                            \
    }                                                                              \
  }

#define EPI_LOOP(BODY)                                                             \
  {                                                                                \
    const int lane_ = ltid() & 63, w_ = ltid() >> 6;                     \
    const int l15_ = lane_ & 15, quad_ = lane_ >> 4, wm_ = w_ >> 1, wn_ = w_ & 1;  \
    _Pragma("unroll") for (int i = 0; i < 4; ++i) {                                \
      _Pragma("unroll") for (int j = 0; j < 4; ++j) {                              \
        const int mr = wm_ * 64 + i * 16 + quad_ * 4;                              \
        const int nc = wn_ * 64 + j * 16 + l15_;                                   \
        BODY                                                                       \
      }                                                                            \
    }                                                                              \
  }

__device__ __forceinline__ void gemm_main_blk2(const u16* __restrict__ A, const u16* __restrict__ B, int K, u16* As, u16* Bs,
                                               f32x4 (&acc)[8][4]) {
  const int tid = ltid(), lane = tid & 63, w = tid >> 6, l15 = lane & 15, quad = lane >> 4;
  const int wm = w >> 1, wn = w & 1;
  u32x4 ra[8], rb[4];
  const char* Ab = (const char*)A;
  const char* A2b = (const char*)(A + (size_t)(K >> 6) * 8192);
  const char* Bb = (const char*)B;
  const unsigned lo = (unsigned)tid * 16u;
#define G2_LOAD(KK)                                                                   \
  {                                                                                   \
    const unsigned ko_ = (unsigned)min((KK), K - 64) * 256u;                          \
    _Pragma("unroll") for (int i = 0; i < 4; ++i) {                                   \
      ra[i] = *(const u32x4*)(Ab + (unsigned)(lo + ko_ + (unsigned)i * 4096u));       \
      ra[4 + i] = *(const u32x4*)(A2b + (unsigned)(lo + ko_ + (unsigned)i * 4096u));  \
      rb[i] = *(const u32x4*)(Bb + (unsigned)(lo + ko_ + (unsigned)i * 4096u));       \
    }                                                                                 \
  }
  G2_LOAD(0)
  for (int k0 = 0; k0 < K; k0 += 64) {
    LBAR();
#pragma unroll
    for (int i = 0; i < 8; ++i) *(u32x4*)(As + i * 2048 + tid * 8) = ra[i];
#pragma unroll
    for (int i = 0; i < 4; ++i) *(u32x4*)(Bs + i * 2048 + tid * 8) = rb[i];
    LBAR();
    G2_LOAD(k0 + 64)
#pragma unroll
    for (int ks = 0; ks < 2; ++ks) {
      bf16x8 af[8], bfr[4];
#pragma unroll
      for (int i = 0; i < 8; ++i)
        af[i] = *(const bf16x8*)(As + (wm * 128 + i * 16 + l15) * 64 + (((ks * 4 + quad) ^ (l15 & 7)) * 8));
#pragma unroll
      for (int j = 0; j < 4; ++j)
        bfr[j] = *(const bf16x8*)(Bs + (wn * 64 + j * 16 + l15) * 64 + (((ks * 4 + quad) ^ (l15 & 7)) * 8));
#pragma unroll
      for (int i = 0; i < 8; ++i)
#pragma unroll
        for (int j = 0; j < 4; ++j) acc[i][j] = __builtin_amdgcn_mfma_f32_16x16x32_bf16(af[i], bfr[j], acc[i][j], 0, 0, 0);
    }
  }
#undef G2_LOAD
}

#define EPI_LOOP8(BODY)                                                            \
  {                                                                                \
    const int lane_ = ltid() & 63, w_ = ltid() >> 6;                               \
    const int l15_ = lane_ & 15, quad_ = lane_ >> 4, wm_ = w_ >> 1, wn_ = w_ & 1;  \
    _Pragma("unroll") for (int i = 0; i < 8; ++i) {                                \
      _Pragma("unroll") for (int j = 0; j < 4; ++j) {                              \
        const int mr = wm_ * 128 + i * 16 + quad_ * 4;                             \
        const int nc = wn_ * 64 + j * 16 + l15_;                                   \
        BODY                                                                       \
      }                                                                            \
    }                                                                              \
  }

template <bool BLK>
__device__ __forceinline__ void transpose_tile(const float* __restrict__ src, int N, u16* __restrict__ dst, int K, int kt, int nt,
                               float* tile) {
  const int tid = ltid();
  __syncthreads();
  {
    int c = tid & 63, r0 = tid >> 6;
#pragma unroll
    for (int i = 0; i < 16; ++i) {
      int r = r0 + i * 4;
      tile[r * 65 + c] = src[(size_t)(kt * 64 + r) * N + nt * 64 + c];
    }
  }
  __syncthreads();
#pragma unroll
  for (int i = 0; i < 2; ++i) {
    int c = tid + i * 256, n = c >> 3, kc = c & 7;
    uint4 o;
    o.x = pack2(tile[(kc * 8 + 0) * 65 + n], tile[(kc * 8 + 1) * 65 + n]);
    o.y = pack2(tile[(kc * 8 + 2) * 65 + n], tile[(kc * 8 + 3) * 65 + n]);
    o.z = pack2(tile[(kc * 8 + 4) * 65 + n], tile[(kc * 8 + 5) * 65 + n]);
    o.w = pack2(tile[(kc * 8 + 6) * 65 + n], tile[(kc * 8 + 7) * 65 + n]);
    if (BLK) {
      const int ng = nt * 64 + n;
      *(uint4*)(dst + ((size_t)(ng >> 7) * (K >> 6) + kt) * 8192 + (ng & 127) * 64 + ((kc ^ (ng & 7)) * 8)) = o;
    } else {
      *(uint4*)(dst + (size_t)(nt * 64 + n) * K + kt * 64 + kc * 8) = o;
    }
  }
}

template <bool BLK>
__device__ __forceinline__ void rms_rows(const float* __restrict__ src, int nrows, const float* __restrict__ g, u16* __restrict__ dst) {
  const int lane = ltid() & 63, w = ltid() >> 6;
  for (int row = lbid() * 4 + w; row < nrows; row += gridDim.x * 4) {
    const float4* xr = (const float4*)(src + (size_t)row * D_);
    float4 v[8];
    float ss = 0.f;
#pragma unroll
    for (int i = 0; i < 8; ++i) {
      v[i] = xr[lane + i * 64];
      ss += v[i].x * v[i].x + v[i].y * v[i].y + v[i].z * v[i].z + v[i].w * v[i].w;
    }
    ss = wave_sum(ss);
    float rs = rsqrtf(ss * (1.f / D_) + 1e-6f);
#pragma unroll
    for (int i = 0; i < 8; ++i) {
      int col = (lane + i * 64) * 4;
      float4 gg = *(const float4*)(g + col);
      uint2 o;
      o.x = pack2(v[i].x * rs * gg.x, v[i].y * rs * gg.y);
      o.y = pack2(v[i].z * rs * gg.z, v[i].w * rs * gg.w);
      if (BLK) {
        *(uint2*)(dst + ((size_t)(row >> 7) * 32 + (col >> 6)) * 8192 + (row & 127) * 64 + ((((col & 63) >> 3) ^ (row & 7)) * 8) + (col & 7)) = o;
      } else {
        *(uint2*)(dst + (size_t)row * D_ + col) = o;
      }
    }
  }
}

__device__ __forceinline__ int t5_bucket(int rel) {
  int n = rel < 0 ? -rel : rel;
  int b;
  if (n < 8) b = n;
  else if (n < 12) b = 8;
  else if (n < 16) b = 9;
  else if (n < 23) b = 10;
  else if (n < 32) b = 11;
  else if (n < 46) b = 12;
  else if (n < 64) b = 13;
  else if (n < 91) b = 14;
  else b = 15;
  return (rel > 0 ? 16 : 0) + b;
}

__device__ __forceinline__ void phase_w(const Params p, char* smem) {
  const int tid = ltid();
  float* tile = (float*)smem;
  char* ws = p.ws;
  if (lbid() == 0 && tid < 64) ((int*)(ws + OFF_CNT))[tid] = 0;
  {
    const int lane = tid & 63, w = tid >> 6;
    const int* pos = (const int*)p.in[I_POS];
    for (int t = lbid() * 4 + w; t < 128; t += gridDim.x * 4) {
      int v = pos[t * 64 + lane], mn = v, mx = v;
#pragma unroll
      for (int o = 32; o >= 1; o >>= 1) {
        mn = min(mn, __shfl_xor(mn, o));
        mx = max(mx, __shfl_xor(mx, o));
      }
      if (lane == 0) {
        ((int*)(ws + OFF_KPMM))[t * 2] = mn;
        ((int*)(ws + OFF_KPMM))[t * 2 + 1] = mx;
      }
    }
  }
  for (int i = lbid() * 256 + tid; i < L_ * 32 * 512; i += gridDim.x * 256) {
    int l = i / (32 * 512), r = i % (32 * 512), kt = r >> 9, q = r & 511;
    *(uint4*)((u16*)(ws + OFF_WIN) + (size_t)l * NINP * D_ + ((size_t)115 * 32 + kt) * 8192 + 4096 + q * 8) = make_uint4(0, 0, 0, 0);
  }
  rms_rows<true>((const float*)p.in[I_X], S_, (const float*)p.in[I_NORMG], (u16*)(ws + OFF_H));
  for (int l = 0; l < L_; ++l)
    rms_rows<false>((const float*)p.in[I_MEM], 256, (const float*)p.in[I_MEMNG] + l * D_, (u16*)(ws + OFF_MEMN) + (size_t)l * 256 * D_);
  const int PER_L = 7392 + 1024 + 1024 + 72 + 64 + 512;
  for (int t = lbid(); t < L_ * PER_L; t += gridDim.x) {
    int l = t / PER_L, r = t % PER_L;
    if (r < 7392) {
      transpose_tile<true>((const float*)p.in[I_WIN] + (size_t)l * D_ * NIN, NIN, (u16*)(ws + OFF_WIN) + (size_t)l * NINP * D_, D_,
                     r / 231, r % 231, tile);
    } else if (r < 7392 + 1024) {
      r -= 7392;
      int bi = r >> 8;
      r &= 255;
      transpose_tile<false>((const float*)p.in[I_WBR] + (size_t)(l * 4 + bi) * 512 * 2048, 2048,
                     (u16*)(ws + OFF_WB) + (size_t)(l * 4 + bi) * 2048 * 512, 512, r >> 5, r & 31, tile);
    } else if (r < 7392 + 2048) {
      r -= 7392 + 1024;
      transpose_tile<false>((const float*)p.in[I_WOUT] + (size_t)l * 2048 * 2048, 2048, (u16*)(ws + OFF_WO) + (size_t)l * 2048 * 2048,
                     2048, r >> 5, r & 31, tile);
    } else if (r < 7392 + 2048 + 72) {
      r -= 7392 + 2048;
      transpose_tile<false>((const float*)p.in[I_WUQ] + (size_t)l * 384 * 768, 768, (u16*)(ws + OFF_WUQ) + (size_t)l * 768 * 384, 384,
                     r / 12, r % 12, tile);
    } else if (r < 7392 + 2048 + 72 + 64) {
      r -= 7392 + 2048 + 72;
      transpose_tile<false>((const float*)p.in[I_WUKV] + (size_t)l * 256 * 1024, 1024, (u16*)(ws + OFF_WUKV) + (size_t)l * 1024 * 256,
                     256, r >> 4, r & 15, tile);
    } else {
      r -= 7392 + 2048 + 72 + 64;
      transpose_tile<false>((const float*)p.in[I_WKV] + (size_t)l * 2048 * 1024, 1024, (u16*)(ws + OFF_WKV) + (size_t)l * 1024 * 2048,
                     2048, r >> 4, r & 15, tile);
    }
  }
}

__device__ __forceinline__ int tile_slots(int NT) { return gridDim.x == 512 ? 512 * ((NT + 7) >> 3) : 64 * NT; }
__device__ __forceinline__ bool tile_map(int t, int NT, int& mt, int& nt) {
  if (gridDim.x == 512) {
    int bid = t & 511, k = t >> 9, x = bid & 7, j = bid >> 3;
    mt = 8 * x + (j & 7);
    nt = 8 * k + (j >> 3);
  } else {
    mt = t & 63;
    nt = t >> 6;
  }
  return nt < NT;
}

__device__ __forceinline__ int tile_slots2(int NT) { return gridDim.x == 512 ? 512 * ((NT + 15) >> 4) : 32 * NT; }
__device__ __forceinline__ bool tile_map2(int t, int NT, int& mt, int& nt) {
  if (gridDim.x == 512) {
    int bid = t & 511, k = t >> 9, x = bid & 7, j = bid >> 3;
    mt = 4 * x + (j & 3);
    nt = 16 * k + (j >> 2);
  } else {
    mt = t & 31;
    nt = t >> 5;
  }
  return nt < NT;
}

__device__ __forceinline__ void phase_gemm_in(const Params p, int l, char* smem, int vb) {
  u16* As = (u16*)smem;
  char* ws = p.ws;
  {
    u16* Bs = As + 256 * 64;
    const int nslots = tile_slots2(112);
    for (int t = vb; t < nslots; t += gridDim.x) {
      int mt, nt;
      if (!tile_map2(t, 112, mt, nt)) continue;
      f32x4 acc[8][4];
#pragma unroll
      for (int i_ = 0; i_ < 8; ++i_)
#pragma unroll
        for (int j_ = 0; j_ < 4; ++j_) acc[i_][j_] = (f32x4){0.f, 0.f, 0.f, 0.f};
      int m0 = mt * 256, n0 = nt * 128;
      gemm_main_blk2((const u16*)(ws + OFF_H) + (size_t)(2 * mt) * 32 * 8192,
                     (const u16*)(ws + OFF_WIN) + (size_t)l * NINP * D_ + (size_t)nt * 32 * 8192, D_, As, Bs, acc);
      if (n0 < 1792) {
        float* dst = (float*)(ws + OFF_RWU);
        EPI_LOOP8({
          _Pragma("unroll") for (int r2 = 0; r2 < 4; ++r2) dst[(size_t)(m0 + mr + r2) * 1792 + n0 + nc] = acc[i][j][r2];
        })
      } else if (n0 >= O_DV && n0 < O_QL) {
        u16* dst = (u16*)(ws + OFF_VTD) + (size_t)((n0 - O_DV) / 128) * 128 * S_;
        EPI_LOOP8({
          uint2 o;
          o.x = pack2(acc[i][j][0], acc[i][j][1]);
          o.y = pack2(acc[i][j][2], acc[i][j][3]);
          *(uint2*)(dst + (size_t)nc * S_ + m0 + mr) = o;
        })
      } else {
        u16* dst = (u16*)(ws + OFF_P);
        EPI_LOOP8({
          _Pragma("unroll") for (int r2 = 0; r2 < 4; ++r2) dst[(size_t)(m0 + mr + r2) * NINP + n0 + nc] = f2bf(acc[i][j][r2]);
        })
      }
    }
  }
  {
    u16* Bs = As + 128 * 64;
    for (int t = vb; t < 256; t += gridDim.x) {
      f32x4 acc[4][4];
      ZERO_ACC(acc);
      int mt = t & 63, nt = 112 + (t >> 6);
      int m0 = mt * 128, n0 = nt * 128;
      gemm_main_blk((const u16*)(ws + OFF_H) + (size_t)mt * 32 * 8192,
                    (const u16*)(ws + OFF_WIN) + (size_t)l * NINP * D_ + (size_t)nt * 32 * 8192, D_, As, Bs, acc);
      u16* dst = (u16*)(ws + OFF_P);
      EPI_LOOP({
        _Pragma("unroll") for (int r2 = 0; r2 < 4; ++r2) dst[(size_t)(m0 + mr + r2) * NINP + n0 + nc] = f2bf(acc[i][j][r2]);
      })
    }
  }
  if (l == 0) {
    u16* Bs = As + 128 * 64;
    for (int tt = (vb + gridDim.x - 256) % gridDim.x; tt < 64; tt += gridDim.x) {
      f32x4 acc[4][4];
      ZERO_ACC(acc);
      int ll = tt >> 4, mt = (tt >> 3) & 1, nt = tt & 7;
      int m0 = mt * 128, n0 = nt * 128;
      gemm_main<false>((const u16*)(ws + OFF_MEMN) + ((size_t)ll * 256 + m0) * D_, D_, (const u16*)(ws + OFF_WKV) + ((size_t)ll * 1024 + n0) * D_,
                D_, D_, As, Bs, acc);
      if (nt < 4) {
        float* dst = (float*)(ws + OFF_KVMEM) + (size_t)ll * 256 * 512;
        EPI_LOOP({
          _Pragma("unroll") for (int r2 = 0; r2 < 4; ++r2) dst[(size_t)(m0 + mr + r2) * 512 + n0 + nc] = acc[i][j][r2];
        })
      } else {
        u16* dst = (u16*)(ws + OFF_VTMEM) + (size_t)(ll * 4 + (nt - 4)) * 128 * 256;
        EPI_LOOP({
          uint2 o;
          o.x = pack2(acc[i][j][0], acc[i][j][1]);
          o.y = pack2(acc[i][j][2], acc[i][j][3]);
          *(uint2*)(dst + (size_t)nc * 256 + m0 + mr) = o;
        })
      }
    }
  }
}

__device__ __forceinline__ void phase_gemm_mla(const Params p, int l, char* smem, int vb) {
  u16* As = (u16*)smem;
  u16* Bs = As + 128 * 64;
  char* ws = p.ws;
  const u16* P = (const u16*)(ws + OFF_P);
  const int nslots = tile_slots(14);
  for (int t = vb; t < nslots; t += gridDim.x) {
    f32x4 acc[4][4];
    ZERO_ACC(acc);
    int mt, nt;
    if (!tile_map(t, 14, mt, nt)) continue;
    int m0 = mt * 128;
    if (nt < 6) {
      int n0 = nt * 128;
      gemm_main<true>(P + (size_t)m0 * NINP + O_QL, NINP, (const u16*)(ws + OFF_WUQ) + ((size_t)l * 768 + n0) * 384, 384, 384, As, Bs, acc);
      u16* dst = (u16*)(ws + OFF_MQ);
      EPI_LOOP_T({
        uint2 o;
        o.x = pack2(acc[i][j][0], acc[i][j][1]);
        o.y = pack2(acc[i][j][2], acc[i][j][3]);
        *(uint2*)(dst + (size_t)(m0 + mr) * 768 + n0 + nc) = o;
      })
    } else {
      nt -= 6;
      int n0 = nt * 128, h = nt >> 1;
      if ((nt & 1) == 0) {
        gemm_main<true>(P + (size_t)m0 * NINP + O_KVL, NINP, (const u16*)(ws + OFF_WUKV) + ((size_t)l * 1024 + n0) * 256, 256, 256, As, Bs, acc);
        u16* dst = (u16*)(ws + OFF_MKV);
        EPI_LOOP_T({
          uint2 o;
          o.x = pack2(acc[i][j][0], acc[i][j][1]);
          o.y = pack2(acc[i][j][2], acc[i][j][3]);
          *(uint2*)(dst + (size_t)(m0 + mr) * 512 + h * 128 + nc) = o;
        })
      } else {
        gemm_main<false>(P + (size_t)m0 * NINP + O_KVL, NINP, (const u16*)(ws + OFF_WUKV) + ((size_t)l * 1024 + n0) * 256, 256, 256, As, Bs, acc);
        u16* dst = (u16*)(ws + OFF_VTM) + (size_t)h * 128 * S_;
        EPI_LOOP({
          uint2 o;
          o.x = pack2(acc[i][j][0], acc[i][j][1]);
          o.y = pack2(acc[i][j][2], acc[i][j][3]);
          *(uint2*)(dst + (size_t)nc * S_ + m0 + mr) = o;
        })
      }
    }
  }
}

__device__ __forceinline__ void phase_gemm_branch(const Params p, int l, char* smem, int vb) {
  u16* As = (u16*)smem;
  u16* Bs = As + 128 * 64;
  char* ws = p.ws;
  const u16* P = (const u16*)(ws + OFF_P);
  const int nslots = tile_slots(16);
  for (int t = vb; t < nslots; t += gridDim.x) {
    int mt, nt;
    if (!tile_map(t, 16, mt, nt)) continue;
    int m0 = mt * 128, n0 = nt * 128;
    f32x4 zacc[4][4];
    ZERO_ACC(zacc);
    for (int bi = 0; bi < 4; ++bi) {
      f32x4 acc[4][4];
      ZERO_ACC(acc);
      gemm_main1<true>((const u16*)(ws + OFF_YG) + ((size_t)bi * S_ + m0) * 512, 512,
                (const u16*)(ws + OFF_WB) + ((size_t)(l * 4 + bi) * 2048 + n0) * 512, 512, 512, As, Bs, acc);
      EPI_LOOP_T({
        const uint2 mg = *(const uint2*)(P + (size_t)(m0 + mr) * NINP + O_MG + bi * 2048 + n0 + nc);
        zacc[i][j][0] += sigmoidf_(lo2f(mg.x)) * acc[i][j][0];
        zacc[i][j][1] += sigmoidf_(hi2f(mg.x)) * acc[i][j][1];
        zacc[i][j][2] += sigmoidf_(lo2f(mg.y)) * acc[i][j][2];
        zacc[i][j][3] += sigmoidf_(hi2f(mg.y)) * acc[i][j][3];
      })
    }
    u16* dst = (u16*)(ws + OFF_Z);
    EPI_LOOP_T({
      uint2 o;
      o.x = pack2(zacc[i][j][0], zacc[i][j][1]);
      o.y = pack2(zacc[i][j][2], zacc[i][j][3]);
      *(uint2*)(dst + (size_t)(m0 + mr) * D_ + n0 + nc) = o;
    })
  }
}

__device__ __forceinline__ void phase_gemm_out(const Params p, int l, char* smem, int vb) {
  u16* As = (u16*)smem;
  u16* Bs = As + 128 * 64;
  char* ws = p.ws;
  const float* xin = (l == 0) ? (const float*)p.in[I_X] : (const float*)p.out;
  const int nslots = tile_slots(16);
  for (int t = vb; t < nslots; t += gridDim.x) {
    int mt, nt;
    if (!tile_map(t, 16, mt, nt)) continue;
    int m0 = mt * 128, n0 = nt * 128;
    f32x4 acc[4][4];
    ZERO_ACC(acc);
    gemm_main<true>((const u16*)(ws + OFF_Z) + (size_t)m0 * D_, D_, (const u16*)(ws + OFF_WO) + ((size_t)l * 2048 + n0) * D_, D_, D_, As, Bs,
              acc);
    EPI_LOOP_T({
      size_t idx = (size_t)(m0 + mr) * D_ + n0 + nc;
      float4 xv = *(const float4*)(xin + idx);
      *(float4*)(p.out + idx) = make_float4(xv.x + acc[i][j][0], xv.y + acc[i][j][1], xv.z + acc[i][j][2], xv.w + acc[i][j][3]);
    })
  }
}

__device__ __forceinline__ void seg_norm8(u16* ptr, bool active, int width, float inv_n, const float* g, float scale) {
  uint4 v = make_uint4(0, 0, 0, 0);
  if (active) v = *(const uint4*)ptr;
  float x[8] = {lo2f(v.x), hi2f(v.x), lo2f(v.y), hi2f(v.y), lo2f(v.z), hi2f(v.z), lo2f(v.w), hi2f(v.w)};
  float ss = 0.f;
#pragma unroll
  for (int i = 0; i < 8; ++i) ss += x[i] * x[i];
  for (int o = 1; o < width; o <<= 1) ss += __shfl_xor(ss, o);
  float rs = rsqrtf(ss * inv_n + 1e-6f) * scale;
  if (active) {
    float4 g0 = *(const float4*)g, g1 = *(const float4*)(g + 4);
    uint4 o;
    o.x = pack2(x[0] * rs * g0.x, x[1] * rs * g0.y);
    o.y = pack2(x[2] * rs * g0.z, x[3] * rs * g0.w);
    o.z = pack2(x[4] * rs * g1.x, x[5] * rs * g1.y);
    o.w = pack2(x[6] * rs * g1.z, x[7] * rs * g1.w);
    *(uint4*)ptr = o;
  }
}

template <bool RWONLY>
__device__ __forceinline__ void phase_prep(const Params p, int l, char* smem) {
  char* ws = p.ws;
  const int tid = ltid(), lane = tid & 63, w = tid >> 6;
  u16* P = (u16*)(ws + OFF_P);
  if (!RWONLY) {
    const float* dqg = (const float*)p.in[I_DQKG] + l * 128;
    const float* mqg = (const float*)p.in[I_MQKG] + l * 256;
    const float* qlg = (const float*)p.in[I_QLATG] + l * 384;
    const float* kvg = (const float*)p.in[I_KVLATG] + l * 256;
    for (int s = lbid() * 4 + w; s < S_; s += gridDim.x * 4) {
      u16* row = P + (size_t)s * NINP;
      seg_norm8(row + O_DQ + lane * 8, true, 8, 1.f / 64, dqg + (lane * 8) % 64, 0.125f * LOG2E);
      seg_norm8(row + O_DK + lane * 8, true, 8, 1.f / 64, dqg + 64 + (lane * 8) % 64, 1.f);
      seg_norm8(row + O_MQ + lane * 8, true, 16, 1.f / 128, mqg + (lane * 8) % 128, 0.08838834764831845f * LOG2E);
      seg_norm8(row + O_QL + (lane < 48 ? lane : 0) * 8, lane < 48, 64, 1.f / 384, qlg + (lane < 48 ? lane : 0) * 8, 1.f);
      seg_norm8(row + O_KVL + (lane < 32 ? lane : 0) * 8, lane < 32, 64, 1.f / 256, kvg + (lane < 32 ? lane : 0) * 8, 1.f);
    }
  }
  if (l == 0 && !RWONLY) {
    for (int sg = lbid() * 4 + w; sg < L_ * 256 * 4; sg += gridDim.x * 4) {
      int ll = sg >> 10, m = (sg >> 2) & 255, h = sg & 3;
      const float* src = (const float*)(ws + OFF_KVMEM) + ((size_t)ll * 256 + m) * 512 + h * 128;
      float a = src[lane], b = src[lane + 64];
      float ss = wave_sum(a * a + b * b);
      float rs = rsqrtf(ss * (1.f / 128) + 1e-6f);
      const float* g = (const float*)p.in[I_MQKG] + ll * 256 + 128;
      u16* dst = (u16*)(ws + OFF_KMEM) + ((size_t)(ll * 4 + h) * 256 + m) * 128;
      dst[lane] = f2bf(a * rs * g[lane]);
      dst[lane + 64] = f2bf(b * rs * g[lane + 64]);
    }
  }
  {
    float* ld = (float*)smem;
    const float* RWU = (const float*)(ws + OFF_RWU);
    const float* sh = (const float*)p.in[I_SHIFT] + (size_t)l * 3 * 1792;
    const float* wup = (const float*)p.in[I_WUP] + (size_t)l * 2 * 64 * 512;
    const float* aup = (const float*)p.in[I_AUP] + (size_t)l * 2 * 64 * 512;
    const float* w0 = (const float*)p.in[I_W0] + l * 1024;
    const float* a0 = (const float*)p.in[I_A0] + l * 1024;
    const float* kkp = (const float*)p.in[I_KK] + l * 512;
    const float* kap = (const float*)p.in[I_KA] + l * 512;
    const float* rkp = (const float*)p.in[I_RK] + l * 512;
    for (int tile = lbid(); tile < S_ / 8; tile += gridDim.x) {
      const int s0 = tile * 8;
      __syncthreads();
      {
        int c = 1536 + tid;
        float c0 = sh[c], c1 = sh[1792 + c], c2 = sh[2 * 1792 + c];
#pragma unroll
        for (int tk = 0; tk < 8; ++tk) {
          int s = s0 + tk;
          float um = s > 0 ? RWU[(size_t)(s - 1) * 1792 + c] : 0.f;
          float u0 = RWU[(size_t)s * 1792 + c];
          float up = s < S_ - 1 ? RWU[(size_t)(s + 1) * 1792 + c] : 0.f;
          float v = c0 * um + c1 * u0 + c2 * up;
          if (tid < 128) v = tanhf(v);
          ld[tk * 256 + tid] = v;
        }
      }
      __syncthreads();
      float acc[8][4][2];
#pragma unroll
      for (int a = 0; a < 8; ++a)
#pragma unroll
        for (int b = 0; b < 4; ++b) acc[a][b][0] = acc[a][b][1] = 0.f;
      for (int l4 = 0; l4 < 16; ++l4) {
        float wv[4][4][2];
#pragma unroll
        for (int ll = 0; ll < 4; ++ll) {
#pragma unroll
          for (int ch = 0; ch < 2; ++ch) {
            int c = tid + ch * 256;
            int li = l4 * 4 + ll;
            wv[0][ll][ch] = wup[(size_t)(0 * 64 + li) * 512 + c];
            wv[1][ll][ch] = wup[(size_t)(1 * 64 + li) * 512 + c];
            wv[2][ll][ch] = aup[(size_t)(0 * 64 + li) * 512 + c];
            wv[3][ll][ch] = aup[(size_t)(1 * 64 + li) * 512 + c];
          }
        }
#pragma unroll
        for (int tk = 0; tk < 8; ++tk) {
#pragma unroll
          for (int mat = 0; mat < 4; ++mat) {
            float4 d = *(const float4*)(ld + tk * 256 + mat * 64 + l4 * 4);
#pragma unroll
            for (int ch = 0; ch < 2; ++ch) {
              acc[tk][mat][ch] += d.x * wv[mat][0][ch] + d.y * wv[mat][1][ch] + d.z * wv[mat][2][ch] + d.w * wv[mat][3][ch];
            }
          }
        }
      }
#pragma unroll
      for (int ch = 0; ch < 2; ++ch) {
        const int c = tid + ch * 256;
        float shc[3][3];
#pragma unroll
        for (int q = 0; q < 3; ++q)
#pragma unroll
          for (int j = 0; j < 3; ++j) shc[q][j] = sh[j * 1792 + q * 512 + c];
        const float kkc = kkp[c], kac = kap[c], rkc = rkp[c];
        const float w0c0 = w0[c], w0c1 = w0[512 + c], a0c0 = a0[c], a0c1 = a0[512 + c];
        float um[3], u0[3];
#pragma unroll
        for (int q = 0; q < 3; ++q) {
          um[q] = s0 > 0 ? RWU[(size_t)(s0 - 1) * 1792 + q * 512 + c] : 0.f;
          u0[q] = RWU[(size_t)s0 * 1792 + q * 512 + c];
        }
#pragma unroll
        for (int tk = 0; tk < 8; ++tk) {
          const int s = s0 + tk;
          float rkv[3];
#pragma unroll
          for (int q = 0; q < 3; ++q) {
            float up = s < S_ - 1 ? RWU[(size_t)(s + 1) * 1792 + q * 512 + c] : 0.f;
            rkv[q] = shc[q][0] * um[q] + shc[q][1] * u0[q] + shc[q][2] * up;
            um[q] = u0[q];
            u0[q] = up;
          }
          float r = rkv[0], k = rkv[1], v = rkv[2];
          float kkr = k * kkc;
          float ss = wave_sum(kkr * kkr);
          float kk = kkr / fmaxf(sqrtf(ss), 1e-12f);
          float bsum = 0.f;
#pragma unroll
          for (int n = 0; n < 2; ++n) {
            float zw = (n ? w0c1 : w0c0) + acc[tk][n][ch];
            float za = (n ? a0c1 : a0c0) + acc[tk][2 + n][ch];
            float dec = __expf(-0.6065306597126334f * sigmoidf_(zw));
            float a = sigmoidf_(za);
            float kd = k * (1.f + (a - 1.f) * kac);
            float bb = kk * a;
            size_t o = ((size_t)n * S_ + s) * 512 + c;
            ((float*)(ws + OFF_SCW))[o] = dec;
            ((float*)(ws + OFF_SCKD))[o] = kd;
            ((float*)(ws + OFF_SCB))[o] = bb;
            bsum += r * kd * rkc;
          }
          size_t o1 = (size_t)s * 512 + c;
          ((float*)(ws + OFF_SCR))[o1] = r;
          ((float*)(ws + OFF_SCV))[o1] = v;
          ((float*)(ws + OFF_SCKK))[o1] = kk;
          float bon = wave_sum(bsum);
          if (lane == 0) ((float*)(ws + OFF_BONUS))[s * 8 + w + 4 * ch] = bon;
        }
      }
    }
  }
}

__device__ __forceinline__ void phase_mla_post(const Params p, int l, char* smem) {
  char* ws = p.ws;
  const int lane = ltid() & 63, w = ltid() >> 6;
  const float* ng = (const float*)p.in[I_NOPEG] + l * 256;
  const float* rg = (const float*)p.in[I_ROPEG] + l * 128;
  const int* pos = (const int*)p.in[I_POS];
  const float qscale = 0.07216878364870322f * LOG2E;
  const int fi = lane & 31;
  const float inv_freq = powf(10000.f, -(float)fi / 32.f);
  for (int s = lbid() * 4 + w; s < S_; s += gridDim.x * 4) {
    float ang = (float)pos[s] * inv_freq;
    float cs = cosf(ang), sn = sinf(ang);
    const u16* mq = (const u16*)(ws + OFF_MQ) + (size_t)s * 768;
    const u16* mk = (const u16*)(ws + OFF_MKV) + (size_t)s * 512;
    float kr1, kr2;
    {
      const u16* kr = (const u16*)(ws + OFF_P) + (size_t)s * NINP + O_KR;
      float t1 = lane < 32 ? bf2f(kr[fi]) : 0.f, t2 = lane < 32 ? bf2f(kr[32 + fi]) : 0.f;
      float ss = wave_sum(t1 * t1 + t2 * t2);
      float rs = rsqrtf(ss * (1.f / 64) + 1e-6f);
      t1 *= rs * rg[64 + fi];
      t2 *= rs * rg[64 + 32 + fi];
      kr1 = t1 * cs - t2 * sn;
      kr2 = t2 * cs + t1 * sn;
    }
#pragma unroll
    for (int h = 0; h < 4; ++h) {
      u16* qd = (u16*)(ws + OFF_QM) + ((size_t)h * S_ + s) * 192;
      u16* kd = (u16*)(ws + OFF_KM) + ((size_t)h * S_ + s) * 192;
      {
        const unsigned ab = *(const unsigned*)(mq + h * 192 + 2 * lane);
        float a = lo2f(ab), b = hi2f(ab);
        float ss = wave_sum(a * a + b * b);
        float rs = rsqrtf(ss * (1.f / 128) + 1e-6f) * qscale;
        const float2 gq = *(const float2*)(ng + 2 * lane);
        *(unsigned*)(qd + 2 * lane) = pack2(a * rs * gq.x, b * rs * gq.y);
      }
      {
        float t1 = lane < 32 ? bf2f(mq[h * 192 + 128 + fi]) : 0.f, t2 = lane < 32 ? bf2f(mq[h * 192 + 160 + fi]) : 0.f;
        float ss = wave_sum(t1 * t1 + t2 * t2);
        float rs = rsqrtf(ss * (1.f / 64) + 1e-6f);
        t1 *= rs * rg[fi];
        t2 *= rs * rg[32 + fi];
        if (lane < 32) {
          qd[128 + fi] = f2bf((t1 * cs - t2 * sn) * qscale);
          qd[160 + fi] = f2bf((t2 * cs + t1 * sn) * qscale);
        }
      }
      {
        const unsigned ab = *(const unsigned*)(mk + h * 128 + 2 * lane);
        float a = lo2f(ab), b = hi2f(ab);
        float ss = wave_sum(a * a + b * b);
        float rs = rsqrtf(ss * (1.f / 128) + 1e-6f);
        const float2 gk = *(const float2*)(ng + 128 + 2 * lane);
        *(unsigned*)(kd + 2 * lane) = pack2(a * rs * gk.x, b * rs * gk.y);
        if (lane < 32) {
          kd[128 + fi] = f2bf(kr1);
          kd[160 + fi] = f2bf(kr2);
        }
      }
    }
  }
}

template <int DQK, int NSUB>
__device__ __forceinline__ void attn_item(const u16* __restrict__ Q, int ldq, const u16* __restrict__ K, int ldk, const u16* __restrict__ Vt,
                          int ldv, int Skv, u16* __restrict__ O, int qb, bool hasBias, const float* __restrict__ relb, int head,
                          const int* __restrict__ pos, const int* __restrict__ kpmm, char* smem, const int* __restrict__ kposp,
                          float* __restrict__ ML) {
  constexpr int LDK = DQK;
  constexpr int SW = (DQK == 128) ? 15 : 7;
  constexpr int NKS = DQK / 32;
  constexpr int NKC = DQK / 32;
  u16* Ks = (u16*)smem;
  u16* Vs = (u16*)(smem + 25600);
  float* bt = (float*)(smem + 44032);
  int* kp = (int*)(smem + 45072);
  const int tid = ltid(), lane = tid & 63, w = tid >> 6, l15 = lane & 15, quad = lane >> 4;
  const int q0 = qb * (64 * NSUB) + w * (16 * NSUB);

  bf16x8 qf[NSUB][NKS];
#pragma unroll
  for (int sub = 0; sub < NSUB; ++sub)
#pragma unroll
    for (int ks = 0; ks < NKS; ++ks)
      qf[sub][ks] = *(const bf16x8*)(Q + (size_t)(q0 + sub * 16 + l15) * ldq + ks * 32 + quad * 8);

  int qp[2] = {0, 0};
  int qpmin = 0, qpmax = 0;
  if (hasBias) {
    qp[0] = pos[q0 + l15];
    qp[1] = pos[q0 + (NSUB - 1) * 16 + l15];
    qpmin = min(qp[0], qp[1]);
    qpmax = max(qp[0], qp[1]);
#pragma unroll
    for (int o = 8; o >= 1; o >>= 1) {
      qpmin = min(qpmin, __shfl_xor(qpmin, o));
      qpmax = max(qpmax, __shfl_xor(qpmax, o));
    }
  }
  __syncthreads();
  if (hasBias) {
    for (int i = tid; i < 257; i += 256) bt[i] = relb[t5_bucket(i - 128) * 4 + head] * LOG2E;
  }
  u32x4 kreg[NKC], vreg[4];
#pragma unroll
  for (int i = 0; i < NKC; ++i) {
    int c = tid + i * 256, r = c / (DQK / 8), kc = c % (DQK / 8);
    kreg[i] = *(const u32x4*)(K + (size_t)r * ldk + kc * 8);
  }
#pragma unroll
  for (int i = 0; i < 4; ++i) {
    int c = tid + i * 256, r = c >> 3, kc = c & 7;
    vreg[i] = *(const u32x4*)(Vt + (size_t)r * ldv + kc * 8);
  }
#pragma unroll
  for (int i = 0; i < NKC; ++i) {
    int c = tid + i * 256, r = c / (DQK / 8), kc = c % (DQK / 8);
    *(u32x4*)(Ks + r * LDK + ((kc ^ (r & SW)) * 8)) = kreg[i];
  }
#pragma unroll
  for (int i = 0; i < 4; ++i) {
    int c = tid + i * 256, r = c >> 3, kc = c & 7;
    *(u32x4*)(Vs + r * 72 + kc * 8) = vreg[i];
  }
  if (hasBias && tid < 64) kp[tid] = kposp[tid];
  __syncthreads();

  f32x4 oacc[8][NSUB];
#pragma unroll
  for (int et = 0; et < 8; ++et)
#pragma unroll
    for (int sub = 0; sub < NSUB; ++sub) oacc[et][sub] = (f32x4){0.f, 0.f, 0.f, 0.f};
  float mrow[2] = {-1e30f, -1e30f}, lrow[2] = {0.f, 0.f};

  const int ntiles = Skv / 64;
  constexpr bool KDMA = (DQK == 192);
  int koff[6];
#pragma unroll
  for (int i = 0; i < 6; ++i) {
    const int o = (w + 4 * i) * 1024 + lane * 16;
    const int r = o / (DQK * 2), pos = (o % (DQK * 2)) >> 4;
    koff[i] = r * ldk + ((pos ^ (r & SW)) * 8);
  }
  for (int t = 0; t < ntiles; ++t) {
    const bool more = (t + 1 < ntiles);
    const int k1 = (t + 1) * 64;
    constexpr bool EARLY = (DQK != 128);
    if (EARLY && more) {
      if (!KDMA) {
#pragma unroll
        for (int i = 0; i < NKC; ++i) {
          int c = tid + i * 256, r = c / (DQK / 8), kc = c % (DQK / 8);
          kreg[i] = *(const u32x4*)(K + (size_t)(k1 + r) * ldk + kc * 8);
        }
      }
#pragma unroll
      for (int i = 0; i < 4; ++i) {
        int c = tid + i * 256, r = c >> 3, kc = c & 7;
        vreg[i] = *(const u32x4*)(Vt + (size_t)r * ldv + k1 + kc * 8);
      }
    }
    f32x4 sacc[4][NSUB];
#pragma unroll
    for (int kt = 0; kt < 4; ++kt)
#pragma unroll
      for (int sub = 0; sub < NSUB; ++sub) sacc[kt][sub] = (f32x4){0.f, 0.f, 0.f, 0.f};
    __builtin_amdgcn_s_setprio(1);
#pragma unroll
    for (int ks = 0; ks < NKS; ++ks) {
#pragma unroll
      for (int kt = 0; kt < 4; ++kt) {
        bf16x8 kf = *(const bf16x8*)(Ks + (kt * 16 + l15) * LDK + (((ks * 4 + quad) ^ (l15 & SW)) * 8));
#pragma unroll
        for (int sub = 0; sub < NSUB; ++sub)
          sacc[kt][sub] = __builtin_amdgcn_mfma_f32_16x16x32_bf16(kf, qf[sub][ks], sacc[kt][sub], 0, 0, 0);
      }
      __builtin_amdgcn_sched_barrier(0);
    }
    __builtin_amdgcn_s_setprio(0);
    float cb = 0.f;
    if (hasBias) {
      int kmn = kpmm[t * 2], kmx = kpmm[t * 2 + 1];
      if (kmn - qpmax >= 128 || kmx - qpmin <= -128) {
        cb = (kmn - qpmax >= 128) ? bt[256] : bt[0];
      } else {
#pragma unroll
        for (int kt = 0; kt < 4; ++kt) {
#pragma unroll
          for (int j = 0; j < 4; ++j) {
            int kpos = kp[kt * 16 + quad * 4 + j];
#pragma unroll
            for (int sub = 0; sub < NSUB; ++sub) {
              int rel = kpos - qp[sub];
              rel = max(-128, min(128, rel));
              sacc[kt][sub][j] += bt[rel + 128];
            }
          }
        }
      }
    }
    LBAR();
    if (more) {
      if (!EARLY) {
#pragma unroll
        for (int i = 0; i < NKC; ++i) {
          int c = tid + i * 256, r = c / (DQK / 8), kc = c % (DQK / 8);
          kreg[i] = *(const u32x4*)(K + (size_t)(k1 + r) * ldk + kc * 8);
        }
#pragma unroll
        for (int i = 0; i < 4; ++i) {
          int c = tid + i * 256, r = c >> 3, kc = c & 7;
          vreg[i] = *(const u32x4*)(Vt + (size_t)r * ldv + k1 + kc * 8);
        }
      }
      if (hasBias && tid < 64) kp[tid] = kposp[k1 + tid];
      if (KDMA) {
#pragma unroll
        for (int i = 0; i < 6; ++i)
          __builtin_amdgcn_global_load_lds((const unsigned*)(K + (size_t)k1 * ldk + koff[i]),
                                           (unsigned*)((char*)Ks + (w + 4 * i) * 1024), 16, 0, 0);
      }
    }
    __builtin_amdgcn_sched_barrier(0);
    bf16x8 pf[NSUB][2];
#pragma unroll
    for (int sub = 0; sub < NSUB; ++sub) {
      float mx = -1e30f;
#pragma unroll
      for (int kt = 0; kt < 4; ++kt)
#pragma unroll
        for (int j = 0; j < 4; ++j) mx = fmaxf(mx, sacc[kt][sub][j]);
      mx = fmaxf(mx, __shfl_xor(mx, 16));
      mx = fmaxf(mx, __shfl_xor(mx, 32));
      float mnew = fmaxf(mrow[sub], mx + cb);
      float alpha = __builtin_amdgcn_exp2f(mrow[sub] - mnew);
      mrow[sub] = mnew;
      const float off = cb - mnew;
      float ps = 0.f;
      float pv[4][4];
#pragma unroll
      for (int kt = 0; kt < 4; ++kt)
#pragma unroll
        for (int j = 0; j < 4; ++j) {
          pv[kt][j] = __builtin_amdgcn_exp2f(sacc[kt][sub][j] + off);
          ps += pv[kt][j];
        }
      lrow[sub] = lrow[sub] * alpha + ps;
#pragma unroll
      for (int kb = 0; kb < 2; ++kb) {
        u32x4 pu = {pack2(pv[2 * kb][0], pv[2 * kb][1]), pack2(pv[2 * kb][2], pv[2 * kb][3]),
                    pack2(pv[2 * kb + 1][0], pv[2 * kb + 1][1]), pack2(pv[2 * kb + 1][2], pv[2 * kb + 1][3])};
        pf[sub][kb] = __builtin_bit_cast(bf16x8, pu);
      }
      if (__builtin_amdgcn_ballot_w64(alpha != 1.f) != 0) {
#pragma unroll
        for (int et = 0; et < 8; ++et) {
          oacc[et][sub][0] *= alpha; oacc[et][sub][1] *= alpha;
          oacc[et][sub][2] *= alpha; oacc[et][sub][3] *= alpha;
        }
      }
    }
    __builtin_amdgcn_s_setprio(1);
#pragma unroll
    for (int et = 0; et < 8; ++et) {
#pragma unroll
      for (int kb = 0; kb < 2; ++kb) {
        const u16* vp = Vs + (et * 16 + l15) * 72 + kb * 32 + quad * 4;
        u32x2 a0 = *(const u32x2*)vp;
        u32x2 a1 = *(const u32x2*)(vp + 16);
        u32x4 cu = {a0.x, a0.y, a1.x, a1.y};
        bf16x8 vb = __builtin_bit_cast(bf16x8, cu);
#pragma unroll
        for (int sub = 0; sub < NSUB; ++sub)
          oacc[et][sub] = __builtin_amdgcn_mfma_f32_16x16x32_bf16(vb, pf[sub][kb], oacc[et][sub], 0, 0, 0);
      }
      if (et & 1) __builtin_amdgcn_sched_barrier(0);
    }
    __builtin_amdgcn_s_setprio(0);
    if (more) {
      if (KDMA) {
        asm volatile("s_waitcnt vmcnt(0)" ::: "memory");
      } else {
#pragma unroll
        for (int i = 0; i < NKC; ++i) {
          int c = tid + i * 256, r = c / (DQK / 8), kc = c % (DQK / 8);
          *(u32x4*)(Ks + r * LDK + ((kc ^ (r & SW)) * 8)) = kreg[i];
        }
      }
    }
    LBAR();
    if (more) {
#pragma unroll
      for (int i = 0; i < 4; ++i) {
        int c = tid + i * 256, r = c >> 3, kc = c & 7;
        *(u32x4*)(Vs + r * 72 + kc * 8) = vreg[i];
      }
    }
  }
#pragma unroll
  for (int sub = 0; sub < NSUB; ++sub) {
    float lt = lrow[sub];
    lt += __shfl_xor(lt, 16);
    lt += __shfl_xor(lt, 32);
    float inv = 1.f / lt;
    if (ML) {
      inv = 1.f;
      if (quad == 0) *(float2*)(ML + (size_t)(q0 + sub * 16 + l15) * 2) = make_float2(mrow[sub], lt);
    }
    u16* orow = O + (size_t)(q0 + sub * 16 + l15) * 128;
#pragma unroll
    for (int et = 0; et < 8; ++et) {
      uint2 o;
      o.x = pack2(oacc[et][sub][0] * inv, oacc[et][sub][1] * inv);
      o.y = pack2(oacc[et][sub][2] * inv, oacc[et][sub][3] * inv);
      *(uint2*)(orow + et * 16 + quad * 4) = o;
    }
  }
}

#define QB2 (128 / ATT_NSUB)
#define SC_CH 16
#define SC_STEPF 336
typedef float f32x2 __attribute__((ext_vector_type(2)));
struct ScStep { f32x2 kk0, kk1, w0, w1, b0, b1, k0, k1, r0, r1; float v; };
__device__ __forceinline__ ScStep sc_ld(const float* sb, int jg4, int vi) {
  ScStep x;
  f32x4 t;
  t = *(const f32x4*)(sb + jg4);       x.kk0 = t.xy; x.kk1 = t.zw;
  t = *(const f32x4*)(sb + 64 + jg4);  x.w0 = t.xy;  x.w1 = t.zw;
  t = *(const f32x4*)(sb + 128 + jg4); x.b0 = t.xy;  x.b1 = t.zw;
  t = *(const f32x4*)(sb + 192 + jg4); x.k0 = t.xy;  x.k1 = t.zw;
  t = *(const f32x4*)(sb + 256 + jg4); x.r0 = t.xy;  x.r1 = t.zw;
  x.v = sb[320 + vi];
  return x;
}
__device__ __forceinline__ void scan_unit(const Params p, int u, char* smem) {
  char* ws = p.ws;
  const int tid = ltid(), lane = tid & 63, w = tid >> 6;
  const int chain = u >> 2, rg = u & 3, n = chain >> 3, h = chain & 7;
  const int jg = lane & 15, rw = lane >> 4;
  float* buf = (float*)smem;
  const float* a0 = (const float*)(ws + OFF_SCKK) + h * 64;
  const float* a1 = (const float*)(ws + OFF_SCW) + (size_t)n * S_ * 512 + h * 64;
  const float* a2 = (const float*)(ws + OFF_SCB) + (size_t)n * S_ * 512 + h * 64;
  const float* a3 = (const float*)(ws + OFF_SCKD) + (size_t)n * S_ * 512 + h * 64;
  const float* a4 = (const float*)(ws + OFF_SCR) + h * 64;
  const float* vsrc = (const float*)(ws + OFF_SCV) + h * 64 + rg * 16;
  float* ydst = (float*)(ws + OFF_YS) + (size_t)n * S_ * 512 + h * 64 + rg * 16 + w * 4 + rw;

  const float* pb[6];
  int pst[6], pf[6];
#pragma unroll
  for (int i = 0; i < 6; ++i) {
    int f = min(tid + i * 256, SC_CH * 84 - 1);
    int st = f / 84, q = f % 84;
    int a = q >> 4;
    const float* base = a == 0 ? a0 : a == 1 ? a1 : a == 2 ? a2 : a == 3 ? a3 : a == 4 ? a4 : vsrc;
    pb[i] = base + (a < 5 ? (q & 15) * 4 : (q - 80) * 4);
    pst[i] = st;
    pf[i] = f * 4;
  }
  const int sdir = n ? -1 : 1, sbase = n ? (S_ - 1) : 0;
  const int nch = S_ / SC_CH;
  unsigned po[6];
#pragma unroll
  for (int i = 0; i < 6; ++i)
    po[i] = (unsigned)((const char*)(pb[i] + (size_t)(sbase + sdir * pst[i]) * 512) - (const char*)ws);
  const unsigned yo = (unsigned)((const char*)(ydst + (size_t)(sbase + sdir * jg) * 512) - (const char*)ws);
  const int cstep = sdir * SC_CH * 512 * 4;
  f32x4 lregA[6], lregB[6];
#define SC_LOAD(R, CH)                                                            \
  {                                                                               \
    const unsigned d_ = (unsigned)(min((CH), nch - 1) * cstep);                   \
    _Pragma("unroll") for (int i = 0; i < 6; ++i)                                 \
      R[i] = *(const f32x4*)((const char*)ws + (unsigned)(po[i] + d_));           \
  }
#define SC_STORE(R, B)                                                \
  _Pragma("unroll") for (int i = 0; i < 6; ++i) *(f32x4*)(buf + (B) * SC_CH * SC_STEPF + pf[i]) = R[i];

  f32x2 sA = {0.f, 0.f}, sB = {0.f, 0.f};
  const int jg4 = jg * 4, vi = w * 4 + rw;
#define SC_COMPUTE(C, B)                                                              \
  {                                                                                   \
    const float* cb = buf + (B) * SC_CH * SC_STEPF;                                   \
    float ykeep = 0.f;                                                                \
    ScStep cur = sc_ld(cb, jg4, vi);                                                  \
    ScStep nx1 = sc_ld(cb + SC_STEPF, jg4, vi);                                       \
    _Pragma("unroll") for (int st = 0; st < SC_CH; ++st) {                            \
      ScStep nx2 = nx1;                                                               \
      if (st + 2 < SC_CH) nx2 = sc_ld(cb + (st + 2) * SC_STEPF, jg4, vi);             \
      f32x2 sa2 = sA * cur.kk0 + sB * cur.kk1;                                        \
      f32x2 vv = {cur.v, cur.v};                                                      \
      f32x2 uA = sA * cur.w0 + vv * cur.k0;                                           \
      f32x2 uB = sB * cur.w1 + vv * cur.k1;                                           \
      float sa = row16_sum(sa2.x + sa2.y);                                            \
      f32x2 nsa = {-sa, -sa};                                                         \
      sA = uA + nsa * cur.b0;                                                         \
      sB = uB + nsa * cur.b1;                                                         \
      f32x2 y2 = sA * cur.r0 + sB * cur.r1;                                           \
      float y = row16_sum(y2.x + y2.y);                                               \
      ykeep = (jg == st) ? y : ykeep;                                                 \
      cur = nx1;                                                                      \
      nx1 = nx2;                                                                      \
    }                                                                                 \
    *(float*)((char*)ws + (unsigned)(yo + (unsigned)((C) * cstep))) = ykeep;          \
  }

  __syncthreads();
  __builtin_amdgcn_s_setprio(3);
  SC_LOAD(lregA, 0);
  SC_STORE(lregA, 0);
  SC_LOAD(lregB, 1);
  __syncthreads();
  for (int c = 0; c < nch; c += 2) {
    SC_LOAD(lregA, c + 2);
    SC_COMPUTE(c, 0);
    SC_STORE(lregB, 1);
    LBAR();
    SC_LOAD(lregB, c + 3);
    SC_COMPUTE(c + 1, 1);
    SC_STORE(lregA, 0);
    LBAR();
  }
  __builtin_amdgcn_s_setprio(0);
}

template <int ATM>
__device__ __forceinline__ void phase_attn_scan(const Params p, int l, char* smem) {
  char* ws = p.ws;
  __shared__ int s_item;
  if (ATM & 8) for (int u = lbid(); u < 64; u += gridDim.x) scan_unit(p, u, smem);
  if ((ATM & 8) && (DUP_MASK & 2)) for (int u = lbid(); u < 64; u += gridDim.x) scan_unit(p, u, smem);
  int* cnt = (int*)(ws + OFF_CNT) + l * 4;
  const int* pos = (const int*)p.in[I_POS];
  const int* kpmm = (const int*)(ws + OFF_KPMM);
  const u16* P = (const u16*)(ws + OFF_P);
  u16* OB = (u16*)(ws + OFF_OB);
#define NEXT_ITEM(CI, LIMIT)                                   \
    __syncthreads();                                           \
    if (ltid() == 0) s_item = atomicAdd(cnt + (CI), 1);   \
    __syncthreads();                                           \
    const int it = s_item;                                     \
    if (it >= (LIMIT)) break;
  u16* OB2 = (u16*)(ws + OFF_OB2);
  float* MLb = (float*)(ws + OFF_ML);
  const int flip = (blockIdx.x >> 8) & 1;
  for (int pass = 0; pass < 2; ++pass) {
  const int which = pass ^ flip;
  if (which == 0) {
  if (ATM & 1) while (true) {
    NEXT_ITEM(0, 512)
    int hh = it >> 6, qb = it & 63, h = hh >> 1, half = hh & 1;
    const int kv0 = half * (S_ / 2);
    attn_item<192, 2>((const u16*)(ws + OFF_QM) + (size_t)h * S_ * 192, 192,
                      (const u16*)(ws + OFF_KM) + ((size_t)h * S_ + kv0) * 192, 192,
                      (const u16*)(ws + OFF_VTM) + (size_t)h * 128 * S_ + kv0, S_, S_ / 2,
                      (half ? OB2 : OB) + (size_t)(8 + h) * S_ * 128, qb, false, nullptr, 0, pos, kpmm, smem, pos,
                      MLb + ((size_t)half * 16 + 8 + h) * S_ * 2);
  }
  } else {
  if (ATM & 2) while (true) {
    NEXT_ITEM(1, 16 * QB2)
    int pp = it / QB2, qb = it % QB2, pr = pp >> 1, half = pp & 1, h = pr >> 1, hf = pr & 1;
    const int kv0 = half * (S_ / 2);
    attn_item<64, ATT_NSUB>(P + O_DQ + h * 128 + hf * 64, NINP, P + (size_t)kv0 * NINP + O_DK + h * 128 + hf * 64, NINP,
                            (const u16*)(ws + OFF_VTD) + (size_t)h * 128 * S_ + kv0, S_, S_ / 2,
                            (half ? OB2 : OB) + (size_t)pr * S_ * 128, qb, true, (const float*)p.in[I_RELB], h, pos,
                            kpmm + (kv0 / 64) * 2, smem, pos + kv0, MLb + ((size_t)half * 16 + pr) * S_ * 2);
  }
  }
  }
  if (ATM & 4) while (true) {
    NEXT_ITEM(2, 4 * QB2)
    int h = it / QB2, qb = it % QB2;
    attn_item<128, ATT_NSUB>(P + O_MQ + h * 128, NINP, (const u16*)(ws + OFF_KMEM) + (size_t)(l * 4 + h) * 256 * 128, 128,
                             (const u16*)(ws + OFF_VTMEM) + (size_t)(l * 4 + h) * 128 * 256, 256, 256,
                             OB + (size_t)(12 + h) * S_ * 128, qb, false, nullptr, 0, pos, kpmm, smem, pos, nullptr);
  }
}

__device__ __forceinline__ void phase_combine(const Params p, int l, char* smem) {
  char* ws = p.ws;
  const int lane = ltid() & 63, w = ltid() >> 6;
  const float lam_init = 0.8f - 0.6f * expf(-0.3f * (float)l);
  float lam;
  {
    const float* lq = (const float*)p.in[I_DLAM] + l * 256;
    float a = wave_sum(lq[lane] * lq[64 + lane]);
    float b = wave_sum(lq[128 + lane] * lq[192 + lane]);
    lam = expf(a) - expf(b) + lam_init;
  }
  const float* gng = (const float*)p.in[I_GNG] + l * 512;
  const float* gnb = (const float*)p.in[I_GNB] + l * 512;
  const float* subg = (const float*)p.in[I_DSUBG] + l * 128;
  const u16* P = (const u16*)(ws + OFF_P);
  const float* YS = (const float*)(ws + OFF_YS);
  const u16* OB = (const u16*)(ws + OFF_OB);
  const u16* OB2c = (const u16*)(ws + OFF_OB2);
  const float* MLp = (const float*)(ws + OFF_ML);
  u16* YG = (u16*)(ws + OFF_YG);
  for (int s = lbid() * 4 + w; s < S_; s += gridDim.x * 4) {
    const u16* grow = P + (size_t)s * NINP + O_G;
#pragma unroll
    for (int hp = 0; hp < 4; ++hp) {
      const int c = hp * 128 + 2 * lane, h = hp * 2 + (lane >> 5);
      const float2 ya = *(const float2*)(YS + (size_t)s * 512 + c);
      const float2 yb = *(const float2*)(YS + ((size_t)S_ + s) * 512 + c);
      float y0 = ya.x + yb.x, y1 = ya.y + yb.y;
      float sm = y0 + y1;
#pragma unroll
      for (int o = 16; o >= 1; o >>= 1) sm += __shfl_xor(sm, o);
      const float mu = sm * (1.f / 64);
      const float d0 = y0 - mu, d1 = y1 - mu;
      float vs = d0 * d0 + d1 * d1;
#pragma unroll
      for (int o = 16; o >= 1; o >>= 1) vs += __shfl_xor(vs, o);
      const float rstd = rsqrtf(vs * (1.f / 64) + 64e-5f);
      const float2 gg = *(const float2*)(gng + c), gb = *(const float2*)(gnb + c);
      const float bon = ((const float*)(ws + OFF_BONUS))[s * 8 + h];
      const float2 vv = *(const float2*)((const float*)(ws + OFF_SCV) + (size_t)s * 512 + c);
      float o0 = d0 * rstd * gg.x + gb.x + bon * vv.x;
      float o1 = d1 * rstd * gg.y + gb.y + bon * vv.y;
      const unsigned gt = *(const unsigned*)(grow + c);
      const float g0 = lo2f(gt), g1 = hi2f(gt);
      *(unsigned*)(YG + (size_t)s * 512 + c) = pack2(o0 * g0 * sigmoidf_(g0), o1 * g1 * sigmoidf_(g1));
    }
#define MERGE_LOAD(PR, A, B)                                                                   \
    {                                                                                          \
      const float2 ml0 = *(const float2*)(MLp + ((size_t)(PR) * S_ + s) * 2);                  \
      const float2 ml1 = *(const float2*)(MLp + ((size_t)(16 + (PR)) * S_ + s) * 2);           \
      const float mm = fmaxf(ml0.x, ml1.x);                                                    \
      const float w0 = __builtin_amdgcn_exp2f(ml0.x - mm), w1 = __builtin_amdgcn_exp2f(ml1.x - mm); \
      const float inv = 1.f / (w0 * ml0.y + w1 * ml1.y);                                       \
      const unsigned q0 = *(const unsigned*)(OB + ((size_t)(PR) * S_ + s) * 128 + 2 * lane);   \
      const unsigned q1 = *(const unsigned*)(OB2c + ((size_t)(PR) * S_ + s) * 128 + 2 * lane); \
      A = (w0 * lo2f(q0) + w1 * lo2f(q1)) * inv;                                               \
      B = (w0 * hi2f(q0) + w1 * hi2f(q1)) * inv;                                               \
    }
#pragma unroll
    for (int h = 0; h < 4; ++h) {
      float a1, b1, a2, b2;
      MERGE_LOAD(h * 2, a1, b1)
      MERGE_LOAD(h * 2 + 1, a2, b2)
      float a = a1 - lam * a2, b = b1 - lam * b2;
      float ss = wave_sum(a * a + b * b);
      float rs = rsqrtf(ss * (1.f / 128) + 1e-6f) * (1.f - lam_init);
      const unsigned gg = *(const unsigned*)(grow + 512 + h * 128 + 2 * lane);
      float g0 = lo2f(gg), g1 = hi2f(gg);
      const float2 sg = *(const float2*)(subg + 2 * lane);
      u16* dst = YG + ((size_t)S_ + s) * 512 + h * 128;
      *(unsigned*)(dst + 2 * lane) = pack2(a * rs * sg.x * g0 * sigmoidf_(g0), b * rs * sg.y * g1 * sigmoidf_(g1));
    }
#pragma unroll
    for (int br = 2; br < 4; ++br) {
#pragma unroll
      for (int h = 0; h < 4; ++h) {
        float oa, ob;
        if (br == 2) {
          MERGE_LOAD(8 + h, oa, ob)
        } else {
          const unsigned o = *(const unsigned*)(OB + ((size_t)(12 + h) * S_ + s) * 128 + 2 * lane);
          oa = lo2f(o);
          ob = hi2f(o);
        }
        const unsigned gg = *(const unsigned*)(grow + br * 512 + h * 128 + 2 * lane);
        float g0 = lo2f(gg), g1 = hi2f(gg);
        u16* dst = YG + ((size_t)br * S_ + s) * 512 + h * 128;
        *(unsigned*)(dst + 2 * lane) = pack2(oa * g0 * sigmoidf_(g0), ob * g1 * sigmoidf_(g1));
      }
    }
#undef MERGE_LOAD
  }
}

#define XB_TMO      128
#define XB_XCNT(j)  (256  + 64 * (j))
#define XB_XSUB(j)  (1280 + 64 * (j))
#define XB_XGEN(j)  (2304 + 64 * (j))
#define XB_TOP      3328
#define XB_TOPGEN   3392
#define XCD_BAR_WORDS 3456
#define XB_SPIN_CAP (1u << 22)
#define LAS __attribute__((address_space(3)))
__device__ __forceinline__ unsigned xb_ld(unsigned* p)              { return __hip_atomic_load(p, __ATOMIC_RELAXED, __HIP_MEMORY_SCOPE_AGENT); }
__device__ __forceinline__ unsigned xb_add(unsigned* p, unsigned v) { return __hip_atomic_fetch_add(p, v, __ATOMIC_RELAXED, __HIP_MEMORY_SCOPE_AGENT); }
__device__ __forceinline__ unsigned xb_xcc_id() { return (unsigned)__builtin_amdgcn_s_getreg((3 << 11) | 20) & 0xFu; }
#define XB_SPIN(cond, bar) do { unsigned _sp = 0; while (cond) { __builtin_amdgcn_s_sleep(1); \
    if ((++_sp & 255u) == 0u) { if (xb_ld(&(bar)[XB_TMO])) break; if (_sp > XB_SPIN_CAP) { atomicAdd(&(bar)[XB_TMO], 1u); break; } } } } while (0)
struct XcdBarrier { unsigned* bar; unsigned x; volatile LAS unsigned* st; };
__device__ __forceinline__ XcdBarrier xcd_barrier_post(unsigned* bar, volatile LAS unsigned* st) {
  XcdBarrier b; b.bar = bar; b.x = xb_xcc_id(); b.st = st;
  if (threadIdx.x == 0) (void)xb_add(&bar[XB_XCNT(b.x)], 1u);
  return b;
}
__device__ __forceinline__ void xcd_barrier_complete(unsigned* bar, unsigned x, unsigned& nloc, unsigned& nx) {
  const unsigned G = gridDim.x * gridDim.y * gridDim.z;
  unsigned sum, cnt, mine, sp = 0u;
  for (;;) {
    sum = 0u; cnt = 0u; mine = 0u;
#pragma unroll
    for (unsigned j = 0; j < 16; ++j) { const unsigned c = xb_ld(&bar[XB_XCNT(j)]); sum += c; cnt += (c > 0u) ? 1u : 0u; mine = (j == x) ? c : mine; }
    if (sum == G) break;
    __builtin_amdgcn_s_sleep(1);
    if ((++sp & 255u) == 0u) { if (xb_ld(&bar[XB_TMO])) break; if (sp > XB_SPIN_CAP) { atomicAdd(&bar[XB_TMO], 1u); break; } }
  }
  nloc = mine > 0u ? mine : 1u; nx = cnt > 0u ? cnt : 1u;
}
__device__ __forceinline__ void xcd_barrier(const XcdBarrier& b) {
  asm volatile("s_waitcnt vmcnt(0)" ::: "memory");
  __syncthreads();
  if (threadIdx.x == 0) {
    unsigned* bar = b.bar;
    __builtin_amdgcn_s_waitcnt(0);
    unsigned nloc = b.st[0], nx = b.st[1];
    if (nloc == 0u) { xcd_barrier_complete(bar, b.x, nloc, nx); b.st[0] = nloc; b.st[1] = nx; }
    const unsigned old = xb_add(&bar[XB_XSUB(b.x)], 1u);
    const unsigned gen = old / nloc;
    if (old + 1u == (gen + 1u) * nloc) {
      __builtin_amdgcn_fence(__ATOMIC_RELEASE, "agent");
      asm volatile("s_waitcnt vmcnt(0)" ::: "memory");
      const unsigned og = xb_add(&bar[XB_TOP], 1u);
      const unsigned tg = og / nx;
      if (og + 1u == (tg + 1u) * nx) xb_add(&bar[XB_TOPGEN], 1u);
      else XB_SPIN(xb_ld(&bar[XB_TOPGEN]) == tg, bar);
      __builtin_amdgcn_fence(__ATOMIC_ACQUIRE, "agent");
      xb_add(&bar[XB_XGEN(b.x)], 1u);
      asm volatile("s_waitcnt vmcnt(0)" ::: "memory");
    } else {
      XB_SPIN(xb_ld(&bar[XB_XGEN(b.x)]) == gen, bar);
      __builtin_amdgcn_fence(__ATOMIC_ACQUIRE, "agent");
      asm volatile("s_waitcnt vmcnt(0)" ::: "memory");
    }
  }
  __syncthreads();
}

#define N_PHASES (1 + 9 * L_)

__global__ void __launch_bounds__(256, 2) mega(Params p, int ph_lo, int ph_hi) {
  __shared__ __attribute__((aligned(16))) char smem[SMEM_BYTES];
  cg::grid_group grid = cg::this_grid();
  __shared__ uint4 xb_words;
  if (threadIdx.x == 0) xb_words = make_uint4(0u, 0u, 0u, 0u);
  __syncthreads();
  XcdBarrier xb = xcd_barrier_post((unsigned*)(p.ws + OFF_BAR), (volatile LAS unsigned*)&xb_words);
  __shared__ int s_vbid, s_cand;
  if (threadIdx.x == 0) {
    int my_j = (int)xb_add((unsigned*)(p.ws + OFF_BAR) + 8 * xb.x, 1u);
    s_cand = my_j * 8 + (int)xb.x;
    s_vbid = blockIdx.x;
  }
#define VB s_vbid
  for (int ph = ph_lo; ph < ph_hi; ++ph) {
    if (ph == 0) {
      if (PH_MASK & 1) phase_w(p, smem);
    } else {
      int l = (ph - 1) / 9, sp = (ph - 1) % 9;
      switch (sp) {
        case 0: if (PH_MASK & 2) phase_gemm_in(p, l, smem, VB);
          if (DUP_MASK & 1) { __syncthreads(); phase_gemm_in(p, l, smem, VB); }
          break;
        case 1: if (PH_MASK & 4) phase_prep<false>(p, l, smem);
          if (DUP_MASK & 256) { __syncthreads(); phase_prep<true>(p, l, smem); }
          break;
        case 2: if (PH_MASK & 8) phase_gemm_mla(p, l, smem, VB);
          if (DUP_MASK & 16) { __syncthreads(); phase_gemm_mla(p, l, smem, VB); }
          break;
        case 3: if (PH_MASK & 16) phase_mla_post(p, l, smem);
          if (DUP_MASK & 32) { __syncthreads(); phase_mla_post(p, l, smem); }
          break;
        case 4: if (PH_MASK & 32) phase_attn_scan<AT_MASK>(p, l, smem); break;
        case 5: if (PH_MASK & 64) phase_combine(p, l, smem);
          if (DUP_MASK & 64) { __syncthreads(); phase_combine(p, l, smem); }
          break;
        case 6: if (PH_MASK & 128) phase_gemm_branch(p, l, smem, VB);
          if (DUP_MASK & 4) { __syncthreads(); phase_gemm_branch(p, l, smem, VB); }
          break;
        case 7: if (PH_MASK & 256) phase_gemm_out(p, l, smem, VB); break;
        case 8:
          if (l + 1 < L_) rms_rows<true>((const float*)p.out, S_, (const float*)p.in[I_NORMG] + (l + 1) * D_, (u16*)(p.ws + OFF_H));
          if ((DUP_MASK & 128) && l + 1 < L_) rms_rows<true>((const float*)p.out, S_, (const float*)p.in[I_NORMG] + (l + 1) * D_, (u16*)(p.ws + OFF_H));
          break;
      }
    }
#undef VB
    if (ph + 1 < ph_hi) {
      if (ph == ph_lo) {
        if (ph_hi < 0) grid.sync();
        xcd_barrier(xb);
        if (threadIdx.x == 0 && gridDim.x == 512) {
          bool ok = true;
          for (int j = 0; j < 8; ++j) ok = ok && (xb_ld((unsigned*)(p.ws + OFF_BAR) + 8 * j) == 64u);
          if (ok && xb.x < 8u) s_vbid = s_cand;
        }
        __syncthreads();
      } else xcd_barrier(xb);
    }
  }
}

template <int SP, int ATM>
__global__ void __launch_bounds__(256, 2) k_phase(Params p, int l) {
  __shared__ __attribute__((aligned(16))) char smem[SMEM_BYTES];
  const int VB = blockIdx.x;
  if (SP == -1) phase_w(p, smem);
  if (SP == 0) phase_gemm_in(p, l, smem, VB);
  if (SP == 1) phase_prep<false>(p, l, smem);
  if (SP == 2) phase_gemm_mla(p, l, smem, VB);
  if (SP == 3) phase_mla_post(p, l, smem);
  if (SP == 4) phase_attn_scan<ATM>(p, l, smem);
  if (SP == 5) phase_combine(p, l, smem);
  if (SP == 6) phase_gemm_branch(p, l, smem, VB);
  if (SP == 7) phase_gemm_out(p, l, smem, VB);
  if (SP == 8) rms_rows<true>((const float*)p.out, S_, (const float*)p.in[I_NORMG] + (l + 1) * D_, (u16*)(p.ws + OFF_H));
}

extern "C" void kernel_launch(void* const* d_in, const int* in_sizes, int n_in, void* d_out, int out_size, void* d_ws,
                              size_t ws_size, hipStream_t stream) {
  static int grid_blocks = 0;
  if (!grid_blocks) {
    int dev = 0, cus = 0, per_cu = 0;
    hipGetDevice(&dev);
    hipDeviceGetAttribute(&cus, hipDeviceAttributeMultiprocessorCount, dev);
    hipOccupancyMaxActiveBlocksPerMultiprocessor(&per_cu, mega, 256, 0);
    if (per_cu > 2) per_cu = 2;
    if (per_cu < 1) per_cu = 1;
    grid_blocks = cus * per_cu;
  }
  Params p{};
  for (int i = 0; i < N_INPUTS; ++i) p.in[i] = d_in[i];
  p.out = (float*)d_out;
  p.ws = (char*)d_ws;
  if (ws_size < WS_TOTAL) fprintf(stderr, "workspace too small: %zu < %zu\n", ws_size, (size_t)WS_TOTAL);
#if MULTI_LAUNCH
  const int G = grid_blocks;
  hipLaunchKernelGGL((k_phase<-1, 0>), dim3(G), dim3(256), 0, stream, p, 0);
  for (int l = 0; l < L_; ++l) {
    hipLaunchKernelGGL((k_phase<0, 0>), dim3(G), dim3(256), 0, stream, p, l);
    hipLaunchKernelGGL((k_phase<1, 0>), dim3(G), dim3(256), 0, stream, p, l);
    hipLaunchKernelGGL((k_phase<2, 0>), dim3(G), dim3(256), 0, stream, p, l);
    hipLaunchKernelGGL((k_phase<3, 0>), dim3(G), dim3(256), 0, stream, p, l);
    hipLaunchKernelGGL((k_phase<4, 8>), dim3(64), dim3(256), 0, stream, p, l);
    hipLaunchKernelGGL((k_phase<4, 1>), dim3(G), dim3(256), 0, stream, p, l);
    hipLaunchKernelGGL((k_phase<4, 2>), dim3(G), dim3(256), 0, stream, p, l);
    hipLaunchKernelGGL((k_phase<4, 4>), dim3(G), dim3(256), 0, stream, p, l);
    hipLaunchKernelGGL((k_phase<5, 0>), dim3(G), dim3(256), 0, stream, p, l);
    hipLaunchKernelGGL((k_phase<6, 0>), dim3(G), dim3(256), 0, stream, p, l);
    hipLaunchKernelGGL((k_phase<7, 0>), dim3(G), dim3(256), 0, stream, p, l);
    if (l + 1 < L_) hipLaunchKernelGGL((k_phase<8, 0>), dim3(G), dim3(256), 0, stream, p, l);
  }
#else
  hipMemsetAsync((char*)d_ws + OFF_BAR, 0, 3456 * 4, stream);
  int lo = 0, hi = N_PHASES - 1;
  void* args[] = {&p, &lo, &hi};
  hipError_t e = hipLaunchCooperativeKernel((void*)mega, dim3(grid_blocks), dim3(256), args, 0, stream);
  if (e != hipSuccess) fprintf(stderr, "cooperative launch failed: %s (grid %d)\n", hipGetErrorString(e), grid_blocks);
#endif
}
```

```cpp
#include <hip/hip_runtime.h>
#include <hip/hip_cooperative_groups.h>
#include <cstdio>
namespace cg = cooperative_groups;

typedef unsigned short u16;
typedef __attribute__((ext_vector_type(8))) short bf16x8;
typedef __attribute__((ext_vector_type(4))) float f32x4;
typedef __attribute__((ext_vector_type(4))) unsigned int u32x4;
typedef __attribute__((ext_vector_type(2))) unsigned int u32x2;

#ifndef MULTI_LAUNCH
#define MULTI_LAUNCH 0
#endif
#ifndef DUP_MASK
#define DUP_MASK 0
#endif
#ifndef ATT_NSUB
#define ATT_NSUB 2
#endif
#ifndef AT_MASK
#define AT_MASK 15
#endif
#ifndef PH_MASK
#if MULTI_LAUNCH
#define PH_MASK 0
#else
#define PH_MASK 0xffff
#endif
#endif


#define LOG2E 1.4426950408889634f
#define S_ 8192
#define D_ 2048
#define NIN 14784
#define NINP 14848
#define L_ 4
#define O_DQ 1792
#define O_DK 2304
#define O_DV 2816
#define O_QL 3328
#define O_KVL 3712
#define O_KR 3968
#define O_MQ 4032
#define O_G 4544
#define O_MG 6592

enum { I_X = 0, I_MEM, I_POS, I_NORMG, I_WIN, I_SHIFT, I_W0, I_WUP, I_A0, I_AUP, I_KK, I_KA, I_RK, I_GNG, I_GNB,
       I_DQKG, I_DLAM, I_DSUBG, I_RELB, I_QLATG, I_KVLATG, I_WUQ, I_WUKV, I_NOPEG, I_ROPEG, I_MEMNG, I_WKV,
       I_MQKG, I_WBR, I_WOUT, N_INPUTS };

struct Params {
  const void* in[N_INPUTS];
  float* out;
  char* ws;
};

constexpr size_t al(size_t x) { return (x + 255) & ~(size_t)255; }
constexpr size_t OFF_WIN = 0;
constexpr size_t OFF_WB = OFF_WIN + al((size_t)L_ * NINP * D_ * 2);
constexpr size_t OFF_WO = OFF_WB + al((size_t)L_ * 4 * 2048 * 512 * 2);
constexpr size_t OFF_WUQ = OFF_WO + al((size_t)L_ * 2048 * 2048 * 2);
constexpr size_t OFF_WUKV = OFF_WUQ + al((size_t)L_ * 768 * 384 * 2);
constexpr size_t OFF_WKV = OFF_WUKV + al((size_t)L_ * 1024 * 256 * 2);
constexpr size_t OFF_MEMN = OFF_WKV + al((size_t)L_ * 1024 * 2048 * 2);
constexpr size_t OFF_KVMEM = OFF_MEMN + al((size_t)L_ * 256 * 2048 * 2);
constexpr size_t OFF_KMEM = OFF_KVMEM + al((size_t)L_ * 256 * 512 * 4);
constexpr size_t OFF_VTMEM = OFF_KMEM + al((size_t)L_ * 4 * 256 * 128 * 2);
constexpr size_t OFF_H = OFF_VTMEM + al((size_t)L_ * 4 * 128 * 256 * 2);
constexpr size_t OFF_P = OFF_H + al((size_t)S_ * D_ * 2);
constexpr size_t OFF_RWU = OFF_P + al((size_t)S_ * NINP * 2);
constexpr size_t OFF_SCR = OFF_RWU + al((size_t)S_ * 1792 * 4);
constexpr size_t OFF_SCV = OFF_SCR + al((size_t)S_ * 512 * 4);
constexpr size_t OFF_SCKK = OFF_SCV + al((size_t)S_ * 512 * 4);
constexpr size_t OFF_SCW = OFF_SCKK + al((size_t)S_ * 512 * 4);
constexpr size_t OFF_SCKD = OFF_SCW + al((size_t)2 * S_ * 512 * 4);
constexpr size_t OFF_SCB = OFF_SCKD + al((size_t)2 * S_ * 512 * 4);
constexpr size_t OFF_BONUS = OFF_SCB + al((size_t)2 * S_ * 512 * 4);
constexpr size_t OFF_YS = OFF_BONUS + al((size_t)S_ * 8 * 4);
constexpr size_t OFF_MQ = OFF_YS + al((size_t)2 * S_ * 512 * 4);
constexpr size_t OFF_MKV = OFF_MQ + al((size_t)S_ * 768 * 4);
constexpr size_t OFF_QM = OFF_MKV + al((size_t)S_ * 512 * 4);
constexpr size_t OFF_KM = OFF_QM + al((size_t)4 * S_ * 192 * 2);
constexpr size_t OFF_VTM = OFF_KM + al((size_t)4 * S_ * 192 * 2);
constexpr size_t OFF_VTD = OFF_VTM + al((size_t)4 * 128 * S_ * 2);
constexpr size_t OFF_OB = OFF_VTD + al((size_t)4 * 128 * S_ * 2);
constexpr size_t OFF_YG = OFF_OB + al((size_t)16 * S_ * 128 * 4);
constexpr size_t OFF_Z = OFF_YG + al((size_t)4 * S_ * 512 * 2);
constexpr size_t OFF_CNT = OFF_Z + al((size_t)S_ * D_ * 2);
constexpr size_t OFF_KPMM = OFF_CNT + 256;
constexpr size_t OFF_BAR = OFF_KPMM + 1024;
constexpr size_t OFF_OB2 = OFF_BAR + al(3456 * 4);
constexpr size_t OFF_ML = OFF_OB2 + al((size_t)16 * S_ * 128 * 4);
constexpr size_t WS_TOTAL = OFF_ML + (size_t)2 * 16 * S_ * 2 * 4;

#define SMEM_BYTES 49152

#define LBAR() asm volatile("s_waitcnt lgkmcnt(0)\n\ts_barrier" ::: "memory")
__device__ __forceinline__ int ltid() {
  int t = __builtin_amdgcn_workitem_id_x();
  asm volatile("" : "+v"(t));
  return t;
}
__device__ __forceinline__ int lbid() {
  int t = __builtin_amdgcn_workgroup_id_x();
  asm volatile("" : "+s"(t));
  return t;
}
typedef float f32x2_ __attribute__((ext_vector_type(2)));
typedef __bf16 bf16x2_ __attribute__((ext_vector_type(2)));
__device__ __forceinline__ unsigned pack2(float a, float b) {
  f32x2_ v = {a, b};
  return __builtin_bit_cast(unsigned, __builtin_convertvector(v, bf16x2_));
}
__device__ __forceinline__ u16 f2bf(float f) { return (u16)(pack2(f, 0.f) & 0xffffu); }
__device__ __forceinline__ float bf2f(u16 h) { return __uint_as_float(((unsigned)h) << 16); }
__device__ __forceinline__ float lo2f(unsigned u) { return __uint_as_float(u << 16); }
__device__ __forceinline__ float hi2f(unsigned u) { return __uint_as_float(u & 0xffff0000u); }
__device__ __forceinline__ float sigmoidf_(float x) {
  return __builtin_amdgcn_rcpf(1.f + __builtin_amdgcn_exp2f(-1.4426950408889634f * x));
}
__device__ __forceinline__ float wave_sum(float v) {
#pragma unroll
  for (int o = 32; o >= 1; o >>= 1) v += __shfl_xor(v, o);
  return v;
}
template <int CTRL>
__device__ __forceinline__ float dpp_add(float x) {
  return x + __int_as_float(__builtin_amdgcn_update_dpp(0, __float_as_int(x), CTRL, 0xf, 0xf, true));
}
__device__ __forceinline__ float row16_sum(float x) {
  x = dpp_add<0xB1>(x);
  x = dpp_add<0x4E>(x);
  x = dpp_add<0x141>(x);
  x = dpp_add<0x140>(x);
  return x;
}

template <bool SW>
__device__ __forceinline__ void gemm_main1(const u16* __restrict__ A, int lda, const u16* __restrict__ B, int ldb,
                                          int K, u16* As, u16* Bs, f32x4 (&acc)[4][4]) {
  const int tid = ltid(), lane = tid & 63, w = tid >> 6, l15 = lane & 15, quad = lane >> 4;
  const int wm = w >> 1, wn = w & 1;
  u32x4 ra[4], rb[4];
#pragma unroll
  for (int i = 0; i < 4; ++i) {
    int c = tid + i * 256, r = c >> 3, kc = c & 7;
    ra[i] = *(const u32x4*)(A + (size_t)r * lda + kc * 8);
    rb[i] = *(const u32x4*)(B + (size_t)r * ldb + kc * 8);
  }
  for (int k0 = 0; k0 < K; k0 += 64) {
    LBAR();
#pragma unroll
    for (int i = 0; i < 4; ++i) {
      int c = tid + i * 256, r = c >> 3, kc = c & 7;
      *(u32x4*)(As + r * 64 + ((kc ^ (r & 7)) * 8)) = ra[i];
      *(u32x4*)(Bs + r * 64 + ((kc ^ (r & 7)) * 8)) = rb[i];
    }
    LBAR();
    {
      const int kn = min(k0 + 64, K - 64);
#pragma unroll
      for (int i = 0; i < 4; ++i) {
        int c = tid + i * 256, r = c >> 3, kc = c & 7;
        ra[i] = *(const u32x4*)(A + (size_t)r * lda + kn + kc * 8);
        rb[i] = *(const u32x4*)(B + (size_t)r * ldb + kn + kc * 8);
      }
    }
#pragma unroll
    for (int ks = 0; ks < 2; ++ks) {
      bf16x8 af[4], bfr[4];
#pragma unroll
      for (int i = 0; i < 4; ++i) {
        af[i] = *(const bf16x8*)(As + (wm * 64 + i * 16 + l15) * 64 + (((ks * 4 + quad) ^ (l15 & 7)) * 8));
        bfr[i] = *(const bf16x8*)(Bs + (wn * 64 + i * 16 + l15) * 64 + (((ks * 4 + quad) ^ (l15 & 7)) * 8));
      }
#pragma unroll
      for (int i = 0; i < 4; ++i)
#pragma unroll
        for (int j = 0; j < 4; ++j) acc[i][j] = SW ? __builtin_amdgcn_mfma_f32_16x16x32_bf16(bfr[j], af[i], acc[i][j], 0, 0, 0)
                                                     : __builtin_amdgcn_mfma_f32_16x16x32_bf16(af[i], bfr[j], acc[i][j], 0, 0, 0);
    }
  }
}

template <bool SW>
__device__ __forceinline__ void gemm_main(const u16* __restrict__ A, int lda, const u16* __restrict__ B, int ldb,
                                          int K, u16* As, u16* Bs, f32x4 (&acc)[4][4]) {
  const int tid = ltid(), lane = tid & 63, w = tid >> 6, l15 = lane & 15, quad = lane >> 4;
  const int wm = w >> 1, wn = w & 1;
  u32x4 ra0[4], rb0[4], ra1[4], rb1[4];
  const u16* Ap = A + (size_t)(tid >> 3) * lda + (tid & 7) * 8;
  const u16* Bp = B + (size_t)(tid >> 3) * ldb + (tid & 7) * 8;
  const size_t sa = (size_t)32 * lda, sb = (size_t)32 * ldb;
#define G_LOAD(RA, RB, KK)                                            \
  {                                                                   \
    const int kk_ = min((KK), K - 64);                                \
    _Pragma("unroll") for (int i = 0; i < 4; ++i) {                   \
      RA[i] = *(const u32x4*)(Ap + i * sa + kk_);                     \
      RB[i] = *(const u32x4*)(Bp + i * sb + kk_);                     \
    }                                                                 \
  }
#define G_STAGE(RA, RB, KNEXT)                                                                   \
  {                                                                                              \
    LBAR();                                                                             \
    _Pragma("unroll") for (int i = 0; i < 4; ++i) {                                              \
      *(u32x4*)(As + ((tid >> 3) + i * 32) * 64 + (((tid & 7) ^ ((tid >> 3) & 7)) * 8)) = RA[i]; \
      *(u32x4*)(Bs + ((tid >> 3) + i * 32) * 64 + (((tid & 7) ^ ((tid >> 3) & 7)) * 8)) = RB[i]; \
    }                                                                                            \
    LBAR();                                                                             \
    G_LOAD(RA, RB, KNEXT)                                                                        \
    {                                                                                            \
      bf16x8 af[2][4], bfr[2][4];                                                                \
      _Pragma("unroll") for (int ks = 0; ks < 2; ++ks)                                           \
        _Pragma("unroll") for (int i = 0; i < 4; ++i) {                                          \
          af[ks][i] = *(const bf16x8*)(As + (wm * 64 + i * 16 + l15) * 64 + (((ks * 4 + quad) ^ (l15 & 7)) * 8));  \
          bfr[ks][i] = *(const bf16x8*)(Bs + (wn * 64 + i * 16 + l15) * 64 + (((ks * 4 + quad) ^ (l15 & 7)) * 8)); \
        }                                                                                        \
      __builtin_amdgcn_sched_barrier(0);                                                         \
      _Pragma("unroll") for (int ks = 0; ks < 2; ++ks)                                           \
        _Pragma("unroll") for (int i = 0; i < 4; ++i)                                            \
          _Pragma("unroll") for (int j = 0; j < 4; ++j)                                          \
            acc[i][j] = SW ? __builtin_amdgcn_mfma_f32_16x16x32_bf16(bfr[ks][j], af[ks][i], acc[i][j], 0, 0, 0) \
                           : __builtin_amdgcn_mfma_f32_16x16x32_bf16(af[ks][i], bfr[ks][j], acc[i][j], 0, 0, 0); \
    }                                                                                            \
  }
  G_LOAD(ra0, rb0, 0)
  G_LOAD(ra1, rb1, 64)
  for (int k0 = 0; k0 < K; k0 += 128) {
    G_STAGE(ra0, rb0, k0 + 128)
    G_STAGE(ra1, rb1, k0 + 192)
  }
#undef G_LOAD
#undef G_STAGE
}

__device__ __forceinline__ void gemm_main_blk(const u16* __restrict__ A, const u16* __restrict__ B,
                                          int K, u16* As, u16* Bs, f32x4 (&acc)[4][4]) {
  const int tid = ltid(), lane = tid & 63, w = tid >> 6, l15 = lane & 15, quad = lane >> 4;
  const int wm = w >> 1, wn = w & 1;
  u32x4 ra0[4], rb0[4], ra1[4], rb1[4];
  const u16* Ap = A + tid * 8;
  const u16* Bp = B + tid * 8;
#define G_LOAD(RA, RB, KK)                                            \
  {                                                                   \
    const int kk_ = min((KK), K - 64);                                \
    _Pragma("unroll") for (int i = 0; i < 4; ++i) {                   \
      RA[i] = *(const u32x4*)(Ap + (size_t)kk_ * 128 + i * 2048);    \
      RB[i] = *(const u32x4*)(Bp + (size_t)kk_ * 128 + i * 2048);    \
    }                                                                 \
  }
#define G_STAGE(RA, RB, KNEXT)                                                                   \
  {                                                                                              \
    LBAR();                                                                             \
    _Pragma("unroll") for (int i = 0; i < 4; ++i) {                                              \
      *(u32x4*)(As + i * 2048 + tid * 8) = RA[i];                                                \
      *(u32x4*)(Bs + i * 2048 + tid * 8) = RB[i];                                                \
    }                                                                                            \
    LBAR();                                                                             \
    G_LOAD(RA, RB, KNEXT)                                                                        \
    {                                                                                            \
      bf16x8 af[2][4], bfr[2][4];                                                                \
      _Pragma("unroll") for (int ks = 0; ks < 2; ++ks)                                           \
        _Pragma("unroll") for (int i = 0; i < 4; ++i) {                                          \
          af[ks][i] = *(const bf16x8*)(As + (wm * 64 + i * 16 + l15) * 64 + (((ks * 4 + quad) ^ (l15 & 7)) * 8));  \
          bfr[ks][i] = *(const bf16x8*)(Bs + (wn * 64 + i * 16 + l15) * 64 + (((ks * 4 + quad) ^ (l15 & 7)) * 8)); \
        }                                                                                        \
      __builtin_amdgcn_sched_barrier(0);                                                         \
      _Pragma("unroll") for (int ks = 0; ks < 2; ++ks)                                           \
        _Pragma("unroll") for (int i = 0; i < 4; ++i)                                            \
          _Pragma("unroll") for (int j = 0; j < 4; ++j)                                          \
            acc[i][j] = __builtin_amdgcn_mfma_f32_16x16x32_bf16(af[ks][i], bfr[ks][j], acc[i][j], 0, 0, 0); \
    }                                                                                            \
  }
  G_LOAD(ra0, rb0, 0)
  G_LOAD(ra1, rb1, 64)
  for (int k0 = 0; k0 < K; k0 += 128) {
    G_STAGE(ra0, rb0, k0 + 128)
    G_STAGE(ra1, rb1, k0 + 192)
  }
#undef G_LOAD
#undef G_STAGE
}

#define ZERO_ACC(acc)                                  \
  _Pragma("unroll") for (int i_ = 0; i_ < 4; ++i_)     \
  _Pragma("unroll") for (int j_ = 0; j_ < 4; ++j_) acc[i_][j_] = (f32x4){0.f, 0.f, 0.f, 0.f};

#define EPI_LOOP_T(BODY)                                                           \
  {                                                                                \
    const int lane_ = ltid() & 63, w_ = ltid() >> 6;                               \
    const int l15_ = lane_ & 15, quad_ = lane_ >> 4, wm_ = w_ >> 1, wn_ = w_ & 1;  \
    _Pragma("unroll") for (int i = 0; i < 4; ++i) {                                \
      _Pragma("unroll") for (int j = 0; j < 4; ++j) {                              \
        const int mr = wm_ * 64 + i * 16 + l15_;                                   \
        const int nc = wn_ * 64 + j * 16 + quad_ * 4;                              \
        BODY                                                                       \
      }                                                                            \
    }                                                                              \
  }

#define EPI_LOOP(BODY)                                                             \
  {                                                                                \
    const int lane_ = ltid() & 63, w_ = ltid() >> 6;                     \
    const int l15_ = lane_ & 15, quad_ = lane_ >> 4, wm_ = w_ >> 1, wn_ = w_ & 1;  \
    _Pragma("unroll") for (int i = 0; i < 4; ++i) {                                \
      _Pragma("unroll") for (int j = 0; j < 4; ++j) {                              \
        const int mr = wm_ * 64 + i * 16 + quad_ * 4;                              \
        const int nc = wn_ * 64 + j * 16 + l15_;                                   \
        BODY                                                                       \
      }                                                                            \
    }                                                                              \
  }

__device__ __forceinline__ void gemm_main_blk2(const u16* __restrict__ A, const u16* __restrict__ B, int K, u16* As, u16* Bs,
                                               f32x4 (&acc)[8][4]) {
  const int tid = ltid(), lane = tid & 63, w = tid >> 6, l15 = lane & 15, quad = lane >> 4;
  const int wm = w >> 1, wn = w & 1;
  u32x4 ra[8], rb[4];
  const char* Ab = (const char*)A;
  const char* A2b = (const char*)(A + (size_t)(K >> 6) * 8192);
  const char* Bb = (const char*)B;
  const unsigned lo = (unsigned)tid * 16u;
#define G2_LOAD(KK)                                                                   \
  {                                                                                   \
    const unsigned ko_ = (unsigned)min((KK), K - 64) * 256u;                          \
    _Pragma("unroll") for (int i = 0; i < 4; ++i) {                                   \
      ra[i] = *(const u32x4*)(Ab + (unsigned)(lo + ko_ + (unsigned)i * 4096u));       \
      ra[4 + i] = *(const u32x4*)(A2b + (unsigned)(lo + ko_ + (unsigned)i * 4096u));  \
      rb[i] = *(const u32x4*)(Bb + (unsigned)(lo + ko_ + (unsigned)i * 4096u));       \
    }                                                                                 \
  }
  G2_LOAD(0)
  for (int k0 = 0; k0 < K; k0 += 64) {
    LBAR();
#pragma unroll
    for (int i = 0; i < 8; ++i) *(u32x4*)(As + i * 2048 + tid * 8) = ra[i];
#pragma unroll
    for (int i = 0; i < 4; ++i) *(u32x4*)(Bs + i * 2048 + tid * 8) = rb[i];
    LBAR();
    G2_LOAD(k0 + 64)
#pragma unroll
    for (int ks = 0; ks < 2; ++ks) {
      bf16x8 af[8], bfr[4];
#pragma unroll
      for (int i = 0; i < 8; ++i)
        af[i] = *(const bf16x8*)(As + (wm * 128 + i * 16 + l15) * 64 + (((ks * 4 + quad) ^ (l15 & 7)) * 8));
#pragma unroll
      for (int j = 0; j < 4; ++j)
        bfr[j] = *(const bf16x8*)(Bs + (wn * 64 + j * 16 + l15) * 64 + (((ks * 4 + quad) ^ (l15 & 7)) * 8));
#pragma unroll
      for (int i = 0; i < 8; ++i)
#pragma unroll
        for (int j = 0; j < 4; ++j) acc[i][j] = __builtin_amdgcn_mfma_f32_16x16x32_bf16(af[i], bfr[j], acc[i][j], 0, 0, 0);
    }
  }
#undef G2_LOAD
}

#define EPI_LOOP8(BODY)                                                            \
  {                                                                                \
    const int lane_ = ltid() & 63, w_ = ltid() >> 6;                               \
    const int l15_ = lane_ & 15, quad_ = lane_ >> 4, wm_ = w_ >> 1, wn_ = w_ & 1;  \
    _Pragma("unroll") for (int i = 0; i < 8; ++i) {                                \
      _Pragma("unroll") for (int j = 0; j < 4; ++j) {                              \
        const int mr = wm_ * 128 + i * 16 + quad_ * 4;                             \
        const int nc = wn_ * 64 + j * 16 + l15_;                                   \
        BODY                                                                       \
      }                                                                            \
    }                                                                              \
  }

template <bool BLK>
__device__ __forceinline__ void transpose_tile(const float* __restrict__ src, int N, u16* __restrict__ dst, int K, int kt, int nt,
                               float* tile) {
  const int tid = ltid();
  __syncthreads();
  {
    int c = tid & 63, r0 = tid >> 6;
#pragma unroll
    for (int i = 0; i < 16; ++i) {
      int r = r0 + i * 4;
      tile[r * 65 + c] = src[(size_t)(kt * 64 + r) * N + nt * 64 + c];
    }
  }
  __syncthreads();
#pragma unroll
  for (int i = 0; i < 2; ++i) {
    int c = tid + i * 256, n = c >> 3, kc = c & 7;
    uint4 o;
    o.x = pack2(tile[(kc * 8 + 0) * 65 + n], tile[(kc * 8 + 1) * 65 + n]);
    o.y = pack2(tile[(kc * 8 + 2) * 65 + n], tile[(kc * 8 + 3) * 65 + n]);
    o.z = pack2(tile[(kc * 8 + 4) * 65 + n], tile[(kc * 8 + 5) * 65 + n]);
    o.w = pack2(tile[(kc * 8 + 6) * 65 + n], tile[(kc * 8 + 7) * 65 + n]);
    if (BLK) {
      const int ng = nt * 64 + n;
      *(uint4*)(dst + ((size_t)(ng >> 7) * (K >> 6) + kt) * 8192 + (ng & 127) * 64 + ((kc ^ (ng & 7)) * 8)) = o;
    } else {
      *(uint4*)(dst + (size_t)(nt * 64 + n) * K + kt * 64 + kc * 8) = o;
    }
  }
}

template <bool BLK>
__device__ __forceinline__ void rms_rows(const float* __restrict__ src, int nrows, const float* __restrict__ g, u16* __restrict__ dst) {
  const int lane = ltid() & 63, w = ltid() >> 6;
  for (int row = lbid() * 4 + w; row < nrows; row += gridDim.x * 4) {
    const float4* xr = (const float4*)(src + (size_t)row * D_);
    float4 v[8];
    float ss = 0.f;
#pragma unroll
    for (int i = 0; i < 8; ++i) {
      v[i] = xr[lane + i * 64];
      ss += v[i].x * v[i].x + v[i].y * v[i].y + v[i].z * v[i].z + v[i].w * v[i].w;
    }
    ss = wave_sum(ss);
    float rs = rsqrtf(ss * (1.f / D_) + 1e-6f);
#pragma unroll
    for (int i = 0; i < 8; ++i) {
      int col = (lane + i * 64) * 4;
      float4 gg = *(const float4*)(g + col);
      uint2 o;
      o.x = pack2(v[i].x * rs * gg.x, v[i].y * rs * gg.y);
      o.y = pack2(v[i].z * rs * gg.z, v[i].w * rs * gg.w);
      if (BLK) {
        *(uint2*)(dst + ((size_t)(row >> 7) * 32 + (col >> 6)) * 8192 + (row & 127) * 64 + ((((col & 63) >> 3) ^ (row & 7)) * 8) + (col & 7)) = o;
      } else {
        *(uint2*)(dst + (size_t)row * D_ + col) = o;
      }
    }
  }
}

__device__ __forceinline__ int t5_bucket(int rel) {
  int n = rel < 0 ? -rel : rel;
  int b;
  if (n < 8) b = n;
  else if (n < 12) b = 8;
  else if (n < 16) b = 9;
  else if (n < 23) b = 10;
  else if (n < 32) b = 11;
  else if (n < 46) b = 12;
  else if (n < 64) b = 13;
  else if (n < 91) b = 14;
  else b = 15;
  return (rel > 0 ? 16 : 0) + b;
}

__device__ __forceinline__ void phase_w(const Params p, char* smem) {
  const int tid = ltid();
  float* tile = (float*)smem;
  char* ws = p.ws;
  if (lbid() == 0 && tid < 64) ((int*)(ws + OFF_CNT))[tid] = 0;
  {
    const int lane = tid & 63, w = tid >> 6;
    const int* pos = (const int*)p.in[I_POS];
    for (int t = lbid() * 4 + w; t < 128; t += gridDim.x * 4) {
      int v = pos[t * 64 + lane], mn = v, mx = v;
#pragma unroll
      for (int o = 32; o >= 1; o >>= 1) {
        mn = min(mn, __shfl_xor(mn, o));
        mx = max(mx, __shfl_xor(mx, o));
      }
      if (lane == 0) {
        ((int*)(ws + OFF_KPMM))[t * 2] = mn;
        ((int*)(ws + OFF_KPMM))[t * 2 + 1] = mx;
      }
    }
  }
  for (int i = lbid() * 256 + tid; i < L_ * 32 * 512; i += gridDim.x * 256) {
    int l = i / (32 * 512), r = i % (32 * 512), kt = r >> 9, q = r & 511;
    *(uint4*)((u16*)(ws + OFF_WIN) + (size_t)l * NINP * D_ + ((size_t)115 * 32 + kt) * 8192 + 4096 + q * 8) = make_uint4(0, 0, 0, 0);
  }
  rms_rows<true>((const float*)p.in[I_X], S_, (const float*)p.in[I_NORMG], (u16*)(ws + OFF_H));
  for (int l = 0; l < L_; ++l)
    rms_rows<false>((const float*)p.in[I_MEM], 256, (const float*)p.in[I_MEMNG] + l * D_, (u16*)(ws + OFF_MEMN) + (size_t)l * 256 * D_);
  const int PER_L = 7392 + 1024 + 1024 + 72 + 64 + 512;
  for (int t = lbid(); t < L_ * PER_L; t += gridDim.x) {
    int l = t / PER_L, r = t % PER_L;
    if (r < 7392) {
      transpose_tile<true>((const float*)p.in[I_WIN] + (size_t)l * D_ * NIN, NIN, (u16*)(ws + OFF_WIN) + (size_t)l * NINP * D_, D_,
                     r / 231, r % 231, tile);
    } else if (r < 7392 + 1024) {
      r -= 7392;
      int bi = r >> 8;
      r &= 255;
      transpose_tile<false>((const float*)p.in[I_WBR] + (size_t)(l * 4 + bi) * 512 * 2048, 2048,
                     (u16*)(ws + OFF_WB) + (size_t)(l * 4 + bi) * 2048 * 512, 512, r >> 5, r & 31, tile);
    } else if (r < 7392 + 2048) {
      r -= 7392 + 1024;
      transpose_tile<false>((const float*)p.in[I_WOUT] + (size_t)l * 2048 * 2048, 2048, (u16*)(ws + OFF_WO) + (size_t)l * 2048 * 2048,
                     2048, r >> 5, r & 31, tile);
    } else if (r < 7392 + 2048 + 72) {
      r -= 7392 + 2048;
      transpose_tile<false>((const float*)p.in[I_WUQ] + (size_t)l * 384 * 768, 768, (u16*)(ws + OFF_WUQ) + (size_t)l * 768 * 384, 384,
                     r / 12, r % 12, tile);
    } else if (r < 7392 + 2048 + 72 + 64) {
      r -= 7392 + 2048 + 72;
      transpose_tile<false>((const float*)p.in[I_WUKV] + (size_t)l * 256 * 1024, 1024, (u16*)(ws + OFF_WUKV) + (size_t)l * 1024 * 256,
                     256, r >> 4, r & 15, tile);
    } else {
      r -= 7392 + 2048 + 72 + 64;
      transpose_tile<false>((const float*)p.in[I_WKV] + (size_t)l * 2048 * 1024, 1024, (u16*)(ws + OFF_WKV) + (size_t)l * 1024 * 2048,
                     2048, r >> 4, r & 15, tile);
    }
  }
}

__device__ __forceinline__ int tile_slots(int NT) { return gridDim.x == 512 ? 512 * ((NT + 7) >> 3) : 64 * NT; }
__device__ __forceinline__ bool tile_map(int t, int NT, int& mt, int& nt) {
  if (gridDim.x == 512) {
    int bid = t & 511, k = t >> 9, x = bid & 7, j = bid >> 3;
    mt = 8 * x + (j & 7);
    nt = 8 * k + (j >> 3);
  } else {
    mt = t & 63;
    nt = t >> 6;
  }
  return nt < NT;
}

__device__ __forceinline__ int tile_slots2(int NT) { return gridDim.x == 512 ? 512 * ((NT + 15) >> 4) : 32 * NT; }
__device__ __forceinline__ bool tile_map2(int t, int NT, int& mt, int& nt) {
  if (gridDim.x == 512) {
    int bid = t & 511, k = t >> 9, x = bid & 7, j = bid >> 3;
    mt = 4 * x + (j & 3);
    nt = 16 * k + (j >> 2);
  } else {
    mt = t & 31;
    nt = t >> 5;
  }
  return nt < NT;
}

__device__ __forceinline__ void phase_gemm_in(const Params p, int l, char* smem, int vb) {
  u16* As = (u16*)smem;
  char* ws = p.ws;
  {
    u16* Bs = As + 256 * 64;
    const int nslots = tile_slots2(112);
    for (int t = vb; t < nslots; t += gridDim.x) {
      int mt, nt;
      if (!tile_map2(t, 112, mt, nt)) continue;
      f32x4 acc[8][4];
#pragma unroll
      for (int i_ = 0; i_ < 8; ++i_)
#pragma unroll
        for (int j_ = 0; j_ < 4; ++j_) acc[i_][j_] = (f32x4){0.f, 0.f, 0.f, 0.f};
      int m0 = mt * 256, n0 = nt * 128;
      gemm_main_blk2((const u16*)(ws + OFF_H) + (size_t)(2 * mt) * 32 * 8192,
                     (const u16*)(ws + OFF_WIN) + (size_t)l * NINP * D_ + (size_t)nt * 32 * 8192, D_, As, Bs, acc);
      if (n0 < 1792) {
        float* dst = (float*)(ws + OFF_RWU);
        EPI_LOOP8({
          _Pragma("unroll") for (int r2 = 0; r2 < 4; ++r2) dst[(size_t)(m0 + mr + r2) * 1792 + n0 + nc] = acc[i][j][r2];
        })
      } else if (n0 >= O_DV && n0 < O_QL) {
        u16* dst = (u16*)(ws + OFF_VTD) + (size_t)((n0 - O_DV) / 128) * 128 * S_;
        EPI_LOOP8({
          uint2 o;
          o.x = pack2(acc[i][j][0], acc[i][j][1]);
          o.y = pack2(acc[i][j][2], acc[i][j][3]);
          *(uint2*)(dst + (size_t)nc * S_ + m0 + mr) = o;
        })
      } else {
        u16* dst = (u16*)(ws + OFF_P);
        EPI_LOOP8({
          _Pragma("unroll") for (int r2 = 0; r2 < 4; ++r2) dst[(size_t)(m0 + mr + r2) * NINP + n0 + nc] = f2bf(acc[i][j][r2]);
        })
      }
    }
  }
  {
    u16* Bs = As + 128 * 64;
    for (int t = vb; t < 256; t += gridDim.x) {
      f32x4 acc[4][4];
      ZERO_ACC(acc);
      int mt = t & 63, nt = 112 + (t >> 6);
      int m0 = mt * 128, n0 = nt * 128;
      gemm_main_blk((const u16*)(ws + OFF_H) + (size_t)mt * 32 * 8192,
                    (const u16*)(ws + OFF_WIN) + (size_t)l * NINP * D_ + (size_t)nt * 32 * 8192, D_, As, Bs, acc);
      u16* dst = (u16*)(ws + OFF_P);
      EPI_LOOP({
        _Pragma("unroll") for (int r2 = 0; r2 < 4; ++r2) dst[(size_t)(m0 + mr + r2) * NINP + n0 + nc] = f2bf(acc[i][j][r2]);
      })
    }
  }
  if (l == 0) {
    u16* Bs = As + 128 * 64;
    for (int tt = (vb + gridDim.x - 256) % gridDim.x; tt < 64; tt += gridDim.x) {
      f32x4 acc[4][4];
      ZERO_ACC(acc);
      int ll = tt >> 4, mt = (tt >> 3) & 1, nt = tt & 7;
      int m0 = mt * 128, n0 = nt * 128;
      gemm_main<false>((const u16*)(ws + OFF_MEMN) + ((size_t)ll * 256 + m0) * D_, D_, (const u16*)(ws + OFF_WKV) + ((size_t)ll * 1024 + n0) * D_,
                D_, D_, As, Bs, acc);
      if (nt < 4) {
        float* dst = (float*)(ws + OFF_KVMEM) + (size_t)ll * 256 * 512;
        EPI_LOOP({
          _Pragma("unroll") for (int r2 = 0; r2 < 4; ++r2) dst[(size_t)(m0 + mr + r2) * 512 + n0 + nc] = acc[i][j][r2];
        })
      } else {
        u16* dst = (u16*)(ws + OFF_VTMEM) + (size_t)(ll * 4 + (nt - 4)) * 128 * 256;
        EPI_LOOP({
          uint2 o;
          o.x = pack2(acc[i][j][0], acc[i][j][1]);
          o.y = pack2(acc[i][j][2], acc[i][j][3]);
          *(uint2*)(dst + (size_t)nc * 256 + m0 + mr) = o;
        })
      }
    }
  }
}

__device__ __forceinline__ void phase_gemm_mla(const Params p, int l, char* smem, int vb) {
  u16* As = (u16*)smem;
  u16* Bs = As + 128 * 64;
  char* ws = p.ws;
  const u16* P = (const u16*)(ws + OFF_P);
  const int nslots = tile_slots(14);
  for (int t = vb; t < nslots; t += gridDim.x) {
    f32x4 acc[4][4];
    ZERO_ACC(acc);
    int mt, nt;
    if (!tile_map(t, 14, mt, nt)) continue;
    int m0 = mt * 128;
    if (nt < 6) {
      int n0 = nt * 128;
      gemm_main<true>(P + (size_t)m0 * NINP + O_QL, NINP, (const u16*)(ws + OFF_WUQ) + ((size_t)l * 768 + n0) * 384, 384, 384, As, Bs, acc);
      u16* dst = (u16*)(ws + OFF_MQ);
      EPI_LOOP_T({
        uint2 o;
        o.x = pack2(acc[i][j][0], acc[i][j][1]);
        o.y = pack2(acc[i][j][2], acc[i][j][3]);
        *(uint2*)(dst + (size_t)(m0 + mr) * 768 + n0 + nc) = o;
      })
    } else {
      nt -= 6;
      int n0 = nt * 128, h = nt >> 1;
      if ((nt & 1) == 0) {
        gemm_main<true>(P + (size_t)m0 * NINP + O_KVL, NINP, (const u16*)(ws + OFF_WUKV) + ((size_t)l * 1024 + n0) * 256, 256, 256, As, Bs, acc);
        u16* dst = (u16*)(ws + OFF_MKV);
        EPI_LOOP_T({
          uint2 o;
          o.x = pack2(acc[i][j][0], acc[i][j][1]);
          o.y = pack2(acc[i][j][2], acc[i][j][3]);
          *(uint2*)(dst + (size_t)(m0 + mr) * 512 + h * 128 + nc) = o;
        })
      } else {
        gemm_main<false>(P + (size_t)m0 * NINP + O_KVL, NINP, (const u16*)(ws + OFF_WUKV) + ((size_t)l * 1024 + n0) * 256, 256, 256, As, Bs, acc);
        u16* dst = (u16*)(ws + OFF_VTM) + (size_t)h * 128 * S_;
        EPI_LOOP({
          uint2 o;
          o.x = pack2(acc[i][j][0], acc[i][j][1]);
          o.y = pack2(acc[i][j][2], acc[i][j][3]);
          *(uint2*)(dst + (size_t)nc * S_ + m0 + mr) = o;
        })
      }
    }
  }
}

__device__ __forceinline__ void phase_gemm_branch(const Params p, int l, char* smem, int vb) {
  u16* As = (u16*)smem;
  u16* Bs = As + 128 * 64;
  char* ws = p.ws;
  const u16* P = (const u16*)(ws + OFF_P);
  const int nslots = tile_slots(16);
  for (int t = vb; t < nslots; t += gridDim.x) {
    int mt, nt;
    if (!tile_map(t, 16, mt, nt)) continue;
    int m0 = mt * 128, n0 = nt * 128;
    f32x4 zacc[4][4];
    ZERO_ACC(zacc);
    for (int bi = 0; bi < 4; ++bi) {
      f32x4 acc[4][4];
      ZERO_ACC(acc);
      gemm_main1<true>((const u16*)(ws + OFF_YG) + ((size_t)bi * S_ + m0) * 512, 512,
                (const u16*)(ws + OFF_WB) + ((size_t)(l * 4 + bi) * 2048 + n0) * 512, 512, 512, As, Bs, acc);
      EPI_LOOP_T({
        const uint2 mg = *(const uint2*)(P + (size_t)(m0 + mr) * NINP + O_MG + bi * 2048 + n0 + nc);
        zacc[i][j][0] += sigmoidf_(lo2f(mg.x)) * acc[i][j][0];
        zacc[i][j][1] += sigmoidf_(hi2f(mg.x)) * acc[i][j][1];
        zacc[i][j][2] += sigmoidf_(lo2f(mg.y)) * acc[i][j][2];
        zacc[i][j][3] += sigmoidf_(hi2f(mg.y)) * acc[i][j][3];
      })
    }
    u16* dst = (u16*)(ws + OFF_Z);
    EPI_LOOP_T({
      uint2 o;
      o.x = pack2(zacc[i][j][0], zacc[i][j][1]);
      o.y = pack2(zacc[i][j][2], zacc[i][j][3]);
      *(uint2*)(dst + (size_t)(m0 + mr) * D_ + n0 + nc) = o;
    })
  }
}

__device__ __forceinline__ void phase_gemm_out(const Params p, int l, char* smem, int vb) {
  u16* As = (u16*)smem;
  u16* Bs = As + 128 * 64;
  char* ws = p.ws;
  const float* xin = (l == 0) ? (const float*)p.in[I_X] : (const float*)p.out;
  const int nslots = tile_slots(16);
  for (int t = vb; t < nslots; t += gridDim.x) {
    int mt, nt;
    if (!tile_map(t, 16, mt, nt)) continue;
    int m0 = mt * 128, n0 = nt * 128;
    f32x4 acc[4][4];
    ZERO_ACC(acc);
    gemm_main<true>((const u16*)(ws + OFF_Z) + (size_t)m0 * D_, D_, (const u16*)(ws + OFF_WO) + ((size_t)l * 2048 + n0) * D_, D_, D_, As, Bs,
              acc);
    EPI_LOOP_T({
      size_t idx = (size_t)(m0 + mr) * D_ + n0 + nc;
      float4 xv = *(const float4*)(xin + idx);
      *(float4*)(p.out + idx) = make_float4(xv.x + acc[i][j][0], xv.y + acc[i][j][1], xv.z + acc[i][j][2], xv.w + acc[i][j][3]);
    })
  }
}

__device__ __forceinline__ void seg_norm8(u16* ptr, bool active, int width, float inv_n, const float* g, float scale) {
  uint4 v = make_uint4(0, 0, 0, 0);
  if (active) v = *(const uint4*)ptr;
  float x[8] = {lo2f(v.x), hi2f(v.x), lo2f(v.y), hi2f(v.y), lo2f(v.z), hi2f(v.z), lo2f(v.w), hi2f(v.w)};
  float ss = 0.f;
#pragma unroll
  for (int i = 0; i < 8; ++i) ss += x[i] * x[i];
  for (int o = 1; o < width; o <<= 1) ss += __shfl_xor(ss, o);
  float rs = rsqrtf(ss * inv_n + 1e-6f) * scale;
  if (active) {
    float4 g0 = *(const float4*)g, g1 = *(const float4*)(g + 4);
    uint4 o;
    o.x = pack2(x[0] * rs * g0.x, x[1] * rs * g0.y);
    o.y = pack2(x[2] * rs * g0.z, x[3] * rs * g0.w);
    o.z = pack2(x[4] * rs * g1.x, x[5] * rs * g1.y);
    o.w = pack2(x[6] * rs * g1.z, x[7] * rs * g1.w);
    *(uint4*)ptr = o;
  }
}

template <bool RWONLY>
__device__ __forceinline__ void phase_prep(const Params p, int l, char* smem) {
  char* ws = p.ws;
  const int tid = ltid(), lane = tid & 63, w = tid >> 6;
  u16* P = (u16*)(ws + OFF_P);
  if (!RWONLY) {
    const float* dqg = (const float*)p.in[I_DQKG] + l * 128;
    const float* mqg = (const float*)p.in[I_MQKG] + l * 256;
    const float* qlg = (const float*)p.in[I_QLATG] + l * 384;
    const float* kvg = (const float*)p.in[I_KVLATG] + l * 256;
    for (int s = lbid() * 4 + w; s < S_; s += gridDim.x * 4) {
      u16* row = P + (size_t)s * NINP;
      seg_norm8(row + O_DQ + lane * 8, true, 8, 1.f / 64, dqg + (lane * 8) % 64, 0.125f * LOG2E);
      seg_norm8(row + O_DK + lane * 8, true, 8, 1.f / 64, dqg + 64 + (lane * 8) % 64, 1.f);
      seg_norm8(row + O_MQ + lane * 8, true, 16, 1.f / 128, mqg + (lane * 8) % 128, 0.08838834764831845f * LOG2E);
      seg_norm8(row + O_QL + (lane < 48 ? lane : 0) * 8, lane < 48, 64, 1.f / 384, qlg + (lane < 48 ? lane : 0) * 8, 1.f);
      seg_norm8(row + O_KVL + (lane < 32 ? lane : 0) * 8, lane < 32, 64, 1.f / 256, kvg + (lane < 32 ? lane : 0) * 8, 1.f);
    }
  }
  if (l == 0 && !RWONLY) {
    for (int sg = lbid() * 4 + w; sg < L_ * 256 * 4; sg += gridDim.x * 4) {
      int ll = sg >> 10, m = (sg >> 2) & 255, h = sg & 3;
      const float* src = (const float*)(ws + OFF_KVMEM) + ((size_t)ll * 256 + m) * 512 + h * 128;
      float a = src[lane], b = src[lane + 64];
      float ss = wave_sum(a * a + b * b);
      float rs = rsqrtf(ss * (1.f / 128) + 1e-6f);
      const float* g = (const float*)p.in[I_MQKG] + ll * 256 + 128;
      u16* dst = (u16*)(ws + OFF_KMEM) + ((size_t)(ll * 4 + h) * 256 + m) * 128;
      dst[lane] = f2bf(a * rs * g[lane]);
      dst[lane + 64] = f2bf(b * rs * g[lane + 64]);
    }
  }
  {
    float* ld = (float*)smem;
    const float* RWU = (const float*)(ws + OFF_RWU);
    const float* sh = (const float*)p.in[I_SHIFT] + (size_t)l * 3 * 1792;
    const float* wup = (const float*)p.in[I_WUP] + (size_t)l * 2 * 64 * 512;
    const float* aup = (const float*)p.in[I_AUP] + (size_t)l * 2 * 64 * 512;
    const float* w0 = (const float*)p.in[I_W0] + l * 1024;
    const float* a0 = (const float*)p.in[I_A0] + l * 1024;
    const float* kkp = (const float*)p.in[I_KK] + l * 512;
    const float* kap = (const float*)p.in[I_KA] + l * 512;
    const float* rkp = (const float*)p.in[I_RK] + l * 512;
    for (int tile = lbid(); tile < S_ / 8; tile += gridDim.x) {
      const int s0 = tile * 8;
      __syncthreads();
      {
        int c = 1536 + tid;
        float c0 = sh[c], c1 = sh[1792 + c], c2 = sh[2 * 1792 + c];
#pragma unroll
        for (int tk = 0; tk < 8; ++tk) {
          int s = s0 + tk;
          float um = s > 0 ? RWU[(size_t)(s - 1) * 1792 + c] : 0.f;
          float u0 = RWU[(size_t)s * 1792 + c];
          float up = s < S_ - 1 ? RWU[(size_t)(s + 1) * 1792 + c] : 0.f;
          float v = c0 * um + c1 * u0 + c2 * up;
          if (tid < 128) v = tanhf(v);
          ld[tk * 256 + tid] = v;
        }
      }
      __syncthreads();
      float acc[8][4][2];
#pragma unroll
      for (int a = 0; a < 8; ++a)
#pragma unroll
        for (int b = 0; b < 4; ++b) acc[a][b][0] = acc[a][b][1] = 0.f;
      for (int l4 = 0; l4 < 16; ++l4) {
        float wv[4][4][2];
#pragma unroll
        for (int ll = 0; ll < 4; ++ll) {
#pragma unroll
          for (int ch = 0; ch < 2; ++ch) {
            int c = tid + ch * 256;
            int li = l4 * 4 + ll;
            wv[0][ll][ch] = wup[(size_t)(0 * 64 + li) * 512 + c];
            wv[1][ll][ch] = wup[(size_t)(1 * 64 + li) * 512 + c];
            wv[2][ll][ch] = aup[(size_t)(0 * 64 + li) * 512 + c];
            wv[3][ll][ch] = aup[(size_t)(1 * 64 + li) * 512 + c];
          }
        }
#pragma unroll
        for (int tk = 0; tk < 8; ++tk) {
#pragma unroll
          for (int mat = 0; mat < 4; ++mat) {
            float4 d = *(const float4*)(ld + tk * 256 + mat * 64 + l4 * 4);
#pragma unroll
            for (int ch = 0; ch < 2; ++ch) {
              acc[tk][mat][ch] += d.x * wv[mat][0][ch] + d.y * wv[mat][1][ch] + d.z * wv[mat][2][ch] + d.w * wv[mat][3][ch];
            }
          }
        }
      }
#pragma unroll
      for (int ch = 0; ch < 2; ++ch) {
        const int c = tid + ch * 256;
        float shc[3][3];
#pragma unroll
        for (int q = 0; q < 3; ++q)
#pragma unroll
          for (int j = 0; j < 3; ++j) shc[q][j] = sh[j * 1792 + q * 512 + c];
        const float kkc = kkp[c], kac = kap[c], rkc = rkp[c];
        const float w0c0 = w0[c], w0c1 = w0[512 + c], a0c0 = a0[c], a0c1 = a0[512 + c];
        float um[3], u0[3];
#pragma unroll
        for (int q = 0; q < 3; ++q) {
          um[q] = s0 > 0 ? RWU[(size_t)(s0 - 1) * 1792 + q * 512 + c] : 0.f;
          u0[q] = RWU[(size_t)s0 * 1792 + q * 512 + c];
        }
#pragma unroll
        for (int tk = 0; tk < 8; ++tk) {
          const int s = s0 + tk;
          float rkv[3];
#pragma unroll
          for (int q = 0; q < 3; ++q) {
            float up = s < S_ - 1 ? RWU[(size_t)(s + 1) * 1792 + q * 512 + c] : 0.f;
            rkv[q] = shc[q][0] * um[q] + shc[q][1] * u0[q] + shc[q][2] * up;
            um[q] = u0[q];
            u0[q] = up;
          }
          float r = rkv[0], k = rkv[1], v = rkv[2];
          float kkr = k * kkc;
          float ss = wave_sum(kkr * kkr);
          float kk = kkr * __builtin_amdgcn_rcpf(fmaxf(sqrtf(ss), 1e-12f));
          float bsum = 0.f;
#pragma unroll
          for (int n = 0; n < 2; ++n) {
            float zw = (n ? w0c1 : w0c0) + acc[tk][n][ch];
            float za = (n ? a0c1 : a0c0) + acc[tk][2 + n][ch];
            float dec = __expf(-0.6065306597126334f * sigmoidf_(zw));
            float a = sigmoidf_(za);
            float kd = k * (1.f + (a - 1.f) * kac);
            float bb = kk * a;
            size_t o = ((size_t)n * S_ + s) * 512 + c;
            ((float*)(ws + OFF_SCW))[o] = dec;
            ((float*)(ws + OFF_SCKD))[o] = kd;
            ((float*)(ws + OFF_SCB))[o] = bb;
            bsum += r * kd * rkc;
          }
          size_t o1 = (size_t)s * 512 + c;
          ((float*)(ws + OFF_SCR))[o1] = r;
          ((float*)(ws + OFF_SCV))[o1] = v;
          ((float*)(ws + OFF_SCKK))[o1] = kk;
          float bon = wave_sum(bsum);
          if (lane == 0) ((float*)(ws + OFF_BONUS))[s * 8 + w + 4 * ch] = bon;
        }
      }
    }
  }
}

__device__ __forceinline__ void phase_mla_post(const Params p, int l, char* smem) {
  char* ws = p.ws;
  const int lane = ltid() & 63, w = ltid() >> 6;
  const float* ng = (const float*)p.in[I_NOPEG] + l * 256;
  const float* rg = (const float*)p.in[I_ROPEG] + l * 128;
  const int* pos = (const int*)p.in[I_POS];
  const float qscale = 0.07216878364870322f * LOG2E;
  const int fi = lane & 31;
  const float inv_freq = powf(10000.f, -(float)fi / 32.f);
  for (int s = lbid() * 4 + w; s < S_; s += gridDim.x * 4) {
    float ang = (float)pos[s] * inv_freq;
    float cs = cosf(ang), sn = sinf(ang);
    const u16* mq = (const u16*)(ws + OFF_MQ) + (size_t)s * 768;
    const u16* mk = (const u16*)(ws + OFF_MKV) + (size_t)s * 512;
    float kr1, kr2;
    {
      const u16* kr = (const u16*)(ws + OFF_P) + (size_t)s * NINP + O_KR;
      float t1 = lane < 32 ? bf2f(kr[fi]) : 0.f, t2 = lane < 32 ? bf2f(kr[32 + fi]) : 0.f;
      float ss = wave_sum(t1 * t1 + t2 * t2);
      float rs = rsqrtf(ss * (1.f / 64) + 1e-6f);
      t1 *= rs * rg[64 + fi];
      t2 *= rs * rg[64 + 32 + fi];
      kr1 = t1 * cs - t2 * sn;
      kr2 = t2 * cs + t1 * sn;
    }
#pragma unroll
    for (int h = 0; h < 4; ++h) {
      u16* qd = (u16*)(ws + OFF_QM) + ((size_t)h * S_ + s) * 192;
      u16* kd = (u16*)(ws + OFF_KM) + ((size_t)h * S_ + s) * 192;
      {
        const unsigned ab = *(const unsigned*)(mq + h * 192 + 2 * lane);
        float a = lo2f(ab), b = hi2f(ab);
        float ss = wave_sum(a * a + b * b);
        float rs = rsqrtf(ss * (1.f / 128) + 1e-6f) * qscale;
        const float2 gq = *(const float2*)(ng + 2 * lane);
        *(unsigned*)(qd + 2 * lane) = pack2(a * rs * gq.x, b * rs * gq.y);
      }
      {
        float t1 = lane < 32 ? bf2f(mq[h * 192 + 128 + fi]) : 0.f, t2 = lane < 32 ? bf2f(mq[h * 192 + 160 + fi]) : 0.f;
        float ss = wave_sum(t1 * t1 + t2 * t2);
        float rs = rsqrtf(ss * (1.f / 64) + 1e-6f);
        t1 *= rs * rg[fi];
        t2 *= rs * rg[32 + fi];
        if (lane < 32) {
          qd[128 + fi] = f2bf((t1 * cs - t2 * sn) * qscale);
          qd[160 + fi] = f2bf((t2 * cs + t1 * sn) * qscale);
        }
      }
      {
        const unsigned ab = *(const unsigned*)(mk + h * 128 + 2 * lane);
        float a = lo2f(ab), b = hi2f(ab);
        float ss = wave_sum(a * a + b * b);
        float rs = rsqrtf(ss * (1.f / 128) + 1e-6f);
        const float2 gk = *(const float2*)(ng + 128 + 2 * lane);
        *(unsigned*)(kd + 2 * lane) = pack2(a * rs * gk.x, b * rs * gk.y);
        if (lane < 32) {
          kd[128 + fi] = f2bf(kr1);
          kd[160 + fi] = f2bf(kr2);
        }
      }
    }
  }
}

template <int DQK, int NSUB>
__device__ __forceinline__ void attn_item(const u16* __restrict__ Q, int ldq, const u16* __restrict__ K, int ldk, const u16* __restrict__ Vt,
                          int ldv, int Skv, u16* __restrict__ O, int qb, bool hasBias, const float* __restrict__ relb, int head,
                          const int* __restrict__ pos, const int* __restrict__ kpmm, char* smem, const int* __restrict__ kposp,
                          float* __restrict__ ML) {
  constexpr int LDK = DQK;
  constexpr int SW = (DQK == 128) ? 15 : 7;
  constexpr int NKS = DQK / 32;
  constexpr int NKC = DQK / 32;
  u16* Ks = (u16*)smem;
  u16* Vs = (u16*)(smem + 25600);
  float* bt = (float*)(smem + 44032);
  int* kp = (int*)(smem + 45072);
  const int tid = ltid(), lane = tid & 63, w = tid >> 6, l15 = lane & 15, quad = lane >> 4;
  const int q0 = qb * (64 * NSUB) + w * (16 * NSUB);

  bf16x8 qf[NSUB][NKS];
#pragma unroll
  for (int sub = 0; sub < NSUB; ++sub)
#pragma unroll
    for (int ks = 0; ks < NKS; ++ks)
      qf[sub][ks] = *(const bf16x8*)(Q + (size_t)(q0 + sub * 16 + l15) * ldq + ks * 32 + quad * 8);

  int qp[2] = {0, 0};
  int qpmin = 0, qpmax = 0;
  if (hasBias) {
    qp[0] = pos[q0 + l15];
    qp[1] = pos[q0 + (NSUB - 1) * 16 + l15];
    qpmin = min(qp[0], qp[1]);
    qpmax = max(qp[0], qp[1]);
#pragma unroll
    for (int o = 8; o >= 1; o >>= 1) {
      qpmin = min(qpmin, __shfl_xor(qpmin, o));
      qpmax = max(qpmax, __shfl_xor(qpmax, o));
    }
  }
  __syncthreads();
  if (hasBias) {
    for (int i = tid; i < 257; i += 256) bt[i] = relb[t5_bucket(i - 128) * 4 + head] * LOG2E;
  }
  u32x4 kreg[NKC], vreg[4];
#pragma unroll
  for (int i = 0; i < NKC; ++i) {
    int c = tid + i * 256, r = c / (DQK / 8), kc = c % (DQK / 8);
    kreg[i] = *(const u32x4*)(K + (size_t)r * ldk + kc * 8);
  }
#pragma unroll
  for (int i = 0; i < 4; ++i) {
    int c = tid + i * 256, r = c >> 3, kc = c & 7;
    vreg[i] = *(const u32x4*)(Vt + (size_t)r * ldv + kc * 8);
  }
#pragma unroll
  for (int i = 0; i < NKC; ++i) {
    int c = tid + i * 256, r = c / (DQK / 8), kc = c % (DQK / 8);
    *(u32x4*)(Ks + r * LDK + ((kc ^ (r & SW)) * 8)) = kreg[i];
  }
#pragma unroll
  for (int i = 0; i < 4; ++i) {
    int c = tid + i * 256, r = c >> 3, kc = c & 7;
    *(u32x4*)(Vs + r * 72 + kc * 8) = vreg[i];
  }
  if (hasBias && tid < 64) kp[tid] = kposp[tid];
  __syncthreads();

  f32x4 oacc[8][NSUB];
#pragma unroll
  for (int et = 0; et < 8; ++et)
#pragma unroll
    for (int sub = 0; sub < NSUB; ++sub) oacc[et][sub] = (f32x4){0.f, 0.f, 0.f, 0.f};
  float mrow[2] = {-1e30f, -1e30f}, lrow[2] = {0.f, 0.f};

  const int ntiles = Skv / 64;
  constexpr bool KDMA = (DQK == 192);
  int koff[6];
#pragma unroll
  for (int i = 0; i < 6; ++i) {
    const int o = (w + 4 * i) * 1024 + lane * 16;
    const int r = o / (DQK * 2), pos = (o % (DQK * 2)) >> 4;
    koff[i] = r * ldk + ((pos ^ (r & SW)) * 8);
  }
  for (int t = 0; t < ntiles; ++t) {
    const bool more = (t + 1 < ntiles);
    const int k1 = (t + 1) * 64;
    constexpr bool EARLY = (DQK != 128);
    if (EARLY && more) {
      if (!KDMA) {
#pragma unroll
        for (int i = 0; i < NKC; ++i) {
          int c = tid + i * 256, r = c / (DQK / 8), kc = c % (DQK / 8);
          kreg[i] = *(const u32x4*)(K + (size_t)(k1 + r) * ldk + kc * 8);
        }
      }
#pragma unroll
      for (int i = 0; i < 4; ++i) {
        int c = tid + i * 256, r = c >> 3, kc = c & 7;
        vreg[i] = *(const u32x4*)(Vt + (size_t)r * ldv + k1 + kc * 8);
      }
    }
    f32x4 sacc[4][NSUB];
#pragma unroll
    for (int kt = 0; kt < 4; ++kt)
#pragma unroll
      for (int sub = 0; sub < NSUB; ++sub) sacc[kt][sub] = (f32x4){0.f, 0.f, 0.f, 0.f};
    __builtin_amdgcn_s_setprio(1);
#pragma unroll
    for (int ks = 0; ks < NKS; ++ks) {
#pragma unroll
      for (int kt = 0; kt < 4; ++kt) {
        bf16x8 kf = *(const bf16x8*)(Ks + (kt * 16 + l15) * LDK + (((ks * 4 + quad) ^ (l15 & SW)) * 8));
#pragma unroll
        for (int sub = 0; sub < NSUB; ++sub)
          sacc[kt][sub] = __builtin_amdgcn_mfma_f32_16x16x32_bf16(kf, qf[sub][ks], sacc[kt][sub], 0, 0, 0);
      }
      __builtin_amdgcn_sched_barrier(0);
    }
    __builtin_amdgcn_s_setprio(0);
    float cb = 0.f;
    if (hasBias) {
      int kmn = kpmm[t * 2], kmx = kpmm[t * 2 + 1];
      if (kmn - qpmax >= 128 || kmx - qpmin <= -128) {
        cb = (kmn - qpmax >= 128) ? bt[256] : bt[0];
      } else {
#pragma unroll
        for (int kt = 0; kt < 4; ++kt) {
#pragma unroll
          for (int j = 0; j < 4; ++j) {
            int kpos = kp[kt * 16 + quad * 4 + j];
#pragma unroll
            for (int sub = 0; sub < NSUB; ++sub) {
              int rel = kpos - qp[sub];
              rel = max(-128, min(128, rel));
              sacc[kt][sub][j] += bt[rel + 128];
            }
          }
        }
      }
    }
    LBAR();
    if (more) {
      if (!EARLY) {
#pragma unroll
        for (int i = 0; i < NKC; ++i) {
          int c = tid + i * 256, r = c / (DQK / 8), kc = c % (DQK / 8);
          kreg[i] = *(const u32x4*)(K + (size_t)(k1 + r) * ldk + kc * 8);
        }
#pragma unroll
        for (int i = 0; i < 4; ++i) {
          int c = tid + i * 256, r = c >> 3, kc = c & 7;
          vreg[i] = *(const u32x4*)(Vt + (size_t)r * ldv + k1 + kc * 8);
        }
      }
      if (hasBias && tid < 64) kp[tid] = kposp[k1 + tid];
      if (KDMA) {
#pragma unroll
        for (int i = 0; i < 6; ++i)
          __builtin_amdgcn_global_load_lds((const unsigned*)(K + (size_t)k1 * ldk + koff[i]),
                                           (unsigned*)((char*)Ks + (w + 4 * i) * 1024), 16, 0, 0);
      }
    }
    __builtin_amdgcn_sched_barrier(0);
    bf16x8 pf[NSUB][2];
#pragma unroll
    for (int sub = 0; sub < NSUB; ++sub) {
      float mx = -1e30f;
#pragma unroll
      for (int kt = 0; kt < 4; ++kt)
#pragma unroll
        for (int j = 0; j < 4; ++j) mx = fmaxf(mx, sacc[kt][sub][j]);
      mx = fmaxf(mx, __shfl_xor(mx, 16));
      mx = fmaxf(mx, __shfl_xor(mx, 32));
      float mnew = fmaxf(mrow[sub], mx + cb);
      float alpha = __builtin_amdgcn_exp2f(mrow[sub] - mnew);
      mrow[sub] = mnew;
      const float off = cb - mnew;
      float ps = 0.f;
      float pv[4][4];
#pragma unroll
      for (int kt = 0; kt < 4; ++kt)
#pragma unroll
        for (int j = 0; j < 4; ++j) {
          pv[kt][j] = __builtin_amdgcn_exp2f(sacc[kt][sub][j] + off);
          ps += pv[kt][j];
        }
      lrow[sub] = lrow[sub] * alpha + ps;
#pragma unroll
      for (int kb = 0; kb < 2; ++kb) {
        u32x4 pu = {pack2(pv[2 * kb][0], pv[2 * kb][1]), pack2(pv[2 * kb][2], pv[2 * kb][3]),
                    pack2(pv[2 * kb + 1][0], pv[2 * kb + 1][1]), pack2(pv[2 * kb + 1][2], pv[2 * kb + 1][3])};
        pf[sub][kb] = __builtin_bit_cast(bf16x8, pu);
      }
      if (__builtin_amdgcn_ballot_w64(alpha != 1.f) != 0) {
#pragma unroll
        for (int et = 0; et < 8; ++et) {
          oacc[et][sub][0] *= alpha; oacc[et][sub][1] *= alpha;
          oacc[et][sub][2] *= alpha; oacc[et][sub][3] *= alpha;
        }
      }
    }
    __builtin_amdgcn_s_setprio(1);
#pragma unroll
    for (int et = 0; et < 8; ++et) {
#pragma unroll
      for (int kb = 0; kb < 2; ++kb) {
        const u16* vp = Vs + (et * 16 + l15) * 72 + kb * 32 + quad * 4;
        u32x2 a0 = *(const u32x2*)vp;
        u32x2 a1 = *(const u32x2*)(vp + 16);
        u32x4 cu = {a0.x, a0.y, a1.x, a1.y};
        bf16x8 vb = __builtin_bit_cast(bf16x8, cu);
#pragma unroll
        for (int sub = 0; sub < NSUB; ++sub)
          oacc[et][sub] = __builtin_amdgcn_mfma_f32_16x16x32_bf16(vb, pf[sub][kb], oacc[et][sub], 0, 0, 0);
      }
      if (et & 1) __builtin_amdgcn_sched_barrier(0);
    }
    __builtin_amdgcn_s_setprio(0);
    if (more) {
      if (KDMA) {
        asm volatile("s_waitcnt vmcnt(0)" ::: "memory");
      } else {
#pragma unroll
        for (int i = 0; i < NKC; ++i) {
          int c = tid + i * 256, r = c / (DQK / 8), kc = c % (DQK / 8);
          *(u32x4*)(Ks + r * LDK + ((kc ^ (r & SW)) * 8)) = kreg[i];
        }
      }
    }
    LBAR();
    if (more) {
#pragma unroll
      for (int i = 0; i < 4; ++i) {
        int c = tid + i * 256, r = c >> 3, kc = c & 7;
        *(u32x4*)(Vs + r * 72 + kc * 8) = vreg[i];
      }
    }
  }
#pragma unroll
  for (int sub = 0; sub < NSUB; ++sub) {
    float lt = lrow[sub];
    lt += __shfl_xor(lt, 16);
    lt += __shfl_xor(lt, 32);
    float inv = 1.f / lt;
    if (ML) {
      inv = 1.f;
      if (quad == 0) *(float2*)(ML + (size_t)(q0 + sub * 16 + l15) * 2) = make_float2(mrow[sub], lt);
    }
    u16* orow = O + (size_t)(q0 + sub * 16 + l15) * 128;
#pragma unroll
    for (int et = 0; et < 8; ++et) {
      uint2 o;
      o.x = pack2(oacc[et][sub][0] * inv, oacc[et][sub][1] * inv);
      o.y = pack2(oacc[et][sub][2] * inv, oacc[et][sub][3] * inv);
      *(uint2*)(orow + et * 16 + quad * 4) = o;
    }
  }
}

#define QB2 (128 / ATT_NSUB)
#define SC_CH 16
#define SC_STEPF 336
typedef float f32x2 __attribute__((ext_vector_type(2)));
struct ScStep { f32x2 kk0, kk1, w0, w1, b0, b1, k0, k1, r0, r1; float v; };
__device__ __forceinline__ ScStep sc_ld(const float* sb, int jg4, int vi) {
  ScStep x;
  f32x4 t;
  t = *(const f32x4*)(sb + jg4);       x.kk0 = t.xy; x.kk1 = t.zw;
  t = *(const f32x4*)(sb + 64 + jg4);  x.w0 = t.xy;  x.w1 = t.zw;
  t = *(const f32x4*)(sb + 128 + jg4); x.b0 = t.xy;  x.b1 = t.zw;
  t = *(const f32x4*)(sb + 192 + jg4); x.k0 = t.xy;  x.k1 = t.zw;
  t = *(const f32x4*)(sb + 256 + jg4); x.r0 = t.xy;  x.r1 = t.zw;
  x.v = sb[320 + vi];
  return x;
}
__device__ __forceinline__ void scan_unit(const Params p, int u, char* smem) {
  char* ws = p.ws;
  const int tid = ltid(), lane = tid & 63, w = tid >> 6;
  const int chain = u >> 2, rg = u & 3, n = chain >> 3, h = chain & 7;
  const int jg = lane & 15, rw = lane >> 4;
  float* buf = (float*)smem;
  const float* a0 = (const float*)(ws + OFF_SCKK) + h * 64;
  const float* a1 = (const float*)(ws + OFF_SCW) + (size_t)n * S_ * 512 + h * 64;
  const float* a2 = (const float*)(ws + OFF_SCB) + (size_t)n * S_ * 512 + h * 64;
  const float* a3 = (const float*)(ws + OFF_SCKD) + (size_t)n * S_ * 512 + h * 64;
  const float* a4 = (const float*)(ws + OFF_SCR) + h * 64;
  const float* vsrc = (const float*)(ws + OFF_SCV) + h * 64 + rg * 16;
  float* ydst = (float*)(ws + OFF_YS) + (size_t)n * S_ * 512 + h * 64 + rg * 16 + w * 4 + rw;

  const float* pb[6];
  int pst[6], pf[6];
#pragma unroll
  for (int i = 0; i < 6; ++i) {
    int f = min(tid + i * 256, SC_CH * 84 - 1);
    int st = f / 84, q = f % 84;
    int a = q >> 4;
    const float* base = a == 0 ? a0 : a == 1 ? a1 : a == 2 ? a2 : a == 3 ? a3 : a == 4 ? a4 : vsrc;
    pb[i] = base + (a < 5 ? (q & 15) * 4 : (q - 80) * 4);
    pst[i] = st;
    pf[i] = f * 4;
  }
  const int sdir = n ? -1 : 1, sbase = n ? (S_ - 1) : 0;
  const int nch = S_ / SC_CH;
  unsigned po[6];
#pragma unroll
  for (int i = 0; i < 6; ++i)
    po[i] = (unsigned)((const char*)(pb[i] + (size_t)(sbase + sdir * pst[i]) * 512) - (const char*)ws);
  const unsigned yo = (unsigned)((const char*)(ydst + (size_t)(sbase + sdir * jg) * 512) - (const char*)ws);
  const int cstep = sdir * SC_CH * 512 * 4;
  f32x4 lregA[6], lregB[6];
#define SC_LOAD(R, CH)                                                            \
  {                                                                               \
    const unsigned d_ = (unsigned)(min((CH), nch - 1) * cstep);                   \
    _Pragma("unroll") for (int i = 0; i < 6; ++i)                                 \
      R[i] = *(const f32x4*)((const char*)ws + (unsigned)(po[i] + d_));           \
  }
#define SC_STORE(R, B)                                                \
  _Pragma("unroll") for (int i = 0; i < 6; ++i) *(f32x4*)(buf + (B) * SC_CH * SC_STEPF + pf[i]) = R[i];

  f32x2 sA = {0.f, 0.f}, sB = {0.f, 0.f};
  const int jg4 = jg * 4, vi = w * 4 + rw;
#define SC_COMPUTE(C, B)                                                              \
  {                                                                                   \
    const float* cb = buf + (B) * SC_CH * SC_STEPF;                                   \
    float ykeep = 0.f;                                                                \
    ScStep cur = sc_ld(cb, jg4, vi);                                                  \
    ScStep nx1 = sc_ld(cb + SC_STEPF, jg4, vi);                                       \
    _Pragma("unroll") for (int st = 0; st < SC_CH; ++st) {                            \
      ScStep nx2 = nx1;                                                               \
      if (st + 2 < SC_CH) nx2 = sc_ld(cb + (st + 2) * SC_STEPF, jg4, vi);             \
      f32x2 sa2 = sA * cur.kk0 + sB * cur.kk1;                                        \
      f32x2 vv = {cur.v, cur.v};                                                      \
      f32x2 uA = sA * cur.w0 + vv * cur.k0;                                           \
      f32x2 uB = sB * cur.w1 + vv * cur.k1;                                           \
      float sa = row16_sum(sa2.x + sa2.y);                                            \
      f32x2 nsa = {-sa, -sa};                                                         \
      sA = uA + nsa * cur.b0;                                                         \
      sB = uB + nsa * cur.b1;                                                         \
      f32x2 y2 = sA * cur.r0 + sB * cur.r1;                                           \
      float y = row16_sum(y2.x + y2.y);                                               \
      ykeep = (jg == st) ? y : ykeep;                                                 \
      cur = nx1;                                                                      \
      nx1 = nx2;                                                                      \
    }                                                                                 \
    *(float*)((char*)ws + (unsigned)(yo + (unsigned)((C) * cstep))) = ykeep;          \
  }

  __syncthreads();
  __builtin_amdgcn_s_setprio(3);
  SC_LOAD(lregA, 0);
  SC_STORE(lregA, 0);
  SC_LOAD(lregB, 1);
  __syncthreads();
  for (int c = 0; c < nch; c += 2) {
    SC_LOAD(lregA, c + 2);
    SC_COMPUTE(c, 0);
    SC_STORE(lregB, 1);
    LBAR();
    SC_LOAD(lregB, c + 3);
    SC_COMPUTE(c + 1, 1);
    SC_STORE(lregA, 0);
    LBAR();
  }
  __builtin_amdgcn_s_setprio(0);
}

template <int ATM>
__device__ __forceinline__ void phase_attn_scan(const Params p, int l, char* smem) {
  char* ws = p.ws;
  __shared__ int s_item;
  if (ATM & 8) for (int u = lbid(); u < 64; u += gridDim.x) scan_unit(p, u, smem);
  if ((ATM & 8) && (DUP_MASK & 2)) for (int u = lbid(); u < 64; u += gridDim.x) scan_unit(p, u, smem);
  int* cnt = (int*)(ws + OFF_CNT) + l * 4;
  const int* pos = (const int*)p.in[I_POS];
  const int* kpmm = (const int*)(ws + OFF_KPMM);
  const u16* P = (const u16*)(ws + OFF_P);
  u16* OB = (u16*)(ws + OFF_OB);
#define NEXT_ITEM(CI, LIMIT)                                   \
    __syncthreads();                                           \
    if (ltid() == 0) s_item = atomicAdd(cnt + (CI), 1);   \
    __syncthreads();                                           \
    const int it = s_item;                                     \
    if (it >= (LIMIT)) break;
  u16* OB2 = (u16*)(ws + OFF_OB2);
  float* MLb = (float*)(ws + OFF_ML);
  const int flip = (blockIdx.x >> 8) & 1;
  for (int pass = 0; pass < 2; ++pass) {
  const int which = pass ^ flip;
  if (which == 0) {
  if (ATM & 1) while (true) {
    NEXT_ITEM(0, 512)
    int hh = it >> 6, qb = it & 63, h = hh >> 1, half = hh & 1;
    const int kv0 = half * (S_ / 2);
    attn_item<192, 2>((const u16*)(ws + OFF_QM) + (size_t)h * S_ * 192, 192,
                      (const u16*)(ws + OFF_KM) + ((size_t)h * S_ + kv0) * 192, 192,
                      (const u16*)(ws + OFF_VTM) + (size_t)h * 128 * S_ + kv0, S_, S_ / 2,
                      (half ? OB2 : OB) + (size_t)(8 + h) * S_ * 128, qb, false, nullptr, 0, pos, kpmm, smem, pos,
                      MLb + ((size_t)half * 16 + 8 + h) * S_ * 2);
  }
  } else {
  if (ATM & 2) while (true) {
    NEXT_ITEM(1, 16 * QB2)
    int pp = it / QB2, qb = it % QB2, pr = pp >> 1, half = pp & 1, h = pr >> 1, hf = pr & 1;
    const int kv0 = half * (S_ / 2);
    attn_item<64, ATT_NSUB>(P + O_DQ + h * 128 + hf * 64, NINP, P + (size_t)kv0 * NINP + O_DK + h * 128 + hf * 64, NINP,
                            (const u16*)(ws + OFF_VTD) + (size_t)h * 128 * S_ + kv0, S_, S_ / 2,
                            (half ? OB2 : OB) + (size_t)pr * S_ * 128, qb, true, (const float*)p.in[I_RELB], h, pos,
                            kpmm + (kv0 / 64) * 2, smem, pos + kv0, MLb + ((size_t)half * 16 + pr) * S_ * 2);
  }
  }
  }
  if (ATM & 4) while (true) {
    NEXT_ITEM(2, 4 * QB2)
    int h = it / QB2, qb = it % QB2;
    attn_item<128, ATT_NSUB>(P + O_MQ + h * 128, NINP, (const u16*)(ws + OFF_KMEM) + (size_t)(l * 4 + h) * 256 * 128, 128,
                             (const u16*)(ws + OFF_VTMEM) + (size_t)(l * 4 + h) * 128 * 256, 256, 256,
                             OB + (size_t)(12 + h) * S_ * 128, qb, false, nullptr, 0, pos, kpmm, smem, pos, nullptr);
  }
}

__device__ __forceinline__ void phase_combine(const Params p, int l, char* smem) {
  char* ws = p.ws;
  const int lane = ltid() & 63, w = ltid() >> 6;
  const float lam_init = 0.8f - 0.6f * expf(-0.3f * (float)l);
  float lam;
  {
    const float* lq = (const float*)p.in[I_DLAM] + l * 256;
    float a = wave_sum(lq[lane] * lq[64 + lane]);
    float b = wave_sum(lq[128 + lane] * lq[192 + lane]);
    lam = expf(a) - expf(b) + lam_init;
  }
  const float* gng = (const float*)p.in[I_GNG] + l * 512;
  const float* gnb = (const float*)p.in[I_GNB] + l * 512;
  const float* subg = (const float*)p.in[I_DSUBG] + l * 128;
  const u16* P = (const u16*)(ws + OFF_P);
  const float* YS = (const float*)(ws + OFF_YS);
  const u16* OB = (const u16*)(ws + OFF_OB);
  const u16* OB2c = (const u16*)(ws + OFF_OB2);
  const float* MLp = (const float*)(ws + OFF_ML);
  u16* YG = (u16*)(ws + OFF_YG);
  for (int s = lbid() * 4 + w; s < S_; s += gridDim.x * 4) {
    const u16* grow = P + (size_t)s * NINP + O_G;
#pragma unroll
    for (int hp = 0; hp < 4; ++hp) {
      const int c = hp * 128 + 2 * lane, h = hp * 2 + (lane >> 5);
      const float2 ya = *(const float2*)(YS + (size_t)s * 512 + c);
      const float2 yb = *(const float2*)(YS + ((size_t)S_ + s) * 512 + c);
      float y0 = ya.x + yb.x, y1 = ya.y + yb.y;
      float sm = y0 + y1;
#pragma unroll
      for (int o = 16; o >= 1; o >>= 1) sm += __shfl_xor(sm, o);
      const float mu = sm * (1.f / 64);
      const float d0 = y0 - mu, d1 = y1 - mu;
      float vs = d0 * d0 + d1 * d1;
#pragma unroll
      for (int o = 16; o >= 1; o >>= 1) vs += __shfl_xor(vs, o);
      const float rstd = rsqrtf(vs * (1.f / 64) + 64e-5f);
      const float2 gg = *(const float2*)(gng + c), gb = *(const float2*)(gnb + c);
      const float bon = ((const float*)(ws + OFF_BONUS))[s * 8 + h];
      const float2 vv = *(const float2*)((const float*)(ws + OFF_SCV) + (size_t)s * 512 + c);
      float o0 = d0 * rstd * gg.x + gb.x + bon * vv.x;
      float o1 = d1 * rstd * gg.y + gb.y + bon * vv.y;
      const unsigned gt = *(const unsigned*)(grow + c);
      const float g0 = lo2f(gt), g1 = hi2f(gt);
      *(unsigned*)(YG + (size_t)s * 512 + c) = pack2(o0 * g0 * sigmoidf_(g0), o1 * g1 * sigmoidf_(g1));
    }
#define MERGE_LOAD(PR, A, B)                                                                   \
    {                                                                                          \
      const float2 ml0 = *(const float2*)(MLp + ((size_t)(PR) * S_ + s) * 2);                  \
      const float2 ml1 = *(const float2*)(MLp + ((size_t)(16 + (PR)) * S_ + s) * 2);           \
      const float mm = fmaxf(ml0.x, ml1.x);                                                    \
      const float w0 = __builtin_amdgcn_exp2f(ml0.x - mm), w1 = __builtin_amdgcn_exp2f(ml1.x - mm); \
      const float inv = __builtin_amdgcn_rcpf(w0 * ml0.y + w1 * ml1.y);                        \
      const unsigned q0 = *(const unsigned*)(OB + ((size_t)(PR) * S_ + s) * 128 + 2 * lane);   \
      const unsigned q1 = *(const unsigned*)(OB2c + ((size_t)(PR) * S_ + s) * 128 + 2 * lane); \
      A = (w0 * lo2f(q0) + w1 * lo2f(q1)) * inv;                                               \
      B = (w0 * hi2f(q0) + w1 * hi2f(q1)) * inv;                                               \
    }
#pragma unroll
    for (int h = 0; h < 4; ++h) {
      float a1, b1, a2, b2;
      MERGE_LOAD(h * 2, a1, b1)
      MERGE_LOAD(h * 2 + 1, a2, b2)
      float a = a1 - lam * a2, b = b1 - lam * b2;
      float ss = wave_sum(a * a + b * b);
      float rs = rsqrtf(ss * (1.f / 128) + 1e-6f) * (1.f - lam_init);
      const unsigned gg = *(const unsigned*)(grow + 512 + h * 128 + 2 * lane);
      float g0 = lo2f(gg), g1 = hi2f(gg);
      const float2 sg = *(const float2*)(subg + 2 * lane);
      u16* dst = YG + ((size_t)S_ + s) * 512 + h * 128;
      *(unsigned*)(dst + 2 * lane) = pack2(a * rs * sg.x * g0 * sigmoidf_(g0), b * rs * sg.y * g1 * sigmoidf_(g1));
    }
#pragma unroll
    for (int br = 2; br < 4; ++br) {
#pragma unroll
      for (int h = 0; h < 4; ++h) {
        float oa, ob;
        if (br == 2) {
          MERGE_LOAD(8 + h, oa, ob)
        } else {
          const unsigned o = *(const unsigned*)(OB + ((size_t)(12 + h) * S_ + s) * 128 + 2 * lane);
          oa = lo2f(o);
          ob = hi2f(o);
        }
        const unsigned gg = *(const unsigned*)(grow + br * 512 + h * 128 + 2 * lane);
        float g0 = lo2f(gg), g1 = hi2f(gg);
        u16* dst = YG + ((size_t)br * S_ + s) * 512 + h * 128;
        *(unsigned*)(dst + 2 * lane) = pack2(oa * g0 * sigmoidf_(g0), ob * g1 * sigmoidf_(g1));
      }
    }
#undef MERGE_LOAD
  }
}

#define XB_TMO      128
#define XB_XCNT(j)  (256  + 64 * (j))
#define XB_XSUB(j)  (1280 + 64 * (j))
#define XB_XGEN(j)  (2304 + 64 * (j))
#define XB_TOP      3328
#define XB_TOPGEN   3392
#define XCD_BAR_WORDS 3456
#define XB_SPIN_CAP (1u << 22)
#define LAS __attribute__((address_space(3)))
__device__ __forceinline__ unsigned xb_ld(unsigned* p)              { return __hip_atomic_load(p, __ATOMIC_RELAXED, __HIP_MEMORY_SCOPE_AGENT); }
__device__ __forceinline__ unsigned xb_add(unsigned* p, unsigned v) { return __hip_atomic_fetch_add(p, v, __ATOMIC_RELAXED, __HIP_MEMORY_SCOPE_AGENT); }
__device__ __forceinline__ unsigned xb_xcc_id() { return (unsigned)__builtin_amdgcn_s_getreg((3 << 11) | 20) & 0xFu; }
#define XB_SPIN(cond, bar) do { unsigned _sp = 0; while (cond) { __builtin_amdgcn_s_sleep(1); \
    if ((++_sp & 255u) == 0u) { if (xb_ld(&(bar)[XB_TMO])) break; if (_sp > XB_SPIN_CAP) { atomicAdd(&(bar)[XB_TMO], 1u); break; } } } } while (0)
struct XcdBarrier { unsigned* bar; unsigned x; volatile LAS unsigned* st; };
__device__ __forceinline__ XcdBarrier xcd_barrier_post(unsigned* bar, volatile LAS unsigned* st) {
  XcdBarrier b; b.bar = bar; b.x = xb_xcc_id(); b.st = st;
  if (threadIdx.x == 0) (void)xb_add(&bar[XB_XCNT(b.x)], 1u);
  return b;
}
__device__ __forceinline__ void xcd_barrier_complete(unsigned* bar, unsigned x, unsigned& nloc, unsigned& nx) {
  const unsigned G = gridDim.x * gridDim.y * gridDim.z;
  unsigned sum, cnt, mine, sp = 0u;
  for (;;) {
    sum = 0u; cnt = 0u; mine = 0u;
#pragma unroll
    for (unsigned j = 0; j < 16; ++j) { const unsigned c = xb_ld(&bar[XB_XCNT(j)]); sum += c; cnt += (c > 0u) ? 1u : 0u; mine = (j == x) ? c : mine; }
    if (sum == G) break;
    __builtin_amdgcn_s_sleep(1);
    if ((++sp & 255u) == 0u) { if (xb_ld(&bar[XB_TMO])) break; if (sp > XB_SPIN_CAP) { atomicAdd(&bar[XB_TMO], 1u); break; } }
  }
  nloc = mine > 0u ? mine : 1u; nx = cnt > 0u ? cnt : 1u;
}
__device__ __forceinline__ void xcd_barrier(const XcdBarrier& b) {
  asm volatile("s_waitcnt vmcnt(0)" ::: "memory");
  __syncthreads();
  if (threadIdx.x == 0) {
    unsigned* bar = b.bar;
    __builtin_amdgcn_s_waitcnt(0);
    unsigned nloc = b.st[0], nx = b.st[1];
    if (nloc == 0u) { xcd_barrier_complete(bar, b.x, nloc, nx); b.st[0] = nloc; b.st[1] = nx; }
    const unsigned old = xb_add(&bar[XB_XSUB(b.x)], 1u);
    const unsigned gen = old / nloc;
    if (old + 1u == (gen + 1u) * nloc) {
      __builtin_amdgcn_fence(__ATOMIC_RELEASE, "agent");
      asm volatile("s_waitcnt vmcnt(0)" ::: "memory");
      const unsigned og = xb_add(&bar[XB_TOP], 1u);
      const unsigned tg = og / nx;
      if (og + 1u == (tg + 1u) * nx) xb_add(&bar[XB_TOPGEN], 1u);
      else XB_SPIN(xb_ld(&bar[XB_TOPGEN]) == tg, bar);
      __builtin_amdgcn_fence(__ATOMIC_ACQUIRE, "agent");
      xb_add(&bar[XB_XGEN(b.x)], 1u);
      asm volatile("s_waitcnt vmcnt(0)" ::: "memory");
    } else {
      XB_SPIN(xb_ld(&bar[XB_XGEN(b.x)]) == gen, bar);
      __builtin_amdgcn_fence(__ATOMIC_ACQUIRE, "agent");
      asm volatile("s_waitcnt vmcnt(0)" ::: "memory");
    }
  }
  __syncthreads();
}

#define N_PHASES (1 + 9 * L_)

__global__ void __launch_bounds__(256, 2) mega(Params p, int ph_lo, int ph_hi) {
  __shared__ __attribute__((aligned(16))) char smem[SMEM_BYTES];
  cg::grid_group grid = cg::this_grid();
  __shared__ uint4 xb_words;
  if (threadIdx.x == 0) xb_words = make_uint4(0u, 0u, 0u, 0u);
  __syncthreads();
  XcdBarrier xb = xcd_barrier_post((unsigned*)(p.ws + OFF_BAR), (volatile LAS unsigned*)&xb_words);
  __shared__ int s_vbid, s_cand;
  if (threadIdx.x == 0) {
    int my_j = (int)xb_add((unsigned*)(p.ws + OFF_BAR) + 8 * xb.x, 1u);
    s_cand = my_j * 8 + (int)xb.x;
    s_vbid = blockIdx.x;
  }
#define VB s_vbid
  for (int ph = ph_lo; ph < ph_hi; ++ph) {
    if (ph == 0) {
      if (PH_MASK & 1) phase_w(p, smem);
    } else {
      int l = (ph - 1) / 9, sp = (ph - 1) % 9;
      switch (sp) {
        case 0: if (PH_MASK & 2) phase_gemm_in(p, l, smem, VB);
          if (DUP_MASK & 1) { __syncthreads(); phase_gemm_in(p, l, smem, VB); }
          break;
        case 1: if (PH_MASK & 4) phase_prep<false>(p, l, smem);
          if (DUP_MASK & 256) { __syncthreads(); phase_prep<true>(p, l, smem); }
          break;
        case 2: if (PH_MASK & 8) phase_gemm_mla(p, l, smem, VB);
          if (DUP_MASK & 16) { __syncthreads(); phase_gemm_mla(p, l, smem, VB); }
          break;
        case 3: if (PH_MASK & 16) phase_mla_post(p, l, smem);
          if (DUP_MASK & 32) { __syncthreads(); phase_mla_post(p, l, smem); }
          break;
        case 4: if (PH_MASK & 32) phase_attn_scan<AT_MASK>(p, l, smem); break;
        case 5: if (PH_MASK & 64) phase_combine(p, l, smem);
          if (DUP_MASK & 64) { __syncthreads(); phase_combine(p, l, smem); }
          break;
        case 6: if (PH_MASK & 128) phase_gemm_branch(p, l, smem, VB);
          if (DUP_MASK & 4) { __syncthreads(); phase_gemm_branch(p, l, smem, VB); }
          break;
        case 7: if (PH_MASK & 256) phase_gemm_out(p, l, smem, VB); break;
        case 8:
          if (l + 1 < L_) rms_rows<true>((const float*)p.out, S_, (const float*)p.in[I_NORMG] + (l + 1) * D_, (u16*)(p.ws + OFF_H));
          if ((DUP_MASK & 128) && l + 1 < L_) rms_rows<true>((const float*)p.out, S_, (const float*)p.in[I_NORMG] + (l + 1) * D_, (u16*)(p.ws + OFF_H));
          break;
      }
    }
#undef VB
    if (ph + 1 < ph_hi) {
      if (ph == ph_lo) {
        if (ph_hi < 0) grid.sync();
        xcd_barrier(xb);
        if (threadIdx.x == 0 && gridDim.x == 512) {
          bool ok = true;
          for (int j = 0; j < 8; ++j) ok = ok && (xb_ld((unsigned*)(p.ws + OFF_BAR) + 8 * j) == 64u);
          if (ok && xb.x < 8u) s_vbid = s_cand;
        }
        __syncthreads();
      } else xcd_barrier(xb);
    }
  }
}

template <int SP, int ATM>
__global__ void __launch_bounds__(256, 2) k_phase(Params p, int l) {
  __shared__ __attribute__((aligned(16))) char smem[SMEM_BYTES];
  const int VB = blockIdx.x;
  if (SP == -1) phase_w(p, smem);
  if (SP == 0) phase_gemm_in(p, l, smem, VB);
  if (SP == 1) phase_prep<false>(p, l, smem);
  if (SP == 2) phase_gemm_mla(p, l, smem, VB);
  if (SP == 3) phase_mla_post(p, l, smem);
  if (SP == 4) phase_attn_scan<ATM>(p, l, smem);
  if (SP == 5) phase_combine(p, l, smem);
  if (SP == 6) phase_gemm_branch(p, l, smem, VB);
  if (SP == 7) phase_gemm_out(p, l, smem, VB);
  if (SP == 8) rms_rows<true>((const float*)p.out, S_, (const float*)p.in[I_NORMG] + (l + 1) * D_, (u16*)(p.ws + OFF_H));
}

extern "C" void kernel_launch(void* const* d_in, const int* in_sizes, int n_in, void* d_out, int out_size, void* d_ws,
                              size_t ws_size, hipStream_t stream) {
  static int grid_blocks = 0;
  if (!grid_blocks) {
    int dev = 0, cus = 0, per_cu = 0;
    hipGetDevice(&dev);
    hipDeviceGetAttribute(&cus, hipDeviceAttributeMultiprocessorCount, dev);
    hipOccupancyMaxActiveBlocksPerMultiprocessor(&per_cu, mega, 256, 0);
    if (per_cu > 2) per_cu = 2;
    if (per_cu < 1) per_cu = 1;
    grid_blocks = cus * per_cu;
  }
  Params p{};
  for (int i = 0; i < N_INPUTS; ++i) p.in[i] = d_in[i];
  p.out = (float*)d_out;
  p.ws = (char*)d_ws;
  if (ws_size < WS_TOTAL) fprintf(stderr, "workspace too small: %zu < %zu\n", ws_size, (size_t)WS_TOTAL);
#if MULTI_LAUNCH
  const int G = grid_blocks;
  hipLaunchKernelGGL((k_phase<-1, 0>), dim3(G), dim3(256), 0, stream, p, 0);
  for (int l = 0; l < L_; ++l) {
    hipLaunchKernelGGL((k_phase<0, 0>), dim3(G), dim3(256), 0, stream, p, l);
    hipLaunchKernelGGL((k_phase<1, 0>), dim3(G), dim3(256), 0, stream, p, l);
    hipLaunchKernelGGL((k_phase<2, 0>), dim3(G), dim3(256), 0, stream, p, l);
    hipLaunchKernelGGL((k_phase<3, 0>), dim3(G), dim3(256), 0, stream, p, l);
    hipLaunchKernelGGL((k_phase<4, 8>), dim3(64), dim3(256), 0, stream, p, l);
    hipLaunchKernelGGL((k_phase<4, 1>), dim3(G), dim3(256), 0, stream, p, l);
    hipLaunchKernelGGL((k_phase<4, 2>), dim3(G), dim3(256), 0, stream, p, l);
    hipLaunchKernelGGL((k_phase<4, 4>), dim3(G), dim3(256), 0, stream, p, l);
    hipLaunchKernelGGL((k_phase<5, 0>), dim3(G), dim3(256), 0, stream, p, l);
    hipLaunchKernelGGL((k_phase<6, 0>), dim3(G), dim3(256), 0, stream, p, l);
    hipLaunchKernelGGL((k_phase<7, 0>), dim3(G), dim3(256), 0, stream, p, l);
    if (l + 1 < L_) hipLaunchKernelGGL((k_phase<8, 0>), dim3(G), dim3(256), 0, stream, p, l);
  }
#else
  hipMemsetAsync((char*)d_ws + OFF_BAR, 0, 3456 * 4, stream);
  int lo = 0, hi = N_PHASES - 1;
  void* args[] = {&p, &lo, &hi};
  hipError_t e = hipLaunchCooperativeKernel((void*)mega, dim3(grid_blocks), dim3(256), args, 0, stream);
  if (e != hipSuccess) fprintf(stderr, "cooperative launch failed: %s (grid %d)\n", hipGetErrorString(e), grid_blocks);
#endif
}
```

```cpp
#include <hip/hip_runtime.h>
#include <hip/hip_cooperative_groups.h>
#include <cstdio>
namespace cg = cooperative_groups;

typedef unsigned short u16;
typedef __attribute__((ext_vector_type(8))) short bf16x8;
typedef __attribute__((ext_vector_type(4))) float f32x4;
typedef __attribute__((ext_vector_type(4))) unsigned int u32x4;
typedef __attribute__((ext_vector_type(2))) unsigned int u32x2;

#ifndef MULTI_LAUNCH
#define MULTI_LAUNCH 0
#endif
#ifndef DUP_MASK
#define DUP_MASK 0
#endif
#ifndef ATT_NSUB
#define ATT_NSUB 2
#endif
#ifndef AT_MASK
#define AT_MASK 15
#endif
#ifndef PH_MASK
#if MULTI_LAUNCH
#define PH_MASK 0
#else
#define PH_MASK 0xffff
#endif
#endif


#define LOG2E 1.4426950408889634f
#define S_ 8192
#define D_ 2048
#define NIN 14784
#define NINP 14848
#define L_ 4
#define O_DQ 1792
#define O_DK 2304
#define O_DV 2816
#define O_QL 3328
#define O_KVL 3712
#define O_KR 3968
#define O_MQ 4032
#define O_G 4544
#define O_MG 6592

enum { I_X = 0, I_MEM, I_POS, I_NORMG, I_WIN, I_SHIFT, I_W0, I_WUP, I_A0, I_AUP, I_KK, I_KA, I_RK, I_GNG, I_GNB,
       I_DQKG, I_DLAM, I_DSUBG, I_RELB, I_QLATG, I_KVLATG, I_WUQ, I_WUKV, I_NOPEG, I_ROPEG, I_MEMNG, I_WKV,
       I_MQKG, I_WBR, I_WOUT, N_INPUTS };

struct Params {
  const void* in[N_INPUTS];
  float* out;
  char* ws;
};

constexpr size_t al(size_t x) { return (x + 255) & ~(size_t)255; }
constexpr size_t OFF_WIN = 0;
constexpr size_t OFF_WB = OFF_WIN + al((size_t)L_ * NINP * D_ * 2);
constexpr size_t OFF_WO = OFF_WB + al((size_t)L_ * 4 * 2048 * 512 * 2);
constexpr size_t OFF_WUQ = OFF_WO + al((size_t)L_ * 2048 * 2048 * 2);
constexpr size_t OFF_WUKV = OFF_WUQ + al((size_t)L_ * 768 * 384 * 2);
constexpr size_t OFF_WKV = OFF_WUKV + al((size_t)L_ * 1024 * 256 * 2);
constexpr size_t OFF_MEMN = OFF_WKV + al((size_t)L_ * 1024 * 2048 * 2);
constexpr size_t OFF_KVMEM = OFF_MEMN + al((size_t)L_ * 256 * 2048 * 2);
constexpr size_t OFF_KMEM = OFF_KVMEM + al((size_t)L_ * 256 * 512 * 4);
constexpr size_t OFF_VTMEM = OFF_KMEM + al((size_t)L_ * 4 * 256 * 128 * 2);
constexpr size_t OFF_H = OFF_VTMEM + al((size_t)L_ * 4 * 128 * 256 * 2);
constexpr size_t OFF_P = OFF_H + al((size_t)S_ * D_ * 2);
constexpr size_t OFF_RWU = OFF_P + al((size_t)S_ * NINP * 2);
constexpr size_t OFF_SCR = OFF_RWU + al((size_t)S_ * 1792 * 4);
constexpr size_t OFF_SCV = OFF_SCR + al((size_t)S_ * 512 * 4);
constexpr size_t OFF_SCKK = OFF_SCV + al((size_t)S_ * 512 * 4);
constexpr size_t OFF_SCW = OFF_SCKK + al((size_t)S_ * 512 * 4);
constexpr size_t OFF_SCKD = OFF_SCW + al((size_t)2 * S_ * 512 * 4);
constexpr size_t OFF_SCB = OFF_SCKD + al((size_t)2 * S_ * 512 * 4);
constexpr size_t OFF_BONUS = OFF_SCB + al((size_t)2 * S_ * 512 * 4);
constexpr size_t OFF_YS = OFF_BONUS + al((size_t)S_ * 8 * 4);
constexpr size_t OFF_MQ = OFF_YS + al((size_t)2 * S_ * 512 * 4);
constexpr size_t OFF_MKV = OFF_MQ + al((size_t)S_ * 768 * 4);
constexpr size_t OFF_QM = OFF_MKV + al((size_t)S_ * 512 * 4);
constexpr size_t OFF_KM = OFF_QM + al((size_t)4 * S_ * 192 * 2);
constexpr size_t OFF_VTM = OFF_KM + al((size_t)4 * S_ * 192 * 2);
constexpr size_t OFF_VTD = OFF_VTM + al((size_t)4 * 128 * S_ * 2);
constexpr size_t OFF_OB = OFF_VTD + al((size_t)4 * 128 * S_ * 2);
constexpr size_t OFF_YG = OFF_OB + al((size_t)16 * S_ * 128 * 4);
constexpr size_t OFF_Z = OFF_YG + al((size_t)4 * S_ * 512 * 2);
constexpr size_t OFF_CNT = OFF_Z + al((size_t)S_ * D_ * 2);
constexpr size_t OFF_KPMM = OFF_CNT + 256;
constexpr size_t OFF_BAR = OFF_KPMM + 1024;
constexpr size_t OFF_OB2 = OFF_BAR + al(3456 * 4);
constexpr size_t OFF_ML = OFF_OB2 + al((size_t)16 * S_ * 128 * 4);
constexpr size_t WS_TOTAL = OFF_ML + (size_t)2 * 16 * S_ * 2 * 4;

#define SMEM_BYTES 49152

#define LBAR() asm volatile("s_waitcnt lgkmcnt(0)\n\ts_barrier" ::: "memory")
__device__ __forceinline__ int ltid() {
  int t = __builtin_amdgcn_workitem_id_x();
  asm volatile("" : "+v"(t));
  return t;
}
__device__ __forceinline__ int lbid() {
  int t = __builtin_amdgcn_workgroup_id_x();
  asm volatile("" : "+s"(t));
  return t;
}
typedef float f32x2_ __attribute__((ext_vector_type(2)));
typedef __bf16 bf16x2_ __attribute__((ext_vector_type(2)));
__device__ __forceinline__ unsigned pack2(float a, float b) {
  f32x2_ v = {a, b};
  return __builtin_bit_cast(unsigned, __builtin_convertvector(v, bf16x2_));
}
__device__ __forceinline__ u16 f2bf(float f) { return (u16)(pack2(f, 0.f) & 0xffffu); }
__device__ __forceinline__ float bf2f(u16 h) { return __uint_as_float(((unsigned)h) << 16); }
__device__ __forceinline__ float lo2f(unsigned u) { return __uint_as_float(u << 16); }
__device__ __forceinline__ float hi2f(unsigned u) { return __uint_as_float(u & 0xffff0000u); }
__device__ __forceinline__ float sigmoidf_(float x) {
  return __builtin_amdgcn_rcpf(1.f + __builtin_amdgcn_exp2f(-1.4426950408889634f * x));
}
__device__ __forceinline__ float wave_sum(float v) {
#pragma unroll
  for (int o = 32; o >= 1; o >>= 1) v += __shfl_xor(v, o);
  return v;
}
template <int CTRL>
__device__ __forceinline__ float dpp_add(float x) {
  return x + __int_as_float(__builtin_amdgcn_update_dpp(0, __float_as_int(x), CTRL, 0xf, 0xf, true));
}
__device__ __forceinline__ float row16_sum(float x) {
  x = dpp_add<0xB1>(x);
  x = dpp_add<0x4E>(x);
  x = dpp_add<0x141>(x);
  x = dpp_add<0x140>(x);
  return x;
}

template <bool SW>
__device__ __forceinline__ void gemm_main1(const u16* __restrict__ A, int lda, const u16* __restrict__ B, int ldb,
                                          int K, u16* As, u16* Bs, f32x4 (&acc)[4][4]) {
  const int tid = ltid(), lane = tid & 63, w = tid >> 6, l15 = lane & 15, quad = lane >> 4;
  const int wm = w >> 1, wn = w & 1;
  u32x4 ra[4], rb[4];
#pragma unroll
  for (int i = 0; i < 4; ++i) {
    int c = tid + i * 256, r = c >> 3, kc = c & 7;
    ra[i] = *(const u32x4*)(A + (size_t)r * lda + kc * 8);
    rb[i] = *(const u32x4*)(B + (size_t)r * ldb + kc * 8);
  }
  for (int k0 = 0; k0 < K; k0 += 64) {
    LBAR();
#pragma unroll
    for (int i = 0; i < 4; ++i) {
      int c = tid + i * 256, r = c >> 3, kc = c & 7;
      *(u32x4*)(As + r * 64 + ((kc ^ (r & 7)) * 8)) = ra[i];
      *(u32x4*)(Bs + r * 64 + ((kc ^ (r & 7)) * 8)) = rb[i];
    }
    LBAR();
    {
      const int kn = min(k0 + 64, K - 64);
#pragma unroll
      for (int i = 0; i < 4; ++i) {
        int c = tid + i * 256, r = c >> 3, kc = c & 7;
        ra[i] = *(const u32x4*)(A + (size_t)r * lda + kn + kc * 8);
        rb[i] = *(const u32x4*)(B + (size_t)r * ldb + kn + kc * 8);
      }
    }
#pragma unroll
    for (int ks = 0; ks < 2; ++ks) {
      bf16x8 af[4], bfr[4];
#pragma unroll
      for (int i = 0; i < 4; ++i) {
        af[i] = *(const bf16x8*)(As + (wm * 64 + i * 16 + l15) * 64 + (((ks * 4 + quad) ^ (l15 & 7)) * 8));
        bfr[i] = *(const bf16x8*)(Bs + (wn * 64 + i * 16 + l15) * 64 + (((ks * 4 + quad) ^ (l15 & 7)) * 8));
      }
#pragma unroll
      for (int i = 0; i < 4; ++i)
#pragma unroll
        for (int j = 0; j < 4; ++j) acc[i][j] = SW ? __builtin_amdgcn_mfma_f32_16x16x32_bf16(bfr[j], af[i], acc[i][j], 0, 0, 0)
                                                     : __builtin_amdgcn_mfma_f32_16x16x32_bf16(af[i], bfr[j], acc[i][j], 0, 0, 0);
    }
  }
}

template <bool SW>
__device__ __forceinline__ void gemm_main(const u16* __restrict__ A, int lda, const u16* __restrict__ B, int ldb,
                                          int K, u16* As, u16* Bs, f32x4 (&acc)[4][4]) {
  const int tid = ltid(), lane = tid & 63, w = tid >> 6, l15 = lane & 15, quad = lane >> 4;
  const int wm = w >> 1, wn = w & 1;
  u32x4 ra0[4], rb0[4], ra1[4], rb1[4];
  const u16* Ap = A + (size_t)(tid >> 3) * lda + (tid & 7) * 8;
  const u16* Bp = B + (size_t)(tid >> 3) * ldb + (tid & 7) * 8;
  const size_t sa = (size_t)32 * lda, sb = (size_t)32 * ldb;
#define G_LOAD(RA, RB, KK)                                            \
  {                                                                   \
    const int kk_ = min((KK), K - 64);                                \
    _Pragma("unroll") for (int i = 0; i < 4; ++i) {                   \
      RA[i] = *(const u32x4*)(Ap + i * sa + kk_);                     \
      RB[i] = *(const u32x4*)(Bp + i * sb + kk_);                     \
    }                                                                 \
  }
#define G_STAGE(RA, RB, KNEXT)                                                                   \
  {                                                                                              \
    LBAR();                                                                             \
    _Pragma("unroll") for (int i = 0; i < 4; ++i) {                                              \
      *(u32x4*)(As + ((tid >> 3) + i * 32) * 64 + (((tid & 7) ^ ((tid >> 3) & 7)) * 8)) = RA[i]; \
      *(u32x4*)(Bs + ((tid >> 3) + i * 32) * 64 + (((tid & 7) ^ ((tid >> 3) & 7)) * 8)) = RB[i]; \
    }                                                                                            \
    LBAR();                                                                             \
    G_LOAD(RA, RB, KNEXT)                                                                        \
    {                                                                                            \
      bf16x8 af[2][4], bfr[2][4];                                                                \
      _Pragma("unroll") for (int ks = 0; ks < 2; ++ks)                                           \
        _Pragma("unroll") for (int i = 0; i < 4; ++i) {                                          \
          af[ks][i] = *(const bf16x8*)(As + (wm * 64 + i * 16 + l15) * 64 + (((ks * 4 + quad) ^ (l15 & 7)) * 8));  \
          bfr[ks][i] = *(const bf16x8*)(Bs + (wn * 64 + i * 16 + l15) * 64 + (((ks * 4 + quad) ^ (l15 & 7)) * 8)); \
        }                                                                                        \
      __builtin_amdgcn_sched_barrier(0);                                                         \
      _Pragma("unroll") for (int ks = 0; ks < 2; ++ks)                                           \
        _Pragma("unroll") for (int i = 0; i < 4; ++i)                                            \
          _Pragma("unroll") for (int j = 0; j < 4; ++j)                                          \
            acc[i][j] = SW ? __builtin_amdgcn_mfma_f32_16x16x32_bf16(bfr[ks][j], af[ks][i], acc[i][j], 0, 0, 0) \
                           : __builtin_amdgcn_mfma_f32_16x16x32_bf16(af[ks][i], bfr[ks][j], acc[i][j], 0, 0, 0); \
    }                                                                                            \
  }
  G_LOAD(ra0, rb0, 0)
  G_LOAD(ra1, rb1, 64)
  for (int k0 = 0; k0 < K; k0 += 128) {
    G_STAGE(ra0, rb0, k0 + 128)
    G_STAGE(ra1, rb1, k0 + 192)
  }
#undef G_LOAD
#undef G_STAGE
}

__device__ __forceinline__ void gemm_main_blk(const u16* __restrict__ A, const u16* __restrict__ B,
                                          int K, u16* As, u16* Bs, f32x4 (&acc)[4][4]) {
  const int tid = ltid(), lane = tid & 63, w = tid >> 6, l15 = lane & 15, quad = lane >> 4;
  const int wm = w >> 1, wn = w & 1;
  u32x4 ra0[4], rb0[4], ra1[4], rb1[4];
  const u16* Ap = A + tid * 8;
  const u16* Bp = B + tid * 8;
#define G_LOAD(RA, RB, KK)                                            \
  {                                                                   \
    const int kk_ = min((KK), K - 64);                                \
    _Pragma("unroll") for (int i = 0; i < 4; ++i) {                   \
      RA[i] = *(const u32x4*)(Ap + (size_t)kk_ * 128 + i * 2048);    \
      RB[i] = *(const u32x4*)(Bp + (size_t)kk_ * 128 + i * 2048);    \
    }                                                                 \
  }
#define G_STAGE(RA, RB, KNEXT)                                                                   \
  {                                                                                              \
    LBAR();                                                                             \
    _Pragma("unroll") for (int i = 0; i < 4; ++i) {                                              \
      *(u32x4*)(As + i * 2048 + tid * 8) = RA[i];                                                \
      *(u32x4*)(Bs + i * 2048 + tid * 8) = RB[i];                                                \
    }                                                                                            \
    LBAR();                                                                             \
    G_LOAD(RA, RB, KNEXT)                                                                        \
    {                                                                                            \
      bf16x8 af[2][4], bfr[2][4];                                                                \
      _Pragma("unroll") for (int ks = 0; ks < 2; ++ks)                                           \
        _Pragma("unroll") for (int i = 0; i < 4; ++i) {                                          \
          af[ks][i] = *(const bf16x8*)(As + (wm * 64 + i * 16 + l15) * 64 + (((ks * 4 + quad) ^ (l15 & 7)) * 8));  \
          bfr[ks][i] = *(const bf16x8*)(Bs + (wn * 64 + i * 16 + l15) * 64 + (((ks * 4 + quad) ^ (l15 & 7)) * 8)); \
        }                                                                                        \
      __builtin_amdgcn_sched_barrier(0);                                                         \
      _Pragma("unroll") for (int ks = 0; ks < 2; ++ks)                                           \
        _Pragma("unroll") for (int i = 0; i < 4; ++i)                                            \
          _Pragma("unroll") for (int j = 0; j < 4; ++j)                                          \
            acc[i][j] = __builtin_amdgcn_mfma_f32_16x16x32_bf16(af[ks][i], bfr[ks][j], acc[i][j], 0, 0, 0); \
    }                                                                                            \
  }
  G_LOAD(ra0, rb0, 0)
  G_LOAD(ra1, rb1, 64)
  for (int k0 = 0; k0 < K; k0 += 128) {
    G_STAGE(ra0, rb0, k0 + 128)
    G_STAGE(ra1, rb1, k0 + 192)
  }
#undef G_LOAD
#undef G_STAGE
}

#define ZERO_ACC(acc)                                  \
  _Pragma("unroll") for (int i_ = 0; i_ < 4; ++i_)     \
  _Pragma("unroll") for (int j_ = 0; j_ < 4; ++j_) acc[i_][j_] = (f32x4){0.f, 0.f, 0.f, 0.f};

#define EPI_LOOP_T(BODY)                                                           \
  {                                                                                \
    const int lane_ = ltid() & 63, w_ = ltid() >> 6;                               \
    const int l15_ = lane_ & 15, quad_ = lane_ >> 4, wm_ = w_ >> 1, wn_ = w_ & 1;  \
    _Pragma("unroll") for (int i = 0; i < 4; ++i) {                                \
      _Pragma("unroll") for (int j = 0; j < 4; ++j) {                              \
        const int mr = wm_ * 64 + i * 16 + l15_;                                   \
        const int nc = wn_ * 64 + j * 16 + quad_ * 4;                              \
        BODY                                                                       \
      }                                                                            \
    }                                                                              \
  }

#define EPI_LOOP(BODY)                                                             \
  {                                                                                \
    const int lane_ = ltid() & 63, w_ = ltid() >> 6;                     \
    const int l15_ = lane_ & 15, quad_ = lane_ >> 4, wm_ = w_ >> 1, wn_ = w_ & 1;  \
    _Pragma("unroll") for (int i = 0; i < 4; ++i) {                                \
      _Pragma("unroll") for (int j = 0; j < 4; ++j) {                              \
        const int mr = wm_ * 64 + i * 16 + quad_ * 4;                              \
        const int nc = wn_ * 64 + j * 16 + l15_;                                   \
        BODY                                                                       \
      }                                                                            \
    }                                                                              \
  }

__device__ __forceinline__ void gemm_main_blk2(const u16* __restrict__ A, const u16* __restrict__ B, int K, u16* As, u16* Bs,
                                               f32x4 (&acc)[8][4]) {
  const int tid = ltid(), lane = tid & 63, w = tid >> 6, l15 = lane & 15, quad = lane >> 4;
  const int wm = w >> 1, wn = w & 1;
  u32x4 ra[8], rb[4];
  const char* Ab = (const char*)A;
  const char* A2b = (const char*)(A + (size_t)(K >> 6) * 8192);
  const char* Bb = (const char*)B;
  const unsigned lo = (unsigned)tid * 16u;
#define G2_LOAD(KK)                                                                   \
  {                                                                                   \
    const unsigned ko_ = (unsigned)min((KK), K - 64) * 256u;                          \
    _Pragma("unroll") for (int i = 0; i < 4; ++i) {                                   \
      ra[i] = *(const u32x4*)(Ab + (unsigned)(lo + ko_ + (unsigned)i * 4096u));       \
      ra[4 + i] = *(const u32x4*)(A2b + (unsigned)(lo + ko_ + (unsigned)i * 4096u));  \
      rb[i] = *(const u32x4*)(Bb + (unsigned)(lo + ko_ + (unsigned)i * 4096u));       \
    }                                                                                 \
  }
  G2_LOAD(0)
  for (int k0 = 0; k0 < K; k0 += 64) {
    LBAR();
#pragma unroll
    for (int i = 0; i < 8; ++i) *(u32x4*)(As + i * 2048 + tid * 8) = ra[i];
#pragma unroll
    for (int i = 0; i < 4; ++i) *(u32x4*)(Bs + i * 2048 + tid * 8) = rb[i];
    LBAR();
    G2_LOAD(k0 + 64)
#pragma unroll
    for (int ks = 0; ks < 2; ++ks) {
      bf16x8 af[8], bfr[4];
#pragma unroll
      for (int i = 0; i < 8; ++i)
        af[i] = *(const bf16x8*)(As + (wm * 128 + i * 16 + l15) * 64 + (((ks * 4 + quad) ^ (l15 & 7)) * 8));
#pragma unroll
      for (int j = 0; j < 4; ++j)
        bfr[j] = *(const bf16x8*)(Bs + (wn * 64 + j * 16 + l15) * 64 + (((ks * 4 + quad) ^ (l15 & 7)) * 8));
#pragma unroll
      for (int i = 0; i < 8; ++i)
#pragma unroll
        for (int j = 0; j < 4; ++j) acc[i][j] = __builtin_amdgcn_mfma_f32_16x16x32_bf16(af[i], bfr[j], acc[i][j], 0, 0, 0);
    }
  }
#undef G2_LOAD
}

#define EPI_LOOP8(BODY)                                                            \
  {                                                                                \
    const int lane_ = ltid() & 63, w_ = ltid() >> 6;                               \
    const int l15_ = lane_ & 15, quad_ = lane_ >> 4, wm_ = w_ >> 1, wn_ = w_ & 1;  \
    _Pragma("unroll") for (int i = 0; i < 8; ++i) {                                \
      _Pragma("unroll") for (int j = 0; j < 4; ++j) {                              \
        const int mr = wm_ * 128 + i * 16 + quad_ * 4;                             \
        const int nc = wn_ * 64 + j * 16 + l15_;                                   \
        BODY                                                                       \
      }                                                                            \
    }                                                                              \
  }

template <bool BLK>
__device__ __forceinline__ void transpose_tile(const float* __restrict__ src, int N, u16* __restrict__ dst, int K, int kt, int nt,
                               float* tile) {
  const int tid = ltid();
  __syncthreads();
  {
    int c = tid & 63, r0 = tid >> 6;
#pragma unroll
    for (int i = 0; i < 16; ++i) {
      int r = r0 + i * 4;
      tile[r * 65 + c] = src[(size_t)(kt * 64 + r) * N + nt * 64 + c];
    }
  }
  __syncthreads();
#pragma unroll
  for (int i = 0; i < 2; ++i) {
    int c = tid + i * 256, n = c >> 3, kc = c & 7;
    uint4 o;
    o.x = pack2(tile[(kc * 8 + 0) * 65 + n], tile[(kc * 8 + 1) * 65 + n]);
    o.y = pack2(tile[(kc * 8 + 2) * 65 + n], tile[(kc * 8 + 3) * 65 + n]);
    o.z = pack2(tile[(kc * 8 + 4) * 65 + n], tile[(kc * 8 + 5) * 65 + n]);
    o.w = pack2(tile[(kc * 8 + 6) * 65 + n], tile[(kc * 8 + 7) * 65 + n]);
    if (BLK) {
      const int ng = nt * 64 + n;
      *(uint4*)(dst + ((size_t)(ng >> 7) * (K >> 6) + kt) * 8192 + (ng & 127) * 64 + ((kc ^ (ng & 7)) * 8)) = o;
    } else {
      *(uint4*)(dst + (size_t)(nt * 64 + n) * K + kt * 64 + kc * 8) = o;
    }
  }
}

template <bool BLK>
__device__ __forceinline__ void rms_rows(const float* __restrict__ src, int nrows, const float* __restrict__ g, u16* __restrict__ dst) {
  const int lane = ltid() & 63, w = ltid() >> 6;
  for (int row = lbid() * 4 + w; row < nrows; row += gridDim.x * 4) {
    const float4* xr = (const float4*)(src + (size_t)row * D_);
    float4 v[8];
    float ss = 0.f;
#pragma unroll
    for (int i = 0; i < 8; ++i) {
      v[i] = xr[lane + i * 64];
      ss += v[i].x * v[i].x + v[i].y * v[i].y + v[i].z * v[i].z + v[i].w * v[i].w;
    }
    ss = wave_sum(ss);
    float rs = rsqrtf(ss * (1.f / D_) + 1e-6f);
#pragma unroll
    for (int i = 0; i < 8; ++i) {
      int col = (lane + i * 64) * 4;
      float4 gg = *(const float4*)(g + col);
      uint2 o;
      o.x = pack2(v[i].x * rs * gg.x, v[i].y * rs * gg.y);
      o.y = pack2(v[i].z * rs * gg.z, v[i].w * rs * gg.w);
      if (BLK) {
        *(uint2*)(dst + ((size_t)(row >> 7) * 32 + (col >> 6)) * 8192 + (row & 127) * 64 + ((((col & 63) >> 3) ^ (row & 7)) * 8) + (col & 7)) = o;
      } else {
        *(uint2*)(dst + (size_t)row * D_ + col) = o;
      }
    }
  }
}

__device__ __forceinline__ int t5_bucket(int rel) {
  int n = rel < 0 ? -rel : rel;
  int b;
  if (n < 8) b = n;
  else if (n < 12) b = 8;
  else if (n < 16) b = 9;
  else if (n < 23) b = 10;
  else if (n < 32) b = 11;
  else if (n < 46) b = 12;
  else if (n < 64) b = 13;
  else if (n < 91) b = 14;
  else b = 15;
  return (rel > 0 ? 16 : 0) + b;
}

__device__ __forceinline__ void phase_w(const Params p, char* smem) {
  const int tid = ltid();
  float* tile = (float*)smem;
  char* ws = p.ws;
  if (lbid() == 0 && tid < 64) ((int*)(ws + OFF_CNT))[tid] = 0;
  {
    const int lane = tid & 63, w = tid >> 6;
    const int* pos = (const int*)p.in[I_POS];
    for (int t = lbid() * 4 + w; t < 128; t += gridDim.x * 4) {
      int v = pos[t * 64 + lane], mn = v, mx = v;
#pragma unroll
      for (int o = 32; o >= 1; o >>= 1) {
        mn = min(mn, __shfl_xor(mn, o));
        mx = max(mx, __shfl_xor(mx, o));
      }
      if (lane == 0) {
        ((int*)(ws + OFF_KPMM))[t * 2] = mn;
        ((int*)(ws + OFF_KPMM))[t * 2 + 1] = mx;
      }
    }
  }
  for (int i = lbid() * 256 + tid; i < L_ * 32 * 512; i += gridDim.x * 256) {
    int l = i / (32 * 512), r = i % (32 * 512), kt = r >> 9, q = r & 511;
    *(uint4*)((u16*)(ws + OFF_WIN) + (size_t)l * NINP * D_ + ((size_t)115 * 32 + kt) * 8192 + 4096 + q * 8) = make_uint4(0, 0, 0, 0);
  }
  rms_rows<true>((const float*)p.in[I_X], S_, (const float*)p.in[I_NORMG], (u16*)(ws + OFF_H));
  for (int l = 0; l < L_; ++l)
    rms_rows<false>((const float*)p.in[I_MEM], 256, (const float*)p.in[I_MEMNG] + l * D_, (u16*)(ws + OFF_MEMN) + (size_t)l * 256 * D_);
  const int PER_L = 7392 + 1024 + 1024 + 72 + 64 + 512;
  for (int t = lbid(); t < L_ * PER_L; t += gridDim.x) {
    int l = t / PER_L, r = t % PER_L;
    if (r < 7392) {
      transpose_tile<true>((const float*)p.in[I_WIN] + (size_t)l * D_ * NIN, NIN, (u16*)(ws + OFF_WIN) + (size_t)l * NINP * D_, D_,
                     r / 231, r % 231, tile);
    } else if (r < 7392 + 1024) {
      r -= 7392;
      int bi = r >> 8;
      r &= 255;
      transpose_tile<false>((const float*)p.in[I_WBR] + (size_t)(l * 4 + bi) * 512 * 2048, 2048,
                     (u16*)(ws + OFF_WB) + (size_t)(l * 4 + bi) * 2048 * 512, 512, r >> 5, r & 31, tile);
    } else if (r < 7392 + 2048) {
      r -= 7392 + 1024;
      transpose_tile<false>((const float*)p.in[I_WOUT] + (size_t)l * 2048 * 2048, 2048, (u16*)(ws + OFF_WO) + (size_t)l * 2048 * 2048,
                     2048, r >> 5, r & 31, tile);
    } else if (r < 7392 + 2048 + 72) {
      r -= 7392 + 2048;
      transpose_tile<false>((const float*)p.in[I_WUQ] + (size_t)l * 384 * 768, 768, (u16*)(ws + OFF_WUQ) + (size_t)l * 768 * 384, 384,
                     r / 12, r % 12, tile);
    } else if (r < 7392 + 2048 + 72 + 64) {
      r -= 7392 + 2048 + 72;
      transpose_tile<false>((const float*)p.in[I_WUKV] + (size_t)l * 256 * 1024, 1024, (u16*)(ws + OFF_WUKV) + (size_t)l * 1024 * 256,
                     256, r >> 4, r & 15, tile);
    } else {
      r -= 7392 + 2048 + 72 + 64;
      transpose_tile<false>((const float*)p.in[I_WKV] + (size_t)l * 2048 * 1024, 1024, (u16*)(ws + OFF_WKV) + (size_t)l * 1024 * 2048,
                     2048, r >> 4, r & 15, tile);
    }
  }
}

__device__ __forceinline__ int tile_slots(int NT) { return gridDim.x == 512 ? 512 * ((NT + 7) >> 3) : 64 * NT; }
__device__ __forceinline__ bool tile_map(int t, int NT, int& mt, int& nt) {
  if (gridDim.x == 512) {
    int bid = t & 511, k = t >> 9, x = bid & 7, j = bid >> 3;
    mt = 8 * x + (j & 7);
    nt = 8 * k + (j >> 3);
  } else {
    mt = t & 63;
    nt = t >> 6;
  }
  return nt < NT;
}

__device__ __forceinline__ int tile_slots2(int NT) { return gridDim.x == 512 ? 512 * ((NT + 15) >> 4) : 32 * NT; }
__device__ __forceinline__ bool tile_map2(int t, int NT, int& mt, int& nt) {
  if (gridDim.x == 512) {
    int bid = t & 511, k = t >> 9, x = bid & 7, j = bid >> 3;
    mt = 4 * x + (j & 3);
    nt = 16 * k + (j >> 2);
  } else {
    mt = t & 31;
    nt = t >> 5;
  }
  return nt < NT;
}

__device__ __forceinline__ void phase_gemm_in(const Params p, int l, char* smem, int vb) {
  u16* As = (u16*)smem;
  char* ws = p.ws;
  {
    u16* Bs = As + 256 * 64;
    const int nslots = tile_slots2(112);
    for (int t = vb; t < nslots; t += gridDim.x) {
      int mt, nt;
      if (!tile_map2(t, 112, mt, nt)) continue;
      f32x4 acc[8][4];
#pragma unroll
      for (int i_ = 0; i_ < 8; ++i_)
#pragma unroll
        for (int j_ = 0; j_ < 4; ++j_) acc[i_][j_] = (f32x4){0.f, 0.f, 0.f, 0.f};
      int m0 = mt * 256, n0 = nt * 128;
      gemm_main_blk2((const u16*)(ws + OFF_H) + (size_t)(2 * mt) * 32 * 8192,
                     (const u16*)(ws + OFF_WIN) + (size_t)l * NINP * D_ + (size_t)nt * 32 * 8192, D_, As, Bs, acc);
      if (n0 < 1792) {
        float* dst = (float*)(ws + OFF_RWU);
        EPI_LOOP8({
          _Pragma("unroll") for (int r2 = 0; r2 < 4; ++r2) dst[(size_t)(m0 + mr + r2) * 1792 + n0 + nc] = acc[i][j][r2];
        })
      } else if (n0 >= O_DV && n0 < O_QL) {
        u16* dst = (u16*)(ws + OFF_VTD) + (size_t)((n0 - O_DV) / 128) * 128 * S_;
        EPI_LOOP8({
          uint2 o;
          o.x = pack2(acc[i][j][0], acc[i][j][1]);
          o.y = pack2(acc[i][j][2], acc[i][j][3]);
          *(uint2*)(dst + (size_t)nc * S_ + m0 + mr) = o;
        })
      } else {
        u16* dst = (u16*)(ws + OFF_P);
        EPI_LOOP8({
          _Pragma("unroll") for (int r2 = 0; r2 < 4; ++r2) dst[(size_t)(m0 + mr + r2) * NINP + n0 + nc] = f2bf(acc[i][j][r2]);
        })
      }
    }
  }
  {
    u16* Bs = As + 128 * 64;
    for (int t = vb; t < 256; t += gridDim.x) {
      f32x4 acc[4][4];
      ZERO_ACC(acc);
      int mt = t & 63, nt = 112 + (t >> 6);
      int m0 = mt * 128, n0 = nt * 128;
      gemm_main_blk((const u16*)(ws + OFF_H) + (size_t)mt * 32 * 8192,
                    (const u16*)(ws + OFF_WIN) + (size_t)l * NINP * D_ + (size_t)nt * 32 * 8192, D_, As, Bs, acc);
      u16* dst = (u16*)(ws + OFF_P);
      EPI_LOOP({
        _Pragma("unroll") for (int r2 = 0; r2 < 4; ++r2) dst[(size_t)(m0 + mr + r2) * NINP + n0 + nc] = f2bf(acc[i][j][r2]);
      })
    }
  }
  if (l == 0) {
    u16* Bs = As + 128 * 64;
    for (int tt = (vb + gridDim.x - 256) % gridDim.x; tt < 64; tt += gridDim.x) {
      f32x4 acc[4][4];
      ZERO_ACC(acc);
      int ll = tt >> 4, mt = (tt >> 3) & 1, nt = tt & 7;
      int m0 = mt * 128, n0 = nt * 128;
      gemm_main<false>((const u16*)(ws + OFF_MEMN) + ((size_t)ll * 256 + m0) * D_, D_, (const u16*)(ws + OFF_WKV) + ((size_t)ll * 1024 + n0) * D_,
                D_, D_, As, Bs, acc);
      if (nt < 4) {
        float* dst = (float*)(ws + OFF_KVMEM) + (size_t)ll * 256 * 512;
        EPI_LOOP({
          _Pragma("unroll") for (int r2 = 0; r2 < 4; ++r2) dst[(size_t)(m0 + mr + r2) * 512 + n0 + nc] = acc[i][j][r2];
        })
      } else {
        u16* dst = (u16*)(ws + OFF_VTMEM) + (size_t)(ll * 4 + (nt - 4)) * 128 * 256;
        EPI_LOOP({
          uint2 o;
          o.x = pack2(acc[i][j][0], acc[i][j][1]);
          o.y = pack2(acc[i][j][2], acc[i][j][3]);
          *(uint2*)(dst + (size_t)nc * 256 + m0 + mr) = o;
        })
      }
    }
  }
}

__device__ __forceinline__ void phase_gemm_mla(const Params p, int l, char* smem, int vb) {
  u16* As = (u16*)smem;
  u16* Bs = As + 128 * 64;
  char* ws = p.ws;
  const u16* P = (const u16*)(ws + OFF_P);
  const int nslots = tile_slots(14);
  for (int t = vb; t < nslots; t += gridDim.x) {
    f32x4 acc[4][4];
    ZERO_ACC(acc);
    int mt, nt;
    if (!tile_map(t, 14, mt, nt)) continue;
    int m0 = mt * 128;
    if (nt < 6) {
      int n0 = nt * 128;
      gemm_main<true>(P + (size_t)m0 * NINP + O_QL, NINP, (const u16*)(ws + OFF_WUQ) + ((size_t)l * 768 + n0) * 384, 384, 384, As, Bs, acc);
      u16* dst = (u16*)(ws + OFF_MQ);
      EPI_LOOP_T({
        uint2 o;
        o.x = pack2(acc[i][j][0], acc[i][j][1]);
        o.y = pack2(acc[i][j][2], acc[i][j][3]);
        *(uint2*)(dst + (size_t)(m0 + mr) * 768 + n0 + nc) = o;
      })
    } else {
      nt -= 6;
      int n0 = nt * 128, h = nt >> 1;
      if ((nt & 1) == 0) {
        gemm_main<true>(P + (size_t)m0 * NINP + O_KVL, NINP, (const u16*)(ws + OFF_WUKV) + ((size_t)l * 1024 + n0) * 256, 256, 256, As, Bs, acc);
        u16* dst = (u16*)(ws + OFF_MKV);
        EPI_LOOP_T({
          uint2 o;
          o.x = pack2(acc[i][j][0], acc[i][j][1]);
          o.y = pack2(acc[i][j][2], acc[i][j][3]);
          *(uint2*)(dst + (size_t)(m0 + mr) * 512 + h * 128 + nc) = o;
        })
      } else {
        gemm_main<false>(P + (size_t)m0 * NINP + O_KVL, NINP, (const u16*)(ws + OFF_WUKV) + ((size_t)l * 1024 + n0) * 256, 256, 256, As, Bs, acc);
        u16* dst = (u16*)(ws + OFF_VTM) + (size_t)h * 128 * S_;
        EPI_LOOP({
          uint2 o;
          o.x = pack2(acc[i][j][0], acc[i][j][1]);
          o.y = pack2(acc[i][j][2], acc[i][j][3]);
          *(uint2*)(dst + (size_t)nc * S_ + m0 + mr) = o;
        })
      }
    }
  }
}

__device__ __forceinline__ void phase_gemm_branch(const Params p, int l, char* smem, int vb) {
  u16* As = (u16*)smem;
  u16* Bs = As + 128 * 64;
  char* ws = p.ws;
  const u16* P = (const u16*)(ws + OFF_P);
  const int nslots = tile_slots(16);
  for (int t = vb; t < nslots; t += gridDim.x) {
    int mt, nt;
    if (!tile_map(t, 16, mt, nt)) continue;
    int m0 = mt * 128, n0 = nt * 128;
    f32x4 zacc[4][4];
    ZERO_ACC(zacc);
    for (int bi = 0; bi < 4; ++bi) {
      f32x4 acc[4][4];
      ZERO_ACC(acc);
      gemm_main1<true>((const u16*)(ws + OFF_YG) + ((size_t)bi * S_ + m0) * 512, 512,
                (const u16*)(ws + OFF_WB) + ((size_t)(l * 4 + bi) * 2048 + n0) * 512, 512, 512, As, Bs, acc);
      EPI_LOOP_T({
        const uint2 mg = *(const uint2*)(P + (size_t)(m0 + mr) * NINP + O_MG + bi * 2048 + n0 + nc);
        zacc[i][j][0] += sigmoidf_(lo2f(mg.x)) * acc[i][j][0];
        zacc[i][j][1] += sigmoidf_(hi2f(mg.x)) * acc[i][j][1];
        zacc[i][j][2] += sigmoidf_(lo2f(mg.y)) * acc[i][j][2];
        zacc[i][j][3] += sigmoidf_(hi2f(mg.y)) * acc[i][j][3];
      })
    }
    u16* dst = (u16*)(ws + OFF_Z);
    EPI_LOOP_T({
      uint2 o;
      o.x = pack2(zacc[i][j][0], zacc[i][j][1]);
      o.y = pack2(zacc[i][j][2], zacc[i][j][3]);
      *(uint2*)(dst + (size_t)(m0 + mr) * D_ + n0 + nc) = o;
    })
  }
}

__device__ __forceinline__ void phase_gemm_out(const Params p, int l, char* smem, int vb) {
  u16* As = (u16*)smem;
  u16* Bs = As + 128 * 64;
  char* ws = p.ws;
  const float* xin = (l == 0) ? (const float*)p.in[I_X] : (const float*)p.out;
  const int nslots = tile_slots(16);
  for (int t = vb; t < nslots; t += gridDim.x) {
    int mt, nt;
    if (!tile_map(t, 16, mt, nt)) continue;
    int m0 = mt * 128, n0 = nt * 128;
    f32x4 acc[4][4];
    ZERO_ACC(acc);
    gemm_main<true>((const u16*)(ws + OFF_Z) + (size_t)m0 * D_, D_, (const u16*)(ws + OFF_WO) + ((size_t)l * 2048 + n0) * D_, D_, D_, As, Bs,
              acc);
    EPI_LOOP_T({
      size_t idx = (size_t)(m0 + mr) * D_ + n0 + nc;
      float4 xv = *(const float4*)(xin + idx);
      *(float4*)(p.out + idx) = make_float4(xv.x + acc[i][j][0], xv.y + acc[i][j][1], xv.z + acc[i][j][2], xv.w + acc[i][j][3]);
    })
  }
}

__device__ __forceinline__ void seg_norm8(u16* ptr, bool active, int width, float inv_n, const float* g, float scale) {
  uint4 v = make_uint4(0, 0, 0, 0);
  if (active) v = *(const uint4*)ptr;
  float x[8] = {lo2f(v.x), hi2f(v.x), lo2f(v.y), hi2f(v.y), lo2f(v.z), hi2f(v.z), lo2f(v.w), hi2f(v.w)};
  float ss = 0.f;
#pragma unroll
  for (int i = 0; i < 8; ++i) ss += x[i] * x[i];
  for (int o = 1; o < width; o <<= 1) ss += __shfl_xor(ss, o);
  float rs = rsqrtf(ss * inv_n + 1e-6f) * scale;
  if (active) {
    float4 g0 = *(const float4*)g, g1 = *(const float4*)(g + 4);
    uint4 o;
    o.x = pack2(x[0] * rs * g0.x, x[1] * rs * g0.y);
    o.y = pack2(x[2] * rs * g0.z, x[3] * rs * g0.w);
    o.z = pack2(x[4] * rs * g1.x, x[5] * rs * g1.y);
    o.w = pack2(x[6] * rs * g1.z, x[7] * rs * g1.w);
    *(uint4*)ptr = o;
  }
}

template <bool RWONLY>
__device__ __forceinline__ void phase_prep(const Params p, int l, char* smem) {
  char* ws = p.ws;
  const int tid = ltid(), lane = tid & 63, w = tid >> 6;
  u16* P = (u16*)(ws + OFF_P);
  if (!RWONLY) {
    const float* dqg = (const float*)p.in[I_DQKG] + l * 128;
    const float* mqg = (const float*)p.in[I_MQKG] + l * 256;
    const float* qlg = (const float*)p.in[I_QLATG] + l * 384;
    const float* kvg = (const float*)p.in[I_KVLATG] + l * 256;
    for (int s = lbid() * 4 + w; s < S_; s += gridDim.x * 4) {
      u16* row = P + (size_t)s * NINP;
      seg_norm8(row + O_DQ + lane * 8, true, 8, 1.f / 64, dqg + (lane * 8) % 64, 0.125f * LOG2E);
      seg_norm8(row + O_DK + lane * 8, true, 8, 1.f / 64, dqg + 64 + (lane * 8) % 64, 1.f);
      seg_norm8(row + O_MQ + lane * 8, true, 16, 1.f / 128, mqg + (lane * 8) % 128, 0.08838834764831845f * LOG2E);
      seg_norm8(row + O_QL + (lane < 48 ? lane : 0) * 8, lane < 48, 64, 1.f / 384, qlg + (lane < 48 ? lane : 0) * 8, 1.f);
      seg_norm8(row + O_KVL + (lane < 32 ? lane : 0) * 8, lane < 32, 64, 1.f / 256, kvg + (lane < 32 ? lane : 0) * 8, 1.f);
    }
  }
  if (l == 0 && !RWONLY) {
    for (int sg = lbid() * 4 + w; sg < L_ * 256 * 4; sg += gridDim.x * 4) {
      int ll = sg >> 10, m = (sg >> 2) & 255, h = sg & 3;
      const float* src = (const float*)(ws + OFF_KVMEM) + ((size_t)ll * 256 + m) * 512 + h * 128;
      float a = src[lane], b = src[lane + 64];
      float ss = wave_sum(a * a + b * b);
      float rs = rsqrtf(ss * (1.f / 128) + 1e-6f);
      const float* g = (const float*)p.in[I_MQKG] + ll * 256 + 128;
      u16* dst = (u16*)(ws + OFF_KMEM) + ((size_t)(ll * 4 + h) * 256 + m) * 128;
      dst[lane] = f2bf(a * rs * g[lane]);
      dst[lane + 64] = f2bf(b * rs * g[lane + 64]);
    }
  }
  {
    float* ld = (float*)smem;
    const float* RWU = (const float*)(ws + OFF_RWU);
    const float* sh = (const float*)p.in[I_SHIFT] + (size_t)l * 3 * 1792;
    const float* wup = (const float*)p.in[I_WUP] + (size_t)l * 2 * 64 * 512;
    const float* aup = (const float*)p.in[I_AUP] + (size_t)l * 2 * 64 * 512;
    const float* w0 = (const float*)p.in[I_W0] + l * 1024;
    const float* a0 = (const float*)p.in[I_A0] + l * 1024;
    const float* kkp = (const float*)p.in[I_KK] + l * 512;
    const float* kap = (const float*)p.in[I_KA] + l * 512;
    const float* rkp = (const float*)p.in[I_RK] + l * 512;
    for (int tile = lbid(); tile < S_ / 8; tile += gridDim.x) {
      const int s0 = tile * 8;
      __syncthreads();
      {
        int c = 1536 + tid;
        float c0 = sh[c], c1 = sh[1792 + c], c2 = sh[2 * 1792 + c];
#pragma unroll
        for (int tk = 0; tk < 8; ++tk) {
          int s = s0 + tk;
          float um = s > 0 ? RWU[(size_t)(s - 1) * 1792 + c] : 0.f;
          float u0 = RWU[(size_t)s * 1792 + c];
          float up = s < S_ - 1 ? RWU[(size_t)(s + 1) * 1792 + c] : 0.f;
          float v = c0 * um + c1 * u0 + c2 * up;
          if (tid < 128) {
            const float e2 = __builtin_amdgcn_exp2f(2.885390081777927f * v);
            v = 1.f - 2.f * __builtin_amdgcn_rcpf(e2 + 1.f);
          }
          ld[tk * 256 + tid] = v;
        }
      }
      __syncthreads();
      float acc[8][4][2];
#pragma unroll
      for (int a = 0; a < 8; ++a)
#pragma unroll
        for (int b = 0; b < 4; ++b) acc[a][b][0] = acc[a][b][1] = 0.f;
      for (int l4 = 0; l4 < 16; ++l4) {
        float wv[4][4][2];
#pragma unroll
        for (int ll = 0; ll < 4; ++ll) {
#pragma unroll
          for (int ch = 0; ch < 2; ++ch) {
            int c = tid + ch * 256;
            int li = l4 * 4 + ll;
            wv[0][ll][ch] = wup[(size_t)(0 * 64 + li) * 512 + c];
            wv[1][ll][ch] = wup[(size_t)(1 * 64 + li) * 512 + c];
            wv[2][ll][ch] = aup[(size_t)(0 * 64 + li) * 512 + c];
            wv[3][ll][ch] = aup[(size_t)(1 * 64 + li) * 512 + c];
          }
        }
#pragma unroll
        for (int tk = 0; tk < 8; ++tk) {
#pragma unroll
          for (int mat = 0; mat < 4; ++mat) {
            float4 d = *(const float4*)(ld + tk * 256 + mat * 64 + l4 * 4);
#pragma unroll
            for (int ch = 0; ch < 2; ++ch) {
              acc[tk][mat][ch] += d.x * wv[mat][0][ch] + d.y * wv[mat][1][ch] + d.z * wv[mat][2][ch] + d.w * wv[mat][3][ch];
            }
          }
        }
      }
#pragma unroll
      for (int ch = 0; ch < 2; ++ch) {
        const int c = tid + ch * 256;
        float shc[3][3];
#pragma unroll
        for (int q = 0; q < 3; ++q)
#pragma unroll
          for (int j = 0; j < 3; ++j) shc[q][j] = sh[j * 1792 + q * 512 + c];
        const float kkc = kkp[c], kac = kap[c], rkc = rkp[c];
        const float w0c0 = w0[c], w0c1 = w0[512 + c], a0c0 = a0[c], a0c1 = a0[512 + c];
        float um[3], u0[3];
#pragma unroll
        for (int q = 0; q < 3; ++q) {
          um[q] = s0 > 0 ? RWU[(size_t)(s0 - 1) * 1792 + q * 512 + c] : 0.f;
          u0[q] = RWU[(size_t)s0 * 1792 + q * 512 + c];
        }
#pragma unroll
        for (int tk = 0; tk < 8; ++tk) {
          const int s = s0 + tk;
          float rkv[3];
#pragma unroll
          for (int q = 0; q < 3; ++q) {
            float up = s < S_ - 1 ? RWU[(size_t)(s + 1) * 1792 + q * 512 + c] : 0.f;
            rkv[q] = shc[q][0] * um[q] + shc[q][1] * u0[q] + shc[q][2] * up;
            um[q] = u0[q];
            u0[q] = up;
          }
          float r = rkv[0], k = rkv[1], v = rkv[2];
          float kkr = k * kkc;
          float ss = wave_sum(kkr * kkr);
          float kk = kkr * __builtin_amdgcn_rcpf(fmaxf(__builtin_amdgcn_sqrtf(ss), 1e-12f));
          float bsum = 0.f;
#pragma unroll
          for (int n = 0; n < 2; ++n) {
            float zw = (n ? w0c1 : w0c0) + acc[tk][n][ch];
            float za = (n ? a0c1 : a0c0) + acc[tk][2 + n][ch];
            float dec = __expf(-0.6065306597126334f * sigmoidf_(zw));
            float a = sigmoidf_(za);
            float kd = k * (1.f + (a - 1.f) * kac);
            float bb = kk * a;
            size_t o = ((size_t)n * S_ + s) * 512 + c;
            ((float*)(ws + OFF_SCW))[o] = dec;
            ((float*)(ws + OFF_SCKD))[o] = kd;
            ((float*)(ws + OFF_SCB))[o] = bb;
            bsum += r * kd * rkc;
          }
          size_t o1 = (size_t)s * 512 + c;
          ((float*)(ws + OFF_SCR))[o1] = r;
          ((float*)(ws + OFF_SCV))[o1] = v;
          ((float*)(ws + OFF_SCKK))[o1] = kk;
          float bon = wave_sum(bsum);
          if (lane == 0) ((float*)(ws + OFF_BONUS))[s * 8 + w + 4 * ch] = bon;
        }
      }
    }
  }
}

__device__ __forceinline__ void phase_mla_post(const Params p, int l, char* smem) {
  char* ws = p.ws;
  const int lane = ltid() & 63, w = ltid() >> 6;
  const float* ng = (const float*)p.in[I_NOPEG] + l * 256;
  const float* rg = (const float*)p.in[I_ROPEG] + l * 128;
  const int* pos = (const int*)p.in[I_POS];
  const float qscale = 0.07216878364870322f * LOG2E;
  const int fi = lane & 31;
  const float inv_freq = powf(10000.f, -(float)fi / 32.f);
  for (int s = lbid() * 4 + w; s < S_; s += gridDim.x * 4) {
    float ang = (float)pos[s] * inv_freq;
    float cs = cosf(ang), sn = sinf(ang);
    const u16* mq = (const u16*)(ws + OFF_MQ) + (size_t)s * 768;
    const u16* mk = (const u16*)(ws + OFF_MKV) + (size_t)s * 512;
    float kr1, kr2;
    {
      const u16* kr = (const u16*)(ws + OFF_P) + (size_t)s * NINP + O_KR;
      float t1 = lane < 32 ? bf2f(kr[fi]) : 0.f, t2 = lane < 32 ? bf2f(kr[32 + fi]) : 0.f;
      float ss = wave_sum(t1 * t1 + t2 * t2);
      float rs = rsqrtf(ss * (1.f / 64) + 1e-6f);
      t1 *= rs * rg[64 + fi];
      t2 *= rs * rg[64 + 32 + fi];
      kr1 = t1 * cs - t2 * sn;
      kr2 = t2 * cs + t1 * sn;
    }
#pragma unroll
    for (int h = 0; h < 4; ++h) {
      u16* qd = (u16*)(ws + OFF_QM) + ((size_t)h * S_ + s) * 192;
      u16* kd = (u16*)(ws + OFF_KM) + ((size_t)h * S_ + s) * 192;
      {
        const unsigned ab = *(const unsigned*)(mq + h * 192 + 2 * lane);
        float a = lo2f(ab), b = hi2f(ab);
        float ss = wave_sum(a * a + b * b);
        float rs = rsqrtf(ss * (1.f / 128) + 1e-6f) * qscale;
        const float2 gq = *(const float2*)(ng + 2 * lane);
        *(unsigned*)(qd + 2 * lane) = pack2(a * rs * gq.x, b * rs * gq.y);
      }
      {
        float t1 = lane < 32 ? bf2f(mq[h * 192 + 128 + fi]) : 0.f, t2 = lane < 32 ? bf2f(mq[h * 192 + 160 + fi]) : 0.f;
        float ss = wave_sum(t1 * t1 + t2 * t2);
        float rs = rsqrtf(ss * (1.f / 64) + 1e-6f);
        t1 *= rs * rg[fi];
        t2 *= rs * rg[32 + fi];
        if (lane < 32) {
          qd[128 + fi] = f2bf((t1 * cs - t2 * sn) * qscale);
          qd[160 + fi] = f2bf((t2 * cs + t1 * sn) * qscale);
        }
      }
      {
        const unsigned ab = *(const unsigned*)(mk + h * 128 + 2 * lane);
        float a = lo2f(ab), b = hi2f(ab);
        float ss = wave_sum(a * a + b * b);
        float rs = rsqrtf(ss * (1.f / 128) + 1e-6f);
        const float2 gk = *(const float2*)(ng + 128 + 2 * lane);
        *(unsigned*)(kd + 2 * lane) = pack2(a * rs * gk.x, b * rs * gk.y);
        if (lane < 32) {
          kd[128 + fi] = f2bf(kr1);
          kd[160 + fi] = f2bf(kr2);
        }
      }
    }
  }
}

template <int DQK, int NSUB>
__device__ __forceinline__ void attn_item(const u16* __restrict__ Q, int ldq, const u16* __restrict__ K, int ldk, const u16* __restrict__ Vt,
                          int ldv, int Skv, u16* __restrict__ O, int qb, bool hasBias, const float* __restrict__ relb, int head,
                          const int* __restrict__ pos, const int* __restrict__ kpmm, char* smem, const int* __restrict__ kposp,
                          float* __restrict__ ML) {
  constexpr int LDK = DQK;
  constexpr int SW = (DQK == 128) ? 15 : 7;
  constexpr int NKS = DQK / 32;
  constexpr int NKC = DQK / 32;
  u16* Ks = (u16*)smem;
  u16* Vs = (u16*)(smem + 25600);
  float* bt = (float*)(smem + 44032);
  int* kp = (int*)(smem + 45072);
  const int tid = ltid(), lane = tid & 63, w = tid >> 6, l15 = lane & 15, quad = lane >> 4;
  const int q0 = qb * (64 * NSUB) + w * (16 * NSUB);

  bf16x8 qf[NSUB][NKS];
#pragma unroll
  for (int sub = 0; sub < NSUB; ++sub)
#pragma unroll
    for (int ks = 0; ks < NKS; ++ks)
      qf[sub][ks] = *(const bf16x8*)(Q + (size_t)(q0 + sub * 16 + l15) * ldq + ks * 32 + quad * 8);

  int qp[2] = {0, 0};
  int qpmin = 0, qpmax = 0;
  if (hasBias) {
    qp[0] = pos[q0 + l15];
    qp[1] = pos[q0 + (NSUB - 1) * 16 + l15];
    qpmin = min(qp[0], qp[1]);
    qpmax = max(qp[0], qp[1]);
#pragma unroll
    for (int o = 8; o >= 1; o >>= 1) {
      qpmin = min(qpmin, __shfl_xor(qpmin, o));
      qpmax = max(qpmax, __shfl_xor(qpmax, o));
    }
  }
  __syncthreads();
  if (hasBias) {
    for (int i = tid; i < 257; i += 256) bt[i] = relb[t5_bucket(i - 128) * 4 + head] * LOG2E;
  }
  u32x4 kreg[NKC], vreg[4];
#pragma unroll
  for (int i = 0; i < NKC; ++i) {
    int c = tid + i * 256, r = c / (DQK / 8), kc = c % (DQK / 8);
    kreg[i] = *(const u32x4*)(K + (size_t)r * ldk + kc * 8);
  }
#pragma unroll
  for (int i = 0; i < 4; ++i) {
    int c = tid + i * 256, r = c >> 3, kc = c & 7;
    vreg[i] = *(const u32x4*)(Vt + (size_t)r * ldv + kc * 8);
  }
#pragma unroll
  for (int i = 0; i < NKC; ++i) {
    int c = tid + i * 256, r = c / (DQK / 8), kc = c % (DQK / 8);
    *(u32x4*)(Ks + r * LDK + ((kc ^ (r & SW)) * 8)) = kreg[i];
  }
#pragma unroll
  for (int i = 0; i < 4; ++i) {
    int c = tid + i * 256, r = c >> 3, kc = c & 7;
    *(u32x4*)(Vs + r * 72 + kc * 8) = vreg[i];
  }
  if (hasBias && tid < 64) kp[tid] = kposp[tid];
  __syncthreads();

  f32x4 oacc[8][NSUB];
#pragma unroll
  for (int et = 0; et < 8; ++et)
#pragma unroll
    for (int sub = 0; sub < NSUB; ++sub) oacc[et][sub] = (f32x4){0.f, 0.f, 0.f, 0.f};
  float mrow[2] = {-1e30f, -1e30f}, lrow[2] = {0.f, 0.f};

  const int ntiles = Skv / 64;
  constexpr bool KDMA = (DQK == 192);
  int koff[6];
#pragma unroll
  for (int i = 0; i < 6; ++i) {
    const int o = (w + 4 * i) * 1024 + lane * 16;
    const int r = o / (DQK * 2), pos = (o % (DQK * 2)) >> 4;
    koff[i] = r * ldk + ((pos ^ (r & SW)) * 8);
  }
  for (int t = 0; t < ntiles; ++t) {
    const bool more = (t + 1 < ntiles);
    const int k1 = (t + 1) * 64;
    constexpr bool EARLY = (DQK != 128);
    if (EARLY && more) {
      if (!KDMA) {
#pragma unroll
        for (int i = 0; i < NKC; ++i) {
          int c = tid + i * 256, r = c / (DQK / 8), kc = c % (DQK / 8);
          kreg[i] = *(const u32x4*)(K + (size_t)(k1 + r) * ldk + kc * 8);
        }
      }
#pragma unroll
      for (int i = 0; i < 4; ++i) {
        int c = tid + i * 256, r = c >> 3, kc = c & 7;
        vreg[i] = *(const u32x4*)(Vt + (size_t)r * ldv + k1 + kc * 8);
      }
    }
    f32x4 sacc[4][NSUB];
#pragma unroll
    for (int kt = 0; kt < 4; ++kt)
#pragma unroll
      for (int sub = 0; sub < NSUB; ++sub) sacc[kt][sub] = (f32x4){0.f, 0.f, 0.f, 0.f};
    __builtin_amdgcn_s_setprio(1);
#pragma unroll
    for (int ks = 0; ks < NKS; ++ks) {
#pragma unroll
      for (int kt = 0; kt < 4; ++kt) {
        bf16x8 kf = *(const bf16x8*)(Ks + (kt * 16 + l15) * LDK + (((ks * 4 + quad) ^ (l15 & SW)) * 8));
#pragma unroll
        for (int sub = 0; sub < NSUB; ++sub)
          sacc[kt][sub] = __builtin_amdgcn_mfma_f32_16x16x32_bf16(kf, qf[sub][ks], sacc[kt][sub], 0, 0, 0);
      }
      __builtin_amdgcn_sched_barrier(0);
    }
    __builtin_amdgcn_s_setprio(0);
    float cb = 0.f;
    if (hasBias) {
      int kmn = kpmm[t * 2], kmx = kpmm[t * 2 + 1];
      if (kmn - qpmax >= 128 || kmx - qpmin <= -128) {
        cb = (kmn - qpmax >= 128) ? bt[256] : bt[0];
      } else {
#pragma unroll
        for (int kt = 0; kt < 4; ++kt) {
#pragma unroll
          for (int j = 0; j < 4; ++j) {
            int kpos = kp[kt * 16 + quad * 4 + j];
#pragma unroll
            for (int sub = 0; sub < NSUB; ++sub) {
              int rel = kpos - qp[sub];
              rel = max(-128, min(128, rel));
              sacc[kt][sub][j] += bt[rel + 128];
            }
          }
        }
      }
    }
    LBAR();
    if (more) {
      if (!EARLY) {
#pragma unroll
        for (int i = 0; i < NKC; ++i) {
          int c = tid + i * 256, r = c / (DQK / 8), kc = c % (DQK / 8);
          kreg[i] = *(const u32x4*)(K + (size_t)(k1 + r) * ldk + kc * 8);
        }
#pragma unroll
        for (int i = 0; i < 4; ++i) {
          int c = tid + i * 256, r = c >> 3, kc = c & 7;
          vreg[i] = *(const u32x4*)(Vt + (size_t)r * ldv + k1 + kc * 8);
        }
      }
      if (hasBias && tid < 64) kp[tid] = kposp[k1 + tid];
      if (KDMA) {
#pragma unroll
        for (int i = 0; i < 6; ++i)
          __builtin_amdgcn_global_load_lds((const unsigned*)(K + (size_t)k1 * ldk + koff[i]),
                                           (unsigned*)((char*)Ks + (w + 4 * i) * 1024), 16, 0, 0);
      }
    }
    __builtin_amdgcn_sched_barrier(0);
    bf16x8 pf[NSUB][2];
#pragma unroll
    for (int sub = 0; sub < NSUB; ++sub) {
      float mx = -1e30f;
#pragma unroll
      for (int kt = 0; kt < 4; ++kt)
#pragma unroll
        for (int j = 0; j < 4; ++j) mx = fmaxf(mx, sacc[kt][sub][j]);
      mx = fmaxf(mx, __shfl_xor(mx, 16));
      mx = fmaxf(mx, __shfl_xor(mx, 32));
      float mnew = fmaxf(mrow[sub], mx + cb);
      float alpha = __builtin_amdgcn_exp2f(mrow[sub] - mnew);
      mrow[sub] = mnew;
      const float off = cb - mnew;
      float ps = 0.f;
      float pv[4][4];
#pragma unroll
      for (int kt = 0; kt < 4; ++kt)
#pragma unroll
        for (int j = 0; j < 4; ++j) {
          pv[kt][j] = __builtin_amdgcn_exp2f(sacc[kt][sub][j] + off);
          ps += pv[kt][j];
        }
      lrow[sub] = lrow[sub] * alpha + ps;
#pragma unroll
      for (int kb = 0; kb < 2; ++kb) {
        u32x4 pu = {pack2(pv[2 * kb][0], pv[2 * kb][1]), pack2(pv[2 * kb][2], pv[2 * kb][3]),
                    pack2(pv[2 * kb + 1][0], pv[2 * kb + 1][1]), pack2(pv[2 * kb + 1][2], pv[2 * kb + 1][3])};
        pf[sub][kb] = __builtin_bit_cast(bf16x8, pu);
      }
      if (__builtin_amdgcn_ballot_w64(alpha != 1.f) != 0) {
#pragma unroll
        for (int et = 0; et < 8; ++et) {
          oacc[et][sub][0] *= alpha; oacc[et][sub][1] *= alpha;
          oacc[et][sub][2] *= alpha; oacc[et][sub][3] *= alpha;
        }
      }
    }
    __builtin_amdgcn_s_setprio(1);
#pragma unroll
    for (int et = 0; et < 8; ++et) {
#pragma unroll
      for (int kb = 0; kb < 2; ++kb) {
        const u16* vp = Vs + (et * 16 + l15) * 72 + kb * 32 + quad * 4;
        u32x2 a0 = *(const u32x2*)vp;
        u32x2 a1 = *(const u32x2*)(vp + 16);
        u32x4 cu = {a0.x, a0.y, a1.x, a1.y};
        bf16x8 vb = __builtin_bit_cast(bf16x8, cu);
#pragma unroll
        for (int sub = 0; sub < NSUB; ++sub)
          oacc[et][sub] = __builtin_amdgcn_mfma_f32_16x16x32_bf16(vb, pf[sub][kb], oacc[et][sub], 0, 0, 0);
      }
      if (et & 1) __builtin_amdgcn_sched_barrier(0);
    }
    __builtin_amdgcn_s_setprio(0);
    if (more) {
      if (KDMA) {
        asm volatile("s_waitcnt vmcnt(0)" ::: "memory");
      } else {
#pragma unroll
        for (int i = 0; i < NKC; ++i) {
          int c = tid + i * 256, r = c / (DQK / 8), kc = c % (DQK / 8);
          *(u32x4*)(Ks + r * LDK + ((kc ^ (r & SW)) * 8)) = kreg[i];
        }
      }
    }
    LBAR();
    if (more) {
#pragma unroll
      for (int i = 0; i < 4; ++i) {
        int c = tid + i * 256, r = c >> 3, kc = c & 7;
        *(u32x4*)(Vs + r * 72 + kc * 8) = vreg[i];
      }
    }
  }
#pragma unroll
  for (int sub = 0; sub < NSUB; ++sub) {
    float lt = lrow[sub];
    lt += __shfl_xor(lt, 16);
    lt += __shfl_xor(lt, 32);
    float inv = 1.f / lt;
    if (ML) {
      inv = 1.f;
      if (quad == 0) *(float2*)(ML + (size_t)(q0 + sub * 16 + l15) * 2) = make_float2(mrow[sub], lt);
    }
    u16* orow = O + (size_t)(q0 + sub * 16 + l15) * 128;
#pragma unroll
    for (int et = 0; et < 8; ++et) {
      uint2 o;
      o.x = pack2(oacc[et][sub][0] * inv, oacc[et][sub][1] * inv);
      o.y = pack2(oacc[et][sub][2] * inv, oacc[et][sub][3] * inv);
      *(uint2*)(orow + et * 16 + quad * 4) = o;
    }
  }
}

#define QB2 (128 / ATT_NSUB)
#define SC_CH 16
#define SC_STEPF 336
typedef float f32x2 __attribute__((ext_vector_type(2)));
struct ScStep { f32x2 kk0, kk1, w0, w1, b0, b1, k0, k1, r0, r1; float v; };
__device__ __forceinline__ ScStep sc_ld(const float* sb, int jg4, int vi) {
  ScStep x;
  f32x4 t;
  t = *(const f32x4*)(sb + jg4);       x.kk0 = t.xy; x.kk1 = t.zw;
  t = *(const f32x4*)(sb + 64 + jg4);  x.w0 = t.xy;  x.w1 = t.zw;
  t = *(const f32x4*)(sb + 128 + jg4); x.b0 = t.xy;  x.b1 = t.zw;
  t = *(const f32x4*)(sb + 192 + jg4); x.k0 = t.xy;  x.k1 = t.zw;
  t = *(const f32x4*)(sb + 256 + jg4); x.r0 = t.xy;  x.r1 = t.zw;
  x.v = sb[320 + vi];
  return x;
}
__device__ __forceinline__ void scan_unit(const Params p, int u, char* smem) {
  char* ws = p.ws;
  const int tid = ltid(), lane = tid & 63, w = tid >> 6;
  const int chain = u >> 2, rg = u & 3, n = chain >> 3, h = chain & 7;
  const int jg = lane & 15, rw = lane >> 4;
  float* buf = (float*)smem;
  const float* a0 = (const float*)(ws + OFF_SCKK) + h * 64;
  const float* a1 = (const float*)(ws + OFF_SCW) + (size_t)n * S_ * 512 + h * 64;
  const float* a2 = (const float*)(ws + OFF_SCB) + (size_t)n * S_ * 512 + h * 64;
  const float* a3 = (const float*)(ws + OFF_SCKD) + (size_t)n * S_ * 512 + h * 64;
  const float* a4 = (const float*)(ws + OFF_SCR) + h * 64;
  const float* vsrc = (const float*)(ws + OFF_SCV) + h * 64 + rg * 16;
  float* ydst = (float*)(ws + OFF_YS) + (size_t)n * S_ * 512 + h * 64 + rg * 16 + w * 4 + rw;

  const float* pb[6];
  int pst[6], pf[6];
#pragma unroll
  for (int i = 0; i < 6; ++i) {
    int f = min(tid + i * 256, SC_CH * 84 - 1);
    int st = f / 84, q = f % 84;
    int a = q >> 4;
    const float* base = a == 0 ? a0 : a == 1 ? a1 : a == 2 ? a2 : a == 3 ? a3 : a == 4 ? a4 : vsrc;
    pb[i] = base + (a < 5 ? (q & 15) * 4 : (q - 80) * 4);
    pst[i] = st;
    pf[i] = f * 4;
  }
  const int sdir = n ? -1 : 1, sbase = n ? (S_ - 1) : 0;
  const int nch = S_ / SC_CH;
  unsigned po[6];
#pragma unroll
  for (int i = 0; i < 6; ++i)
    po[i] = (unsigned)((const char*)(pb[i] + (size_t)(sbase + sdir * pst[i]) * 512) - (const char*)ws);
  const unsigned yo = (unsigned)((const char*)(ydst + (size_t)(sbase + sdir * jg) * 512) - (const char*)ws);
  const int cstep = sdir * SC_CH * 512 * 4;
  f32x4 lregA[6], lregB[6];
#define SC_LOAD(R, CH)                                                            \
  {                                                                               \
    const unsigned d_ = (unsigned)(min((CH), nch - 1) * cstep);                   \
    _Pragma("unroll") for (int i = 0; i < 6; ++i)                                 \
      R[i] = *(const f32x4*)((const char*)ws + (unsigned)(po[i] + d_));           \
  }
#define SC_STORE(R, B)                                                \
  _Pragma("unroll") for (int i = 0; i < 6; ++i) *(f32x4*)(buf + (B) * SC_CH * SC_STEPF + pf[i]) = R[i];

  f32x2 sA = {0.f, 0.f}, sB = {0.f, 0.f};
  const int jg4 = jg * 4, vi = w * 4 + rw;
#define SC_COMPUTE(C, B)                                                              \
  {                                                                                   \
    const float* cb = buf + (B) * SC_CH * SC_STEPF;                                   \
    float ykeep = 0.f;                                                                \
    ScStep cur = sc_ld(cb, jg4, vi);                                                  \
    ScStep nx1 = sc_ld(cb + SC_STEPF, jg4, vi);                                       \
    _Pragma("unroll") for (int st = 0; st < SC_CH; ++st) {                            \
      ScStep nx2 = nx1;                                                               \
      if (st + 2 < SC_CH) nx2 = sc_ld(cb + (st + 2) * SC_STEPF, jg4, vi);             \
      f32x2 sa2 = sA * cur.kk0 + sB * cur.kk1;                                        \
      f32x2 vv = {cur.v, cur.v};                                                      \
      f32x2 uA = sA * cur.w0 + vv * cur.k0;                                           \
      f32x2 uB = sB * cur.w1 + vv * cur.k1;                                           \
      float sa = row16_sum(sa2.x + sa2.y);                                            \
      f32x2 nsa = {-sa, -sa};                                                         \
      sA = uA + nsa * cur.b0;                                                         \
      sB = uB + nsa * cur.b1;                                                         \
      f32x2 y2 = sA * cur.r0 + sB * cur.r1;                                           \
      float y = row16_sum(y2.x + y2.y);                                               \
      ykeep = (jg == st) ? y : ykeep;                                                 \
      cur = nx1;                                                                      \
      nx1 = nx2;                                                                      \
    }                                                                                 \
    *(float*)((char*)ws + (unsigned)(yo + (unsigned)((C) * cstep))) = ykeep;          \
  }

  __syncthreads();
  __builtin_amdgcn_s_setprio(3);
  SC_LOAD(lregA, 0);
  SC_STORE(lregA, 0);
  SC_LOAD(lregB, 1);
  __syncthreads();
  for (int c = 0; c < nch; c += 2) {
    SC_LOAD(lregA, c + 2);
    SC_COMPUTE(c, 0);
    SC_STORE(lregB, 1);
    LBAR();
    SC_LOAD(lregB, c + 3);
    SC_COMPUTE(c + 1, 1);
    SC_STORE(lregA, 0);
    LBAR();
  }
  __builtin_amdgcn_s_setprio(0);
}

template <int ATM>
__device__ __forceinline__ void phase_attn_scan(const Params p, int l, char* smem) {
  char* ws = p.ws;
  __shared__ int s_item;
  if (ATM & 8) for (int u = lbid(); u < 64; u += gridDim.x) scan_unit(p, u, smem);
  if ((ATM & 8) && (DUP_MASK & 2)) for (int u = lbid(); u < 64; u += gridDim.x) scan_unit(p, u, smem);
  int* cnt = (int*)(ws + OFF_CNT) + l * 4;
  const int* pos = (const int*)p.in[I_POS];
  const int* kpmm = (const int*)(ws + OFF_KPMM);
  const u16* P = (const u16*)(ws + OFF_P);
  u16* OB = (u16*)(ws + OFF_OB);
#define NEXT_ITEM(CI, LIMIT)                                   \
    __syncthreads();                                           \
    if (ltid() == 0) s_item = atomicAdd(cnt + (CI), 1);   \
    __syncthreads();                                           \
    const int it = s_item;                                     \
    if (it >= (LIMIT)) break;
  u16* OB2 = (u16*)(ws + OFF_OB2);
  float* MLb = (float*)(ws + OFF_ML);
  const int flip = (blockIdx.x >> 8) & 1;
  for (int pass = 0; pass < 2; ++pass) {
  const int which = pass ^ flip;
  if (which == 0) {
  if (ATM & 1) while (true) {
    NEXT_ITEM(0, 512)
    int hh = it >> 6, qb = it & 63, h = hh >> 1, half = hh & 1;
    const int kv0 = half * (S_ / 2);
    attn_item<192, 2>((const u16*)(ws + OFF_QM) + (size_t)h * S_ * 192, 192,
                      (const u16*)(ws + OFF_KM) + ((size_t)h * S_ + kv0) * 192, 192,
                      (const u16*)(ws + OFF_VTM) + (size_t)h * 128 * S_ + kv0, S_, S_ / 2,
                      (half ? OB2 : OB) + (size_t)(8 + h) * S_ * 128, qb, false, nullptr, 0, pos, kpmm, smem, pos,
                      MLb + ((size_t)half * 16 + 8 + h) * S_ * 2);
  }
  } else {
  if (ATM & 2) while (true) {
    NEXT_ITEM(1, 16 * QB2)
    int pp = it / QB2, qb = it % QB2, pr = pp >> 1, half = pp & 1, h = pr >> 1, hf = pr & 1;
    const int kv0 = half * (S_ / 2);
    attn_item<64, ATT_NSUB>(P + O_DQ + h * 128 + hf * 64, NINP, P + (size_t)kv0 * NINP + O_DK + h * 128 + hf * 64, NINP,
                            (const u16*)(ws + OFF_VTD) + (size_t)h * 128 * S_ + kv0, S_, S_ / 2,
                            (half ? OB2 : OB) + (size_t)pr * S_ * 128, qb, true, (const float*)p.in[I_RELB], h, pos,
                            kpmm + (kv0 / 64) * 2, smem, pos + kv0, MLb + ((size_t)half * 16 + pr) * S_ * 2);
  }
  }
  }
  if (ATM & 4) while (true) {
    NEXT_ITEM(2, 4 * QB2)
    int h = it / QB2, qb = it % QB2;
    attn_item<128, ATT_NSUB>(P + O_MQ + h * 128, NINP, (const u16*)(ws + OFF_KMEM) + (size_t)(l * 4 + h) * 256 * 128, 128,
                             (const u16*)(ws + OFF_VTMEM) + (size_t)(l * 4 + h) * 128 * 256, 256, 256,
                             OB + (size_t)(12 + h) * S_ * 128, qb, false, nullptr, 0, pos, kpmm, smem, pos, nullptr);
  }
}

__device__ __forceinline__ void phase_combine(const Params p, int l, char* smem) {
  char* ws = p.ws;
  const int lane = ltid() & 63, w = ltid() >> 6;
  const float lam_init = 0.8f - 0.6f * expf(-0.3f * (float)l);
  float lam;
  {
    const float* lq = (const float*)p.in[I_DLAM] + l * 256;
    float a = wave_sum(lq[lane] * lq[64 + lane]);
    float b = wave_sum(lq[128 + lane] * lq[192 + lane]);
    lam = expf(a) - expf(b) + lam_init;
  }
  const float* gng = (const float*)p.in[I_GNG] + l * 512;
  const float* gnb = (const float*)p.in[I_GNB] + l * 512;
  const float* subg = (const float*)p.in[I_DSUBG] + l * 128;
  const u16* P = (const u16*)(ws + OFF_P);
  const float* YS = (const float*)(ws + OFF_YS);
  const u16* OB = (const u16*)(ws + OFF_OB);
  const u16* OB2c = (const u16*)(ws + OFF_OB2);
  const float* MLp = (const float*)(ws + OFF_ML);
  u16* YG = (u16*)(ws + OFF_YG);
  for (int s = lbid() * 4 + w; s < S_; s += gridDim.x * 4) {
    const u16* grow = P + (size_t)s * NINP + O_G;
#pragma unroll
    for (int hp = 0; hp < 4; ++hp) {
      const int c = hp * 128 + 2 * lane, h = hp * 2 + (lane >> 5);
      const float2 ya = *(const float2*)(YS + (size_t)s * 512 + c);
      const float2 yb = *(const float2*)(YS + ((size_t)S_ + s) * 512 + c);
      float y0 = ya.x + yb.x, y1 = ya.y + yb.y;
      float sm = y0 + y1;
#pragma unroll
      for (int o = 16; o >= 1; o >>= 1) sm += __shfl_xor(sm, o);
      const float mu = sm * (1.f / 64);
      const float d0 = y0 - mu, d1 = y1 - mu;
      float vs = d0 * d0 + d1 * d1;
#pragma unroll
      for (int o = 16; o >= 1; o >>= 1) vs += __shfl_xor(vs, o);
      const float rstd = rsqrtf(vs * (1.f / 64) + 64e-5f);
      const float2 gg = *(const float2*)(gng + c), gb = *(const float2*)(gnb + c);
      const float bon = ((const float*)(ws + OFF_BONUS))[s * 8 + h];
      const float2 vv = *(const float2*)((const float*)(ws + OFF_SCV) + (size_t)s * 512 + c);
      float o0 = d0 * rstd * gg.x + gb.x + bon * vv.x;
      float o1 = d1 * rstd * gg.y + gb.y + bon * vv.y;
      const unsigned gt = *(const unsigned*)(grow + c);
      const float g0 = lo2f(gt), g1 = hi2f(gt);
      *(unsigned*)(YG + (size_t)s * 512 + c) = pack2(o0 * g0 * sigmoidf_(g0), o1 * g1 * sigmoidf_(g1));
    }
#define MERGE_LOAD(PR, A, B)                                                                   \
    {                                                                                          \
      const float2 ml0 = *(const float2*)(MLp + ((size_t)(PR) * S_ + s) * 2);                  \
      const float2 ml1 = *(const float2*)(MLp + ((size_t)(16 + (PR)) * S_ + s) * 2);           \
      const float mm = fmaxf(ml0.x, ml1.x);                                                    \
      const float w0 = __builtin_amdgcn_exp2f(ml0.x - mm), w1 = __builtin_amdgcn_exp2f(ml1.x - mm); \
      const float inv = __builtin_amdgcn_rcpf(w0 * ml0.y + w1 * ml1.y);                        \
      const unsigned q0 = *(const unsigned*)(OB + ((size_t)(PR) * S_ + s) * 128 + 2 * lane);   \
      const unsigned q1 = *(const unsigned*)(OB2c + ((size_t)(PR) * S_ + s) * 128 + 2 * lane); \
      A = (w0 * lo2f(q0) + w1 * lo2f(q1)) * inv;                                               \
      B = (w0 * hi2f(q0) + w1 * hi2f(q1)) * inv;                                               \
    }
#pragma unroll
    for (int h = 0; h < 4; ++h) {
      float a1, b1, a2, b2;
      MERGE_LOAD(h * 2, a1, b1)
      MERGE_LOAD(h * 2 + 1, a2, b2)
      float a = a1 - lam * a2, b = b1 - lam * b2;
      float ss = wave_sum(a * a + b * b);
      float rs = rsqrtf(ss * (1.f / 128) + 1e-6f) * (1.f - lam_init);
      const unsigned gg = *(const unsigned*)(grow + 512 + h * 128 + 2 * lane);
      float g0 = lo2f(gg), g1 = hi2f(gg);
      const float2 sg = *(const float2*)(subg + 2 * lane);
      u16* dst = YG + ((size_t)S_ + s) * 512 + h * 128;
      *(unsigned*)(dst + 2 * lane) = pack2(a * rs * sg.x * g0 * sigmoidf_(g0), b * rs * sg.y * g1 * sigmoidf_(g1));
    }
#pragma unroll
    for (int br = 2; br < 4; ++br) {
#pragma unroll
      for (int h = 0; h < 4; ++h) {
        float oa, ob;
        if (br == 2) {
          MERGE_LOAD(8 + h, oa, ob)
        } else {
          const unsigned o = *(const unsigned*)(OB + ((size_t)(12 + h) * S_ + s) * 128 + 2 * lane);
          oa = lo2f(o);
          ob = hi2f(o);
        }
        const unsigned gg = *(const unsigned*)(grow + br * 512 + h * 128 + 2 * lane);
        float g0 = lo2f(gg), g1 = hi2f(gg);
        u16* dst = YG + ((size_t)br * S_ + s) * 512 + h * 128;
        *(unsigned*)(dst + 2 * lane) = pack2(oa * g0 * sigmoidf_(g0), ob * g1 * sigmoidf_(g1));
      }
    }
#undef MERGE_LOAD
  }
}

#define XB_TMO      128
#define XB_XCNT(j)  (256  + 64 * (j))
#define XB_XSUB(j)  (1280 + 64 * (j))
#define XB_XGEN(j)  (2304 + 64 * (j))
#define XB_TOP      3328
#define XB_TOPGEN   3392
#define XCD_BAR_WORDS 3456
#define XB_SPIN_CAP (1u << 22)
#define LAS __attribute__((address_space(3)))
__device__ __forceinline__ unsigned xb_ld(unsigned* p)              { return __hip_atomic_load(p, __ATOMIC_RELAXED, __HIP_MEMORY_SCOPE_AGENT); }
__device__ __forceinline__ unsigned xb_add(unsigned* p, unsigned v) { return __hip_atomic_fetch_add(p, v, __ATOMIC_RELAXED, __HIP_MEMORY_SCOPE_AGENT); }
__device__ __forceinline__ unsigned xb_xcc_id() { return (unsigned)__builtin_amdgcn_s_getreg((3 << 11) | 20) & 0xFu; }
#define XB_SPIN(cond, bar) do { unsigned _sp = 0; while (cond) { __builtin_amdgcn_s_sleep(1); \
    if ((++_sp & 255u) == 0u) { if (xb_ld(&(bar)[XB_TMO])) break; if (_sp > XB_SPIN_CAP) { atomicAdd(&(bar)[XB_TMO], 1u); break; } } } } while (0)
struct XcdBarrier { unsigned* bar; unsigned x; volatile LAS unsigned* st; };
__device__ __forceinline__ XcdBarrier xcd_barrier_post(unsigned* bar, volatile LAS unsigned* st) {
  XcdBarrier b; b.bar = bar; b.x = xb_xcc_id(); b.st = st;
  if (threadIdx.x == 0) (void)xb_add(&bar[XB_XCNT(b.x)], 1u);
  return b;
}
__device__ __forceinline__ void xcd_barrier_complete(unsigned* bar, unsigned x, unsigned& nloc, unsigned& nx) {
  const unsigned G = gridDim.x * gridDim.y * gridDim.z;
  unsigned sum, cnt, mine, sp = 0u;
  for (;;) {
    sum = 0u; cnt = 0u; mine = 0u;
#pragma unroll
    for (unsigned j = 0; j < 16; ++j) { const unsigned c = xb_ld(&bar[XB_XCNT(j)]); sum += c; cnt += (c > 0u) ? 1u : 0u; mine = (j == x) ? c : mine; }
    if (sum == G) break;
    __builtin_amdgcn_s_sleep(1);
    if ((++sp & 255u) == 0u) { if (xb_ld(&bar[XB_TMO])) break; if (sp > XB_SPIN_CAP) { atomicAdd(&bar[XB_TMO], 1u); break; } }
  }
  nloc = mine > 0u ? mine : 1u; nx = cnt > 0u ? cnt : 1u;
}
__device__ __forceinline__ void xcd_barrier(const XcdBarrier& b) {
  asm volatile("s_waitcnt vmcnt(0)" ::: "memory");
  __syncthreads();
  if (threadIdx.x == 0) {
    unsigned* bar = b.bar;
    __builtin_amdgcn_s_waitcnt(0);
    unsigned nloc = b.st[0], nx = b.st[1];
    if (nloc == 0u) { xcd_barrier_complete(bar, b.x, nloc, nx); b.st[0] = nloc; b.st[1] = nx; }
    const unsigned old = xb_add(&bar[XB_XSUB(b.x)], 1u);
    const unsigned gen = old / nloc;
    if (old + 1u == (gen + 1u) * nloc) {
      __builtin_amdgcn_fence(__ATOMIC_RELEASE, "agent");
      asm volatile("s_waitcnt vmcnt(0)" ::: "memory");
      const unsigned og = xb_add(&bar[XB_TOP], 1u);
      const unsigned tg = og / nx;
      if (og + 1u == (tg + 1u) * nx) xb_add(&bar[XB_TOPGEN], 1u);
      else XB_SPIN(xb_ld(&bar[XB_TOPGEN]) == tg, bar);
      __builtin_amdgcn_fence(__ATOMIC_ACQUIRE, "agent");
      xb_add(&bar[XB_XGEN(b.x)], 1u);
      asm volatile("s_waitcnt vmcnt(0)" ::: "memory");
    } else {
      XB_SPIN(xb_ld(&bar[XB_XGEN(b.x)]) == gen, bar);
      __builtin_amdgcn_fence(__ATOMIC_ACQUIRE, "agent");
      asm volatile("s_waitcnt vmcnt(0)" ::: "memory");
    }
  }
  __syncthreads();
}

#define N_PHASES (1 + 9 * L_)

__global__ void __launch_bounds__(256, 2) mega(Params p, int ph_lo, int ph_hi) {
  __shared__ __attribute__((aligned(16))) char smem[SMEM_BYTES];
  cg::grid_group grid = cg::this_grid();
  __shared__ uint4 xb_words;
  if (threadIdx.x == 0) xb_words = make_uint4(0u, 0u, 0u, 0u);
  __syncthreads();
  XcdBarrier xb = xcd_barrier_post((unsigned*)(p.ws + OFF_BAR), (volatile LAS unsigned*)&xb_words);
  __shared__ int s_vbid, s_cand;
  if (threadIdx.x == 0) {
    int my_j = (int)xb_add((unsigned*)(p.ws + OFF_BAR) + 8 * xb.x, 1u);
    s_cand = my_j * 8 + (int)xb.x;
    s_vbid = blockIdx.x;
  }
#define VB s_vbid
  for (int ph = ph_lo; ph < ph_hi; ++ph) {
    if (ph == 0) {
      if (PH_MASK & 1) phase_w(p, smem);
    } else {
      int l = (ph - 1) / 9, sp = (ph - 1) % 9;
      switch (sp) {
        case 0: if (PH_MASK & 2) phase_gemm_in(p, l, smem, VB);
          if (DUP_MASK & 1) { __syncthreads(); phase_gemm_in(p, l, smem, VB); }
          break;
        case 1: if (PH_MASK & 4) phase_prep<false>(p, l, smem);
          if (DUP_MASK & 256) { __syncthreads(); phase_prep<true>(p, l, smem); }
          break;
        case 2: if (PH_MASK & 8) phase_gemm_mla(p, l, smem, VB);
          if (DUP_MASK & 16) { __syncthreads(); phase_gemm_mla(p, l, smem, VB); }
          break;
        case 3: if (PH_MASK & 16) phase_mla_post(p, l, smem);
          if (DUP_MASK & 32) { __syncthreads(); phase_mla_post(p, l, smem); }
          break;
        case 4: if (PH_MASK & 32) phase_attn_scan<AT_MASK>(p, l, smem); break;
        case 5: if (PH_MASK & 64) phase_combine(p, l, smem);
          if (DUP_MASK & 64) { __syncthreads(); phase_combine(p, l, smem); }
          break;
        case 6: if (PH_MASK & 128) phase_gemm_branch(p, l, smem, VB);
          if (DUP_MASK & 4) { __syncthreads(); phase_gemm_branch(p, l, smem, VB); }
          break;
        case 7: if (PH_MASK & 256) phase_gemm_out(p, l, smem, VB); break;
        case 8:
          if (l + 1 < L_) rms_rows<true>((const float*)p.out, S_, (const float*)p.in[I_NORMG] + (l + 1) * D_, (u16*)(p.ws + OFF_H));
          if ((DUP_MASK & 128) && l + 1 < L_) rms_rows<true>((const float*)p.out, S_, (const float*)p.in[I_NORMG] + (l + 1) * D_, (u16*)(p.ws + OFF_H));
          break;
      }
    }
#undef VB
    if (ph + 1 < ph_hi) {
      if (ph == ph_lo) {
        if (ph_hi < 0) grid.sync();
        xcd_barrier(xb);
        if (threadIdx.x == 0 && gridDim.x == 512) {
          bool ok = true;
          for (int j = 0; j < 8; ++j) ok = ok && (xb_ld((unsigned*)(p.ws + OFF_BAR) + 8 * j) == 64u);
          if (ok && xb.x < 8u) s_vbid = s_cand;
        }
        __syncthreads();
      } else xcd_barrier(xb);
    }
  }
}

template <int SP, int ATM>
__global__ void __launch_bounds__(256, 2) k_phase(Params p, int l) {
  __shared__ __attribute__((aligned(16))) char smem[SMEM_BYTES];
  const int VB = blockIdx.x;
  if (SP == -1) phase_w(p, smem);
  if (SP == 0) phase_gemm_in(p, l, smem, VB);
  if (SP == 1) phase_prep<false>(p, l, smem);
  if (SP == 2) phase_gemm_mla(p, l, smem, VB);
  if (SP == 3) phase_mla_post(p, l, smem);
  if (SP == 4) phase_attn_scan<ATM>(p, l, smem);
  if (SP == 5) phase_combine(p, l, smem);
  if (SP == 6) phase_gemm_branch(p, l, smem, VB);
  if (SP == 7) phase_gemm_out(p, l, smem, VB);
  if (SP == 8) rms_rows<true>((const float*)p.out, S_, (const float*)p.in[I_NORMG] + (l + 1) * D_, (u16*)(p.ws + OFF_H));
}

extern "C" void kernel_launch(void* const* d_in, const int* in_sizes, int n_in, void* d_out, int out_size, void* d_ws,
                              size_t ws_size, hipStream_t stream) {
  static int grid_blocks = 0;
  if (!grid_blocks) {
    int dev = 0, cus = 0, per_cu = 0;
    hipGetDevice(&dev);
    hipDeviceGetAttribute(&cus, hipDeviceAttributeMultiprocessorCount, dev);
    hipOccupancyMaxActiveBlocksPerMultiprocessor(&per_cu, mega, 256, 0);
    if (per_cu > 2) per_cu = 2;
    if (per_cu < 1) per_cu = 1;
    grid_blocks = cus * per_cu;
  }
  Params p{};
  for (int i = 0; i < N_INPUTS; ++i) p.in[i] = d_in[i];
  p.out = (float*)d_out;
  p.ws = (char*)d_ws;
  if (ws_size < WS_TOTAL) fprintf(stderr, "workspace too small: %zu < %zu\n", ws_size, (size_t)WS_TOTAL);
#if MULTI_LAUNCH
  const int G = grid_blocks;
  hipLaunchKernelGGL((k_phase<-1, 0>), dim3(G), dim3(256), 0, stream, p, 0);
  for (int l = 0; l < L_; ++l) {
    hipLaunchKernelGGL((k_phase<0, 0>), dim3(G), dim3(256), 0, stream, p, l);
    hipLaunchKernelGGL((k_phase<1, 0>), dim3(G), dim3(256), 0, stream, p, l);
    hipLaunchKernelGGL((k_phase<2, 0>), dim3(G), dim3(256), 0, stream, p, l);
    hipLaunchKernelGGL((k_phase<3, 0>), dim3(G), dim3(256), 0, stream, p, l);
    hipLaunchKernelGGL((k_phase<4, 8>), dim3(64), dim3(256), 0, stream, p, l);
    hipLaunchKernelGGL((k_phase<4, 1>), dim3(G), dim3(256), 0, stream, p, l);
    hipLaunchKernelGGL((k_phase<4, 2>), dim3(G), dim3(256), 0, stream, p, l);
    hipLaunchKernelGGL((k_phase<4, 4>), dim3(G), dim3(256), 0, stream, p, l);
    hipLaunchKernelGGL((k_phase<5, 0>), dim3(G), dim3(256), 0, stream, p, l);
    hipLaunchKernelGGL((k_phase<6, 0>), dim3(G), dim3(256), 0, stream, p, l);
    hipLaunchKernelGGL((k_phase<7, 0>), dim3(G), dim3(256), 0, stream, p, l);
    if (l + 1 < L_) hipLaunchKernelGGL((k_phase<8, 0>), dim3(G), dim3(256), 0, stream, p, l);
  }
#else
  hipMemsetAsync((char*)d_ws + OFF_BAR, 0, 3456 * 4, stream);
  int lo = 0, hi = N_PHASES - 1;
  void* args[] = {&p, &lo, &hi};
  hipError_t e = hipLaunchCooperativeKernel((void*)mega, dim3(grid_blocks), dim3(256), args, 0, stream);
  if (e != hipSuccess) fprintf(stderr, "cooperative launch failed: %s (grid %d)\n", hipGetErrorString(e), grid_blocks);
#endif
}
```
